# Optimizing an MI355X kernel written in HIP

```python
import math
import jax, jax.numpy as jnp
from jax import lax
import numpy as np

D_MODEL = 1024
BATCH = 4
SEQ = 8192
DEPTH = 1

CONV_CH = 768
CONV_K = 3
SSM_CH = 256
SSM_GROUP = 16
SSM_GROUPS = SSM_CH // SSM_GROUP
SSM_STATE = 64
DT_MIN = 1e-3
DT_MAX = 1e-1
N_BRANCH = 2
IN_COLS = 3 * CONV_CH + SSM_CH + N_BRANCH * D_MODEL
PEER_HEADS = 8
PEER_KEYS = 128
PEER_N = PEER_KEYS * PEER_KEYS
PEER_QDIM = 256
PEER_HALF = PEER_QDIM // 2
PEER_TOPK = 16
PEER_CHUNK = 128
RMS_EPS = 1e-6

kernel_name = "hybrid_conv_s5_peer_block"


def rmsnorm(x, g):
    xf = x.astype(jnp.float32)
    y = xf * lax.rsqrt(jnp.mean(xf * xf, axis=-1, keepdims=True) + RMS_EPS)
    return (y * g.astype(jnp.float32)).astype(x.dtype)


def short_conv_mixer(b, c, h, conv_w, conv_b):
    v = c * h
    s = v.shape[1]
    vp = jnp.pad(v, ((0, 0), (CONV_K - 1, 0), (0, 0)))
    y = conv_b
    for k in range(CONV_K):
        y = y + conv_w[k] * vp[:, k:k + s]
    return b * y


def _complex_scan_op(e1, e2):
    a1r, a1i, b1r, b1i = e1
    a2r, a2i, b2r, b2i = e2
    ar = a2r * a1r - a2i * a1i
    ai = a2r * a1i + a2i * a1r
    br = a2r * b1r - a2i * b1i + b2r
    bi = a2r * b1i + a2i * b1r + b2i
    return (ar, ai, br, bi)


def s5_mixer(u, lam_re, lam_im, log_dt, b_re, b_im, c_re, c_im, d_skip, w_glu, b_glu):
    f32 = jnp.float32
    bsz, s, _ = u.shape
    uf = u.astype(f32).reshape(bsz, s, SSM_GROUPS, SSM_GROUP)
    lr = lam_re.astype(f32)
    li = lam_im.astype(f32)
    dt = jnp.exp(log_dt.astype(f32))[:, None]
    mag = jnp.exp(lr * dt)
    ang = li * dt
    a_re = mag * jnp.cos(ang)
    a_im = mag * jnp.sin(ang)
    den = lr * lr + li * li
    nr = a_re - 1.0
    ni = a_im
    k_re = (nr * lr + ni * li) / den
    k_im = (ni * lr - nr * li) / den
    bu_re = jnp.einsum('bsgh,gph->bsgp', uf, b_re.astype(f32))
    bu_im = jnp.einsum('bsgh,gph->bsgp', uf, b_im.astype(f32))
    x_re = k_re * bu_re - k_im * bu_im
    x_im = k_re * bu_im + k_im * bu_re
    A_re = jnp.broadcast_to(a_re, x_re.shape)
    A_im = jnp.broadcast_to(a_im, x_im.shape)
    _, _, s_re, s_im = lax.associative_scan(_complex_scan_op, (A_re, A_im, x_re, x_im), axis=1)
    y = (jnp.einsum('bsgp,ghp->bsgh', s_re, c_re.astype(f32))
         - jnp.einsum('bsgp,ghp->bsgh', s_im, c_im.astype(f32))
         + d_skip.astype(f32) * uf)
    y = y.reshape(bsz, s, SSM_CH)
    z = jax.nn.gelu(y, approximate=False)
    out = z * jax.nn.sigmoid(z @ w_glu.astype(f32) + b_glu.astype(f32))
    return out.astype(u.dtype)


def peer_ffn(x, w_q, sub_k1, sub_k2, expert_u, expert_v):
    f32 = jnp.float32
    bsz, s, d = x.shape
    q = (x @ w_q).astype(f32).reshape(bsz, s, PEER_HEADS, 2, PEER_HALF)
    s1 = jnp.einsum('bshd,nd->bshn', q[..., 0, :], sub_k1.astype(f32))
    s2 = jnp.einsum('bshd,nd->bshn', q[..., 1, :], sub_k2.astype(f32))
    v1, i1 = lax.top_k(s1, PEER_TOPK)
    v2, i2 = lax.top_k(s2, PEER_TOPK)
    cand = (v1[..., :, None] + v2[..., None, :]).reshape(bsz, s, PEER_HEADS, PEER_TOPK * PEER_TOPK)
    cidx = (i1[..., :, None] * PEER_KEYS + i2[..., None, :]).reshape(bsz, s, PEER_HEADS, PEER_TOPK * PEER_TOPK)
    best, pos = lax.top_k(cand, PEER_TOPK)
    eidx = jnp.take_along_axis(cidx, pos, axis=-1)
    gate = jax.nn.softmax(best, axis=-1)
    n_chunks = (bsz * s) // PEER_CHUNK
    hk = PEER_HEADS * PEER_TOPK
    xs = x.reshape(n_chunks, PEER_CHUNK, d)
    es = eidx.reshape(n_chunks, PEER_CHUNK, hk)
    gs = gate.reshape(n_chunks, PEER_CHUNK, hk).astype(x.dtype)

    def block(args):
        xc, ec, gc = args
        u = jnp.take(expert_u, ec, axis=0)
        v = jnp.take(expert_v, ec, axis=0)
        h = jax.nn.gelu(jnp.einsum('cd,ckd->ck', xc, u), approximate=False)
        return jnp.einsum('ck,ckd->cd', gc * h, v)

    out = lax.map(block, (xs, es, gs))
    return out.reshape(bsz, s, d)


def setup_inputs(seed: int = 0) -> dict:
    key = jax.random.key(seed)
    ks = jax.random.split(key, 32)
    f32 = jnp.float32
    L = DEPTH
    D = D_MODEL

    def nrm(k, shape, scale):
        return jax.random.normal(k, shape, f32) * scale

    n_idx = jnp.arange(SSM_STATE, dtype=f32)
    lam_re = -0.5 + nrm(ks[6], (L, SSM_GROUPS, SSM_STATE), 0.01)
    lam_im = math.pi * n_idx[None, None, :] + nrm(ks[7], (L, SSM_GROUPS, SSM_STATE), 0.01)
    log_dt = jax.random.uniform(ks[8], (L, SSM_GROUPS), f32, math.log(DT_MIN), math.log(DT_MAX))
    return {
        "x": nrm(ks[0], (BATCH, SEQ, D), 1.0),
        "g_mix": 1.0 + nrm(ks[1], (L, D), 0.01),
        "w_in": nrm(ks[2], (L, D, IN_COLS), D ** -0.5),
        "b_gate": nrm(ks[3], (L, N_BRANCH * D), 0.01),
        "conv_w": nrm(ks[4], (L, CONV_K, CONV_CH), CONV_K ** -0.5),
        "conv_b": nrm(ks[5], (L, CONV_CH), 0.01),
        "lam_re": lam_re,
        "lam_im": lam_im,
        "log_dt": log_dt,
        "ssm_b_re": nrm(ks[9], (L, SSM_GROUPS, SSM_STATE, SSM_GROUP), (2 * SSM_GROUP) ** -0.5),
        "ssm_b_im": nrm(ks[10], (L, SSM_GROUPS, SSM_STATE, SSM_GROUP), (2 * SSM_GROUP) ** -0.5),
        "ssm_c_re": nrm(ks[11], (L, SSM_GROUPS, SSM_GROUP, SSM_STATE), SSM_STATE ** -0.5),
        "ssm_c_im": nrm(ks[12], (L, SSM_GROUPS, SSM_GROUP, SSM_STATE), SSM_STATE ** -0.5),
        "ssm_d": nrm(ks[13], (L, SSM_GROUPS, SSM_GROUP), 1.0),
        "w_glu": nrm(ks[14], (L, SSM_CH, SSM_CH), SSM_CH ** -0.5),
        "b_glu": nrm(ks[15], (L, SSM_CH), 0.01),
        "w_branch_a": nrm(ks[16], (L, CONV_CH, D), CONV_CH ** -0.5),
        "w_branch_b": nrm(ks[17], (L, SSM_CH, D), SSM_CH ** -0.5),
        "w_out": nrm(ks[18], (L, D, D), D ** -0.5),
        "g_ffn": 1.0 + nrm(ks[19], (L, D), 0.01),
        "w_q": nrm(ks[20], (L, D, PEER_HEADS * PEER_QDIM), D ** -0.5),
        "sub_keys_1": nrm(ks[21], (L, PEER_KEYS, PEER_HALF), PEER_HALF ** -0.5),
        "sub_keys_2": nrm(ks[22], (L, PEER_KEYS, PEER_HALF), PEER_HALF ** -0.5),
        "expert_u": nrm(ks[23], (L, PEER_N, D), D ** -0.5),
        "expert_v": nrm(ks[24], (L, PEER_N, D), PEER_HEADS ** -0.5),
        "g_final": 1.0 + nrm(ks[25], (D,), 0.01),
    }


def reference(x, g_mix, w_in, b_gate, conv_w, conv_b, lam_re, lam_im, log_dt,
              ssm_b_re, ssm_b_im, ssm_c_re, ssm_c_im, ssm_d, w_glu, b_glu,
              w_branch_a, w_branch_b, w_out, g_ffn, w_q, sub_keys_1, sub_keys_2,
              expert_u, expert_v, g_final):
    bsz, s, d = x.shape
    splits = [CONV_CH, 2 * CONV_CH, 3 * CONV_CH, 3 * CONV_CH + SSM_CH]
    for l in range(DEPTH):
        h = rmsnorm(x, g_mix[l])
        proj = h @ w_in[l]
        cb, cc, cx, su, gl = jnp.split(proj, splits, axis=-1)
        ya = short_conv_mixer(cb, cc, cx, conv_w[l], conv_b[l]) @ w_branch_a[l]
        yb = s5_mixer(su, lam_re[l], lam_im[l], log_dt[l], ssm_b_re[l], ssm_b_im[l],
                      ssm_c_re[l], ssm_c_im[l], ssm_d[l], w_glu[l], b_glu[l]) @ w_branch_b[l]
        g = jax.nn.sigmoid(gl + b_gate[l]).reshape(bsz, s, N_BRANCH, d)
        merged = g[:, :, 0] * ya + g[:, :, 1] * yb
        x = x + merged @ w_out[l]
        x = x + peer_ffn(rmsnorm(x, g_ffn[l]), w_q[l], sub_keys_1[l], sub_keys_2[l],
                         expert_u[l], expert_v[l])
    return rmsnorm(x, g_final)
```

```cpp
#include <hip/hip_runtime.h>
#include <cstdint>
#include <cstddef>

namespace {
constexpr int D = 1024, BATCH = 4, SEQ = 8192;
constexpr int CONV_CH = 768, SSM_CH = 256, SSM_GROUPS = 16, SSM_STATE = 64, SSM_GROUP = 16;
constexpr int IN_COLS = 3 * CONV_CH + SSM_CH + 2 * D;
constexpr int PEER_HEADS = 8, PEER_KEYS = 128, PEER_HALF = 128, PEER_TOPK = 16, PEER_QD = 2048;
constexpr float RMS_EPS = 1e-6f;

__device__ __forceinline__ float gelu_exact(float v) { return 0.5f * v * (1.0f + erff(v * 0.70710678118654752f)); }
__device__ __forceinline__ float sigmoidf_(float v) { return 1.0f / (1.0f + expf(-v)); }

__global__ void __launch_bounds__(256) ngemm(const float* __restrict__ A, int lda, const float* __restrict__ B, int ldb,
                                             float* __restrict__ C, int ldc, int M, int N, int K) {
    __shared__ float As[16][64 + 4];
    __shared__ float Bs[16][64 + 4];
    const int tx = threadIdx.x & 15, ty = threadIdx.x >> 4;
    const int bm = blockIdx.y * 64, bn = blockIdx.x * 64;
    float acc[4][4] = {};
    for (int k0 = 0; k0 < K; k0 += 16) {
        {
            const int r = threadIdx.x >> 2, c4 = (threadIdx.x & 3) * 4;
            const float4 v = *(const float4*)(A + (size_t)(bm + r) * lda + k0 + c4);
            As[c4 + 0][r] = v.x; As[c4 + 1][r] = v.y; As[c4 + 2][r] = v.z; As[c4 + 3][r] = v.w;
            const int rb = threadIdx.x >> 4, cb4 = (threadIdx.x & 15) * 4;
            const float4 w = *(const float4*)(B + (size_t)(k0 + rb) * ldb + bn + cb4);
            Bs[rb][cb4 + 0] = w.x; Bs[rb][cb4 + 1] = w.y; Bs[rb][cb4 + 2] = w.z; Bs[rb][cb4 + 3] = w.w;
        }
        __syncthreads();
#pragma unroll
        for (int k = 0; k < 16; ++k) {
            float a[4], b[4];
#pragma unroll
            for (int i = 0; i < 4; ++i) a[i] = As[k][ty * 4 + i];
#pragma unroll
            for (int j = 0; j < 4; ++j) b[j] = Bs[k][tx * 4 + j];
#pragma unroll
            for (int i = 0; i < 4; ++i)
#pragma unroll
                for (int j = 0; j < 4; ++j) acc[i][j] = fmaf(a[i], b[j], acc[i][j]);
        }
        __syncthreads();
    }
#pragma unroll
    for (int i = 0; i < 4; ++i) {
        float4 o = make_float4(acc[i][0], acc[i][1], acc[i][2], acc[i][3]);
        *(float4*)(C + (size_t)(bm + ty * 4 + i) * ldc + bn + tx * 4) = o;
    }
}

__global__ void __launch_bounds__(256) n_rmsnorm(const float* __restrict__ x, const float* __restrict__ g, float* __restrict__ y) {
    __shared__ float red[4];
    const size_t row = blockIdx.x;
    const float4 v = *(const float4*)(x + row * D + threadIdx.x * 4);
    float s = v.x * v.x + v.y * v.y + v.z * v.z + v.w * v.w;
    for (int o = 32; o > 0; o >>= 1) s += __shfl_xor(s, o);
    if ((threadIdx.x & 63) == 0) red[threadIdx.x >> 6] = s;
    __syncthreads();
    const float tot = red[0] + red[1] + red[2] + red[3];
    const float r = rsqrtf(tot * (1.0f / D) + RMS_EPS);
    const float4 gg = *(const float4*)(g + threadIdx.x * 4);
    float4 o = make_float4(v.x * r * gg.x, v.y * r * gg.y, v.z * r * gg.z, v.w * r * gg.w);
    *(float4*)(y + row * D + threadIdx.x * 4) = o;
}

__global__ void __launch_bounds__(256) n_conv(const float* __restrict__ proj, const float* __restrict__ cw, const float* __restrict__ cbias,
                                              float* __restrict__ am, int S) {
    const size_t i = (size_t)blockIdx.x * 256 + threadIdx.x;
    const int t = (int)(i / CONV_CH), j = (int)(i % CONV_CH);
    if (t >= S) return;
    const float* pr = proj + (size_t)t * IN_COLS;
    float y = cbias[j];
#pragma unroll
    for (int k = 0; k < 3; ++k) {
        const int tt = t - 2 + k;
        if (tt >= 0) { const float* q = proj + (size_t)tt * IN_COLS; y += cw[k * CONV_CH + j] * (q[CONV_CH + j] * q[2 * CONV_CH + j]); }
    }
    am[(size_t)t * CONV_CH + j] = pr[j] * y;
}

__global__ void n_ssm_const(const float* lam_re, const float* lam_im, const float* log_dt, float* cst) {
    const int i = blockIdx.x * blockDim.x + threadIdx.x;
    if (i >= 1024) return;
    const int g = i >> 6;
    const float lr = lam_re[i], li = lam_im[i], dt = expf(log_dt[g]);
    const float mag = expf(lr * dt), ang = li * dt;
    const float ar = mag * cosf(ang), ai = mag * sinf(ang);
    const float den = lr * lr + li * li, nr = ar - 1.0f, ni = ai;
    cst[i] = ar; cst[1024 + i] = ai; cst[2048 + i] = (nr * lr + ni * li) / den; cst[3072 + i] = (ni * lr - nr * li) / den;
}
__global__ void __launch_bounds__(256) n_ssm_x(const float* __restrict__ proj, const float* __restrict__ bre, const float* __restrict__ bim,
                                               const float* __restrict__ cst, float* __restrict__ xr, float* __restrict__ xi, int S) {
    const size_t i = (size_t)blockIdx.x * 256 + threadIdx.x;
    const int t = (int)(i >> 10), gp = (int)(i & 1023), g = gp >> 6;
    if (t >= S) return;
    const float* u = proj + (size_t)t * IN_COLS + 3 * CONV_CH + g * 16;
    float br = 0.f, bi = 0.f;
#pragma unroll
    for (int h = 0; h < 16; ++h) { br = fmaf(u[h], bre[gp * 16 + h], br); bi = fmaf(u[h], bim[gp * 16 + h], bi); }
    const float kr = cst[2048 + gp], ki = cst[3072 + gp];
    xr[i] = kr * br - ki * bi; xi[i] = kr * bi + ki * br;
}
__global__ void __launch_bounds__(256) n_ssm_scan(const float* __restrict__ cst, float* __restrict__ xr, float* __restrict__ xi, int S) {
    const int gp = blockIdx.x * 256 + threadIdx.x;
    const float ar = cst[gp], ai = cst[1024 + gp];
    float sr = 0.f, si = 0.f;
    for (int t = 0; t < S; ++t) {
        const size_t o = (size_t)t * 1024 + gp;
        const float a = xr[o], b = xi[o];
        const float nr = ar * sr - ai * si + a, ni = ar * si + ai * sr + b;
        sr = nr; si = ni; xr[o] = sr; xi[o] = si;
    }
}
__global__ void __launch_bounds__(256) n_ssm_y(const float* __restrict__ proj, const float* __restrict__ sr, const float* __restrict__ si,
                                               const float* __restrict__ cre, const float* __restrict__ cim, const float* __restrict__ dsk,
                                               float* __restrict__ z, int S) {
    const size_t i = (size_t)blockIdx.x * 256 + threadIdx.x;
    const int t = (int)(i >> 8), c = (int)(i & 255), g = c >> 4;
    if (t >= S) return;
    const float* a = sr + (size_t)t * 1024 + g * 64; const float* b = si + (size_t)t * 1024 + g * 64;
    float y = 0.f;
    for (int p = 0; p < 64; ++p) y += a[p] * cre[c * 64 + p] - b[p] * cim[c * 64 + p];
    y += dsk[c] * proj[(size_t)t * IN_COLS + 3 * CONV_CH + c];
    z[i] = gelu_exact(y);
}
__global__ void __launch_bounds__(256) n_glu(const float* __restrict__ z, const float* __restrict__ lin, const float* __restrict__ bglu, float* __restrict__ o, size_t n) {
    const size_t i = (size_t)blockIdx.x * 256 + threadIdx.x; if (i >= n) return;
    o[i] = z[i] * sigmoidf_(lin[i] + bglu[i & 255]);
}
__global__ void __launch_bounds__(256) n_merge(const float* __restrict__ proj, const float* __restrict__ bg, const float* __restrict__ ya,
                                               const float* __restrict__ yb, float* __restrict__ m, size_t n) {
    const size_t i = (size_t)blockIdx.x * 256 + threadIdx.x; if (i >= n) return;
    const size_t t = i >> 10; const int d = (int)(i & 1023);
    const float* gl = proj + t * IN_COLS + 3 * CONV_CH + SSM_CH;
    m[i] = sigmoidf_(gl[d] + bg[d]) * ya[i] + sigmoidf_(gl[D + d] + bg[D + d]) * yb[i];
}
__global__ void __launch_bounds__(256) n_add(const float* __restrict__ a, float* __restrict__ b, size_t n) {
    const size_t i = (size_t)blockIdx.x * 256 + threadIdx.x; if (i >= n) return; b[i] += a[i];
}

__device__ __forceinline__ void wave_argmax(float& v, int& idx) {
    for (int o = 32; o > 0; o >>= 1) {
        const float ov = __shfl_xor(v, o); const int oi = __shfl_xor(idx, o);
        if (ov > v || (ov == v && oi < idx)) { v = ov; idx = oi; }
    }
}
__global__ void __launch_bounds__(256) n_route(const float* __restrict__ q, const float* __restrict__ k1, const float* __restrict__ k2,
                                               int* __restrict__ eidx, float* __restrict__ gate) {
    __shared__ float qs[PEER_QD];
    __shared__ float sc[PEER_QD];
    __shared__ float tv[16][16]; __shared__ int ti[16][16];
    const size_t t = blockIdx.x; const int tid = threadIdx.x, lane = tid & 63, w = tid >> 6;
    for (int i = tid; i < PEER_QD; i += 256) qs[i] = q[t * PEER_QD + i];
    __syncthreads();
    for (int i = tid; i < PEER_QD; i += 256) {
        const int hs = i >> 7, n = i & 127, side = hs & 1;
        const float* kk = (side ? k2 : k1) + n * PEER_HALF; const float* qq = qs + hs * 128;
        float s = 0.f;
        for (int k = 0; k < 128; ++k) s = fmaf(qq[k], kk[k], s);
        sc[i] = s;
    }
    __syncthreads();
    for (int gi = 0; gi < 4; ++gi) {
        const int grp = w * 4 + gi;
        float a0 = sc[grp * 128 + lane], a1 = sc[grp * 128 + 64 + lane];
        for (int it = 0; it < 16; ++it) {
            float v; int idx;
            if (a0 >= a1) { v = a0; idx = lane; } else { v = a1; idx = lane + 64; }
            wave_argmax(v, idx);
            if (lane == 0) { tv[grp][it] = v; ti[grp][it] = idx; }
            if (idx == lane) a0 = -INFINITY; if (idx == lane + 64) a1 = -INFINITY;
        }
    }
    __syncthreads();
    for (int hh = 0; hh < 2; ++hh) {
        const int h = w * 2 + hh;
        float c[4]; int ci[4];
#pragma unroll
        for (int j = 0; j < 4; ++j) { const int pos = j * 64 + lane, a = pos >> 4, b = pos & 15; c[j] = tv[2 * h][a] + tv[2 * h + 1][b]; ci[j] = pos; }
        float bestv = 0.f; int beste = 0; float mx = 0.f;
        for (int it = 0; it < 16; ++it) {
            float v = c[0]; int idx = ci[0];
#pragma unroll
            for (int j = 1; j < 4; ++j) if (c[j] > v) { v = c[j]; idx = ci[j]; }
            wave_argmax(v, idx);
#pragma unroll
            for (int j = 0; j < 4; ++j) if (ci[j] == idx) c[j] = -INFINITY;
            if (it == 0) mx = v;
            if (lane == it) { bestv = v; beste = ti[2 * h][idx >> 4] * PEER_KEYS + ti[2 * h + 1][idx & 15]; }
        }
        float e = (lane < 16) ? expf(bestv - mx) : 0.f;
        float s = e; for (int o = 32; o > 0; o >>= 1) s += __shfl_xor(s, o);
        if (lane < 16) { eidx[t * 128 + h * 16 + lane] = beste; gate[t * 128 + h * 16 + lane] = e / s; }
    }
}

__global__ void __launch_bounds__(256) n_expert(const float* __restrict__ xn, const float* __restrict__ x1, const int* __restrict__ eidx,
                                                const float* __restrict__ gate, const float* __restrict__ eu, const float* __restrict__ ev,
                                                const float* __restrict__ gfin, float* __restrict__ out) {
    const size_t t = (size_t)blockIdx.x * 4 + (threadIdx.x >> 6); const int lane = threadIdx.x & 63;
    float4 xv[4], acc[4];
#pragma unroll
    for (int i = 0; i < 4; ++i) { xv[i] = *(const float4*)(xn + t * D + i * 256 + lane * 4); acc[i] = make_float4(0.f, 0.f, 0.f, 0.f); }
    for (int k = 0; k < 128; ++k) {
        const int e = eidx[t * 128 + k]; const float gt = gate[t * 128 + k];
        const float* ur = eu + (size_t)e * D; const float* vr = ev + (size_t)e * D;
        float s = 0.f;
#pragma unroll
        for (int i = 0; i < 4; ++i) { const float4 u = *(const float4*)(ur + i * 256 + lane * 4); s += u.x * xv[i].x + u.y * xv[i].y + u.z * xv[i].z + u.w * xv[i].w; }
        for (int o = 32; o > 0; o >>= 1) s += __shfl_xor(s, o);
        const float wgt = gt * gelu_exact(s);
#pragma unroll
        for (int i = 0; i < 4; ++i) { const float4 v = *(const float4*)(vr + i * 256 + lane * 4);
            acc[i].x = fmaf(wgt, v.x, acc[i].x); acc[i].y = fmaf(wgt, v.y, acc[i].y); acc[i].z = fmaf(wgt, v.z, acc[i].z); acc[i].w = fmaf(wgt, v.w, acc[i].w); }
    }
    float ss = 0.f;
#pragma unroll
    for (int i = 0; i < 4; ++i) { const float4 r = *(const float4*)(x1 + t * D + i * 256 + lane * 4);
        acc[i].x += r.x; acc[i].y += r.y; acc[i].z += r.z; acc[i].w += r.w;
        ss += acc[i].x * acc[i].x + acc[i].y * acc[i].y + acc[i].z * acc[i].z + acc[i].w * acc[i].w; }
    for (int o = 32; o > 0; o >>= 1) ss += __shfl_xor(ss, o);
    const float r = rsqrtf(ss * (1.0f / D) + RMS_EPS);
#pragma unroll
    for (int i = 0; i < 4; ++i) { const float4 g = *(const float4*)(gfin + i * 256 + lane * 4);
        *(float4*)(out + t * D + i * 256 + lane * 4) = make_float4(acc[i].x * r * g.x, acc[i].y * r * g.y, acc[i].z * r * g.z, acc[i].w * r * g.w); }
}

inline void gemm(hipStream_t s, const float* A, int lda, const float* B, int ldb, float* C, int ldc, int M, int N, int K) {
    ngemm<<<dim3(N / 64, M / 64), 256, 0, s>>>(A, lda, B, ldb, C, ldc, M, N, K);
}
}

extern "C" void kernel_launch(void* const* d_in, const int* in_sizes, int n_in, void* d_out, int out_size, void* d_ws, size_t ws_size, hipStream_t stream) {
    const float* x = (const float*)d_in[0];       const float* g_mix = (const float*)d_in[1];   const float* w_in = (const float*)d_in[2];
    const float* b_gate = (const float*)d_in[3];  const float* conv_w = (const float*)d_in[4];  const float* conv_b = (const float*)d_in[5];
    const float* lam_re = (const float*)d_in[6];  const float* lam_im = (const float*)d_in[7];  const float* log_dt = (const float*)d_in[8];
    const float* b_re = (const float*)d_in[9];    const float* b_im = (const float*)d_in[10];   const float* c_re = (const float*)d_in[11];
    const float* c_im = (const float*)d_in[12];   const float* d_skip = (const float*)d_in[13]; const float* w_glu = (const float*)d_in[14];
    const float* b_glu = (const float*)d_in[15];  const float* w_a = (const float*)d_in[16];    const float* w_b = (const float*)d_in[17];
    const float* w_out = (const float*)d_in[18];  const float* g_ffn = (const float*)d_in[19];  const float* w_q = (const float*)d_in[20];
    const float* k1 = (const float*)d_in[21];     const float* k2 = (const float*)d_in[22];     const float* eu = (const float*)d_in[23];
    const float* ev = (const float*)d_in[24];     const float* g_fin = (const float*)d_in[25];
    float* out = (float*)d_out;
    const int S = SEQ;
    char* wp = (char*)d_ws; size_t off = 0;
    auto alloc = [&](size_t bytes) { void* p = wp + off; off += (bytes + 255) & ~(size_t)255; return (float*)p; };
    float* cst = alloc(4096 * 4);
    float* hn = alloc((size_t)S * D * 4);
    float* proj = alloc((size_t)S * IN_COLS * 4);
    float* am = alloc((size_t)S * CONV_CH * 4);
    float* ya = alloc((size_t)S * D * 4);
    float* xr = alloc((size_t)S * 1024 * 4);
    float* xi = alloc((size_t)S * 1024 * 4);
    float* z = alloc((size_t)S * 256 * 4);
    float* lin = alloc((size_t)S * 256 * 4);
    float* s5 = alloc((size_t)S * 256 * 4);
    float* x1 = alloc((size_t)S * D * 4);
    int* eidx = (int*)alloc((size_t)S * 128 * 4);
    float* gate = alloc((size_t)S * 128 * 4);
    float* yb = xr; float* merged = xi; float* q = proj; float* xn = hn;
    n_ssm_const<<<4, 256, 0, stream>>>(lam_re, lam_im, log_dt, cst);
    for (int b = 0; b < BATCH; ++b) {
        const float* xb = x + (size_t)b * S * D; float* ob = out + (size_t)b * S * D;
        n_rmsnorm<<<S, 256, 0, stream>>>(xb, g_mix, hn);
        gemm(stream, hn, D, w_in, IN_COLS, proj, IN_COLS, S, IN_COLS, D);
        n_conv<<<(S * CONV_CH) / 256, 256, 0, stream>>>(proj, conv_w, conv_b, am, S);
        gemm(stream, am, CONV_CH, w_a, D, ya, D, S, D, CONV_CH);
        n_ssm_x<<<(S * 1024) / 256, 256, 0, stream>>>(proj, b_re, b_im, cst, xr, xi, S);
        n_ssm_scan<<<4, 256, 0, stream>>>(cst, xr, xi, S);
        n_ssm_y<<<(S * 256) / 256, 256, 0, stream>>>(proj, xr, xi, c_re, c_im, d_skip, z, S);
        gemm(stream, z, 256, w_glu, 256, lin, 256, S, 256, 256);
        n_glu<<<(S * 256) / 256, 256, 0, stream>>>(z, lin, b_glu, s5, (size_t)S * 256);
        gemm(stream, s5, 256, w_b, D, yb, D, S, D, 256);
        n_merge<<<(S * D) / 256, 256, 0, stream>>>(proj, b_gate, ya, yb, merged, (size_t)S * D);
        gemm(stream, merged, D, w_out, D, x1, D, S, D, D);
        n_add<<<(S * D) / 256, 256, 0, stream>>>(xb, x1, (size_t)S * D);
        n_rmsnorm<<<S, 256, 0, stream>>>(x1, g_ffn, xn);
        gemm(stream, xn, D, w_q, PEER_QD, q, PEER_QD, S, PEER_QD, D);
        n_route<<<S, 256, 0, stream>>>(q, k1, k2, eidx, gate);
        n_expert<<<S / 4, 256, 0, stream>>>(xn, x1, eidx, gate, eu, ev, g_fin, ob);
    }
}
```

```cpp
#include <hip/hip_runtime.h>
#include <cstdint>
#include <cstddef>
#include <cstdio>

#define LAS __attribute__((address_space(3)))
#ifndef DBG
#define DBG 0
#endif
#ifndef DBG_FIRST
#define DBG_FIRST 1
#endif
#if DBG
#define DBGC(...) __VA_ARGS__
#else
#define DBGC(...)
#endif
namespace {
typedef unsigned short bf16_t;
typedef short bf16x8 __attribute__((ext_vector_type(8)));
typedef float f32x4 __attribute__((ext_vector_type(4)));
typedef unsigned u32x4 __attribute__((ext_vector_type(4)));
typedef unsigned u32x2 __attribute__((ext_vector_type(2)));
typedef _Float16 h2 __attribute__((ext_vector_type(2)));

constexpr int D = 1024, T = DBG ? 16384 : 32768, SEQ = 8192;
constexpr int CONV_CH = 768, IN_COLS = 4608;
constexpr float RMS_EPS = 1e-6f;
constexpr int NBLK = 256, NTHR = 512, NWAVE = 8, NGW = NBLK * NWAVE;
constexpr int SUK = 1152;
constexpr int NCHUNK = T / 64;

constexpr size_t MB = 1024 * 1024;
constexpr size_t WS_CTL = 0;
constexpr size_t WS_RSTD1 = WS_CTL + 65536;
constexpr size_t WS_RS2P = WS_RSTD1 + (size_t)T * 4;
constexpr size_t WS_WIN = WS_RS2P + (size_t)T * 64;
constexpr size_t WS_WA = WS_WIN + (size_t)4608 * 1024 * 2;
constexpr size_t WS_WB = WS_WA + (size_t)1024 * 768 * 2;
constexpr size_t WS_WOUT = WS_WB + (size_t)1024 * 256 * 2;
constexpr size_t WS_WGLU = WS_WOUT + (size_t)1024 * 1024 * 2;
constexpr size_t WS_WS = WS_WGLU + (size_t)256 * 256 * 2;
constexpr size_t WS_UH = WS_WS + (size_t)2048 * 1024 * 2;
constexpr size_t WS_VH = WS_UH + (size_t)16384 * 1024 * 2;
constexpr size_t WS_POW = WS_VH + (size_t)16384 * 1024 * 2;
constexpr size_t WS_BBAR = WS_POW + (size_t)16 * 65 * 64 * 2 * 4;
constexpr size_t WS_KC = WS_BBAR + (size_t)16 * 64 * 16 * 2 * 4;
constexpr size_t WS_E = WS_KC + (size_t)16 * 64 * 256 * 4;
constexpr size_t WS_MEND = WS_E + (size_t)16 * 512 * 128 * 4;
constexpr size_t WS_MY = WS_MEND + (size_t)16 * 256 * 1024 * 2;
constexpr size_t WS_EIDX = WS_MEND;
constexpr size_t WS_GATE = WS_EIDX + (size_t)T * 128 * 4;
constexpr size_t WS_XB = WS_MY + (size_t)16 * 1024 * 1152 * 2;
constexpr size_t WS_G = WS_XB + (size_t)T * 1024 * 2;
constexpr size_t WS_CB = WS_G + (size_t)T * 2048 * 2;
constexpr size_t WS_V = WS_CB + (size_t)T * 768 * 2;
constexpr size_t WS_SU = WS_V + (size_t)T * 768 * 2;
constexpr size_t WS_A2 = WS_SU + (size_t)16 * 512 * SUK * 2;
constexpr size_t WS_END = WS_A2 + (size_t)T * 768 * 2;
constexpr size_t WS_P = WS_XB, WS_X1B = WS_XB, WS_X1 = WS_G, WS_MG = WS_CB, WS_SC = WS_CB, WS_Z = WS_A2, WS_S5 = WS_A2 + (size_t)T * 256 * 2;
static_assert(WS_GATE + (size_t)T * 128 * 4 <= WS_XB, "EIDX/GATE overlay");
static_assert(WS_SC + (size_t)(T / 2) * 2048 * 4 <= WS_END, "SC overlay");
static_assert(WS_END <= (size_t)512 * MB, "workspace");
#if DBG
constexpr int NB = 2048;
constexpr size_t DB_BASE = (WS_END + 4095) & ~(size_t)4095;
constexpr size_t DB_ACC = DB_BASE;
constexpr size_t DB_CST = DB_ACC + 4096;
constexpr size_t DB_HN = DB_CST + 16384;
constexpr size_t DB_PROJ = DB_HN + (size_t)NB * D * 4;
constexpr size_t DB_AM = DB_PROJ + (size_t)NB * IN_COLS * 4;
constexpr size_t DB_YA = DB_AM + (size_t)NB * CONV_CH * 4;
constexpr size_t DB_XR = DB_YA + (size_t)NB * D * 4;
constexpr size_t DB_XI = DB_XR + (size_t)NB * D * 4;
constexpr size_t DB_Z = DB_XI + (size_t)NB * D * 4;
constexpr size_t DB_LIN = DB_Z + (size_t)NB * 256 * 4;
constexpr size_t DB_S5 = DB_LIN + (size_t)NB * 256 * 4;
constexpr size_t DB_YB = DB_S5 + (size_t)NB * 256 * 4;
constexpr size_t DB_MG = DB_YB + (size_t)NB * D * 4;
constexpr size_t DB_X1 = DB_MG + (size_t)NB * D * 4;
constexpr size_t DB_XN = DB_X1 + (size_t)NB * D * 4;
constexpr size_t DB_Q = DB_XN + (size_t)NB * D * 4;
constexpr size_t DB_EIDX = DB_Q + (size_t)NB * 2048 * 4;
constexpr size_t DB_GATE = DB_EIDX + (size_t)NB * 128 * 4;
constexpr size_t DB_OUT = DB_GATE + (size_t)NB * 128 * 4;
constexpr size_t DB_H = DB_OUT + (size_t)NB * D * 4;
constexpr size_t DB_END = DB_H + (size_t)NB * 128 * 4;
static_assert(DB_END <= (size_t)512 * MB, "debug workspace");
constexpr size_t DBH_OFF = DB_H;
#endif

constexpr int LDS_STAGE = 131072, LDS_MISC = LDS_STAGE, LDS_BYTES = LDS_STAGE + 4096;

struct Params { const float* in[26]; float* out; unsigned char* ws; };

__device__ __forceinline__ unsigned pk2bf(float lo, float hi) { unsigned r; asm volatile("v_cvt_pk_bf16_f32 %0, %1, %2" : "=v"(r) : "v"(lo), "v"(hi)); return r; }
__device__ __forceinline__ float bflo(unsigned d) { return __uint_as_float(d << 16); }
__device__ __forceinline__ float bfhi(unsigned d) { return __uint_as_float(d & 0xffff0000u); }
__device__ __forceinline__ float gelu_exact(float v) { return 0.5f * v * (1.0f + erff(v * 0.70710678118654752f)); }
__device__ __forceinline__ float sigm(float v) { return 1.0f / (1.0f + __expf(-v)); }
__device__ __forceinline__ u32x4 pack8(const f32x4 a, const f32x4 b) { u32x4 w; w.x = pk2bf(a[0], a[1]); w.y = pk2bf(a[2], a[3]); w.z = pk2bf(b[0], b[1]); w.w = pk2bf(b[2], b[3]); return w; }
__device__ __forceinline__ float wave_sum(float v) {
#pragma unroll
    for (int o = 1; o < 64; o <<= 1) v += __shfl_xor(v, o);
    return v;
}

#define XB_TMO      128
#define XB_XCNT(j)  (256  + 64 * (j))
#define XB_XSUB(j)  (1280 + 64 * (j))
#define XB_XGEN(j)  (2304 + 64 * (j))
#define XB_TOP      3328
#define XB_TOPGEN   3392
#define XCD_BAR_WORDS 3456
#define XB_SPIN_CAP (1u << 22)
__device__ __forceinline__ unsigned xb_ld(unsigned* p)              { return __hip_atomic_load(p, __ATOMIC_RELAXED, __HIP_MEMORY_SCOPE_AGENT); }
__device__ __forceinline__ unsigned xb_add(unsigned* p, unsigned v) { return __hip_atomic_fetch_add(p, v, __ATOMIC_RELAXED, __HIP_MEMORY_SCOPE_AGENT); }
__device__ __forceinline__ unsigned xb_xcc_id() { return (unsigned)__builtin_amdgcn_s_getreg((3 << 11) | 20) & 0xFu; }
#define XB_SPIN(cond, bar) do { unsigned _sp = 0; while (cond) { __builtin_amdgcn_s_sleep(1); \
    if ((++_sp & 255u) == 0u) { if (xb_ld(&(bar)[XB_TMO])) break; if (_sp > XB_SPIN_CAP) { atomicAdd(&(bar)[XB_TMO], 1u); break; } } } } while (0)
struct XcdBarrier { unsigned* bar; unsigned x; volatile LAS unsigned* st; };
__device__ __forceinline__ XcdBarrier xcd_barrier_post(unsigned* bar, volatile LAS unsigned* st) {
    XcdBarrier b; b.bar = bar; b.x = xb_xcc_id(); b.st = st;
    if (threadIdx.x == 0) (void)xb_add(&bar[XB_XCNT(b.x)], 1u);
    return b;
}
__device__ __forceinline__ void xcd_barrier_complete(unsigned* bar, unsigned x, unsigned& nloc, unsigned& nx) {
    const unsigned G = gridDim.x * gridDim.y * gridDim.z;
    unsigned sum, cnt, mine, sp = 0u;
    for (;;) {
        sum = 0u; cnt = 0u; mine = 0u;
#pragma unroll
        for (unsigned j = 0; j < 16; ++j) { const unsigned c = xb_ld(&bar[XB_XCNT(j)]); sum += c; cnt += (c > 0u) ? 1u : 0u; mine = (j == x) ? c : mine; }
        if (sum == G) break;
        __builtin_amdgcn_s_sleep(1);
        if ((++sp & 255u) == 0u) { if (xb_ld(&bar[XB_TMO])) break; if (sp > XB_SPIN_CAP) { atomicAdd(&bar[XB_TMO], 1u); break; } }
    }
    nloc = mine > 0u ? mine : 1u; nx = cnt > 0u ? cnt : 1u;
}
__device__ __forceinline__ void xcd_barrier(const XcdBarrier& b) {
    asm volatile("s_waitcnt vmcnt(0)" ::: "memory");
    __syncthreads();
    if (threadIdx.x == 0) {
        unsigned* bar = b.bar;
        __builtin_amdgcn_s_waitcnt(0);
        unsigned nloc = b.st[0], nx = b.st[1];
        if (nloc == 0u) { xcd_barrier_complete(bar, b.x, nloc, nx); b.st[0] = nloc; b.st[1] = nx; }
        const unsigned old = xb_add(&bar[XB_XSUB(b.x)], 1u);
        const unsigned gen = old / nloc;
        if (old + 1u == (gen + 1u) * nloc) {
            __builtin_amdgcn_fence(__ATOMIC_RELEASE, "agent");
            asm volatile("s_waitcnt vmcnt(0)" ::: "memory");
            const unsigned og = xb_add(&bar[XB_TOP], 1u);
            const unsigned tg = og / nx;
            if (og + 1u == (tg + 1u) * nx) xb_add(&bar[XB_TOPGEN], 1u);
            else XB_SPIN(xb_ld(&bar[XB_TOPGEN]) == tg, bar);
            __builtin_amdgcn_fence(__ATOMIC_ACQUIRE, "agent");
            xb_add(&bar[XB_XGEN(b.x)], 1u);
            asm volatile("s_waitcnt vmcnt(0)" ::: "memory");
        } else {
            XB_SPIN(xb_ld(&bar[XB_XGEN(b.x)]) == gen, bar);
            __builtin_amdgcn_fence(__ATOMIC_ACQUIRE, "agent");
            asm volatile("s_waitcnt vmcnt(0)" ::: "memory");
        }
    }
    __syncthreads();
}

constexpr int BM = 256, BK = 64, HALF = 128, HTB = HALF * BK * 2, NXCD = 8, WGM = 8;
__device__ __forceinline__ int lds_byte(int r, int c) { const int st = (r >> 4) * 2 + (c >> 5), rr = r & 15, cc = c & 31, ob = rr * 64 + cc * 2; return st * 1024 + (ob ^ (((ob >> 9) & 1) << 5)); }
__device__ __forceinline__ void stage_rc(int b, int& R, int& C) { const int st = b / 1024, sb = b % 1024, swz = sb ^ (((sb >> 9) & 1) << 5); R = (st >> 1) * 16 + swz / 64; C = (st & 1) * 32 + (swz % 64) / 2; }
__device__ __forceinline__ int perm32(int rho) { const int n = rho >> 4, i = rho & 15; return 8 * (i >> 2) + 4 * n + (i & 3); }

struct Unit { int pm, pn, z; };
struct Gemm { const bf16_t* A; const bf16_t* Bt; int lda, ldb, K; long sAz, sBz; };
struct Order {
    int nM, nN, nZ, G, c, pm_off;
    __device__ void init(int M, int N, int Z, int pmo) { nM = M / BM; nN = N / BM; nZ = Z; G = gridDim.x; c = blockIdx.x; pm_off = pmo; }
    __device__ bool next(int i, Unit& u) const {
        const long L = (long)i * G + c; const int nwg = nM * nN;
        if (L >= (long)nwg * nZ) return false;
        if (nZ == 1) {
            int wgid = (int)L; { const int q = nwg / NXCD, r = nwg % NXCD, xcd = wgid % NXCD, off = wgid / NXCD; wgid = (xcd < r ? xcd * (q + 1) : r * (q + 1) + (xcd - r) * q) + off; }
            const int nig = WGM * nN, gid = wgid / nig, fm = gid * WGM, gsz = (nM - fm) < WGM ? (nM - fm) : WGM;
            u.pm = pm_off + fm + ((wgid % nig) % gsz); u.pn = (wgid % nig) / gsz; u.z = 0;
        } else { u.z = (int)(L / nwg); const int r = (int)(L % nwg); u.pm = r % nM; u.pn = r / nM; }
        return true;
    }
};

template <class Epi>
__device__ __forceinline__ void gemm_phase(LAS unsigned char* lds, const Gemm g, const Order& S, const Epi& E) {
    int tid = threadIdx.x; asm volatile("" : "+v"(tid));
    const int wid = __builtin_amdgcn_readfirstlane(tid >> 6), lane = tid & 63, wr = wid >> 2, wc = wid & 3, fr = lane & 15, fq = lane >> 4;
    const int K = g.K, nt = K / BK;
    unsigned voffA[2], voffB[2];
#pragma unroll
    for (int i = 0; i < 2; ++i) { int R, C; stage_rc(tid * 16 + i * 8192, R, C); const int Rb = Epi::PERM ? ((R & ~31) + perm32(R & 31)) : R;
        voffA[i] = (unsigned)(R * g.lda + C) * 2u; voffB[i] = (unsigned)(Rb * g.ldb + C) * 2u; }
    const size_t kstep = (size_t)(BK * 2);
    const size_t hstepA = (size_t)HALF * g.lda * 2, hstepB = (size_t)HALF * g.ldb * 2;
    const unsigned ldsw = (unsigned)wid * 1024u;
    const int aoff = lds_byte(wr * 64 + fr, fq * 8), boff = lds_byte(wc * 32 + fr, fq * 8);
#define PG8_SA(b, h) (((b) * 2 + (h)) * HTB)
#define PG8_SB(b, h) ((4 + (b) * 2 + (h)) * HTB)
#define PG8_STAGE(bufoff, gbase, voff) do { _Pragma("unroll") for (int _i = 0; _i < 2; ++_i) \
        __builtin_amdgcn_global_load_lds((const unsigned*)((const char*)(gbase) + (voff)[_i]), (LAS unsigned*)(lds + (bufoff) + ldsw + _i * 8192), 16, 0, 0); } while (0)
#define PG8_LDA(dst, b, h) do { _Pragma("unroll") for (int m = 0; m < 4; ++m) _Pragma("unroll") for (int k = 0; k < 2; ++k) dst[m][k] = *(const LAS bf16x8*)(lds + PG8_SA(b, h) + aoff + m * 2048 + k * 1024); } while (0)
#define PG8_LDB(dst, b, h) do { _Pragma("unroll") for (int n = 0; n < 2; ++n) _Pragma("unroll") for (int k = 0; k < 2; ++k) dst[n][k] = *(const LAS bf16x8*)(lds + PG8_SB(b, h) + boff + n * 2048 + k * 1024); } while (0)
#define PG8_MMA(ai, bj, At, Bt) do { __builtin_amdgcn_s_setprio(1); _Pragma("unroll") for (int m = 0; m < 4; ++m) _Pragma("unroll") for (int n = 0; n < 2; ++n) _Pragma("unroll") for (int k = 0; k < 2; ++k) \
        acc[ai][bj][m][n] = __builtin_amdgcn_mfma_f32_16x16x32_bf16(Bt[n][k], At[m][k], acc[ai][bj][m][n], 0, 0, 0); __builtin_amdgcn_s_setprio(0); } while (0)
#define PG8_WAIT_V(n) asm volatile("s_waitcnt vmcnt(" #n ")" ::: "memory")
#define PG8_WAIT_L(n) asm volatile("s_waitcnt lgkmcnt(" #n ")" ::: "memory")
#define PG8_BAR __builtin_amdgcn_s_barrier()
#define PG8_SCHED __builtin_amdgcn_sched_barrier(0)
    Unit cur, nxt; int ui = 0;
    if (!S.next(0, cur)) return;
    f32x4 acc[2][2][4][2];
#pragma unroll
    for (int a = 0; a < 2; ++a)
#pragma unroll
        for (int b = 0; b < 2; ++b)
#pragma unroll
            for (int m = 0; m < 4; ++m)
#pragma unroll
                for (int n = 0; n < 2; ++n) acc[a][b][m][n] = (f32x4){0.f, 0.f, 0.f, 0.f};
    bf16x8 At[4][2], B0[2][2], B1[2][2];
    const char* cA = (const char*)g.A + ((size_t)cur.z * g.sAz) * 2 + (size_t)cur.pm * 2 * hstepA;
    const char* cB = (const char*)g.Bt + ((size_t)cur.z * g.sBz) * 2 + (size_t)cur.pn * 2 * hstepB;
    PG8_STAGE(PG8_SB(0, 0), cB, voffB); PG8_STAGE(PG8_SA(0, 0), cA, voffA); PG8_STAGE(PG8_SB(0, 1), cB + hstepB, voffB); PG8_STAGE(PG8_SA(0, 1), cA + hstepA, voffA);
    if (wr == 1) PG8_BAR;
    PG8_WAIT_V(4); PG8_BAR;
    PG8_STAGE(PG8_SB(1, 0), cB + kstep, voffB); PG8_STAGE(PG8_SA(1, 0), cA + kstep, voffA); PG8_STAGE(PG8_SB(1, 1), cB + hstepB + kstep, voffB);
    PG8_WAIT_V(6); PG8_BAR;
    for (;;) {
        const bool has_next = S.next(ui + 1, nxt);
        const char* nA = has_next ? (const char*)g.A + ((size_t)nxt.z * g.sAz) * 2 + (size_t)nxt.pm * 2 * hstepA : cA;
        const char* nB = has_next ? (const char*)g.Bt + ((size_t)nxt.z * g.sBz) * 2 + (size_t)nxt.pn * 2 * hstepB : cB;
#pragma unroll 1
        for (int t = 0; t < nt; t += 2) {
            const bool last = (t == nt - 2);
            const char* a1 = cA + (size_t)(t + 1) * kstep;
            const char* a2 = last ? nA : cA + (size_t)(t + 2) * kstep; const char* b2 = last ? nB : cB + (size_t)(t + 2) * kstep;
            const char* a3 = a2 + kstep; const char* b3 = b2 + kstep;
            PG8_LDB(B0, 0, 0); PG8_SCHED; PG8_LDA(At, 0, 0); PG8_STAGE(PG8_SA(1, 1), a1 + hstepA, voffA);
            PG8_WAIT_L(8); PG8_BAR; PG8_WAIT_L(0); PG8_MMA(0, 0, At, B0); PG8_BAR; PG8_SCHED;
            PG8_LDB(B1, 0, 1); PG8_STAGE(PG8_SB(0, 0), b2, voffB);
            PG8_BAR; PG8_WAIT_L(0); PG8_MMA(0, 1, At, B1); PG8_BAR;
            PG8_LDA(At, 0, 1); PG8_STAGE(PG8_SA(0, 0), a2, voffA);
            PG8_BAR; PG8_WAIT_L(0); PG8_MMA(1, 0, At, B0); PG8_BAR; PG8_SCHED;
            PG8_STAGE(PG8_SB(0, 1), b2 + hstepB, voffB);
            PG8_WAIT_V(6); PG8_BAR; PG8_MMA(1, 1, At, B1); PG8_BAR;
            PG8_LDB(B0, 1, 0); PG8_SCHED; PG8_LDA(At, 1, 0); PG8_STAGE(PG8_SA(0, 1), a2 + hstepA, voffA);
            PG8_WAIT_L(8); PG8_BAR; PG8_WAIT_L(0); PG8_MMA(0, 0, At, B0); PG8_BAR; PG8_SCHED;
            PG8_LDB(B1, 1, 1); PG8_STAGE(PG8_SB(1, 0), b3, voffB);
            PG8_BAR; PG8_WAIT_L(0); PG8_MMA(0, 1, At, B1); PG8_BAR;
            PG8_LDA(At, 1, 1); PG8_STAGE(PG8_SA(1, 0), a3, voffA);
            PG8_BAR; PG8_WAIT_L(0); PG8_MMA(1, 0, At, B0); PG8_BAR; PG8_SCHED;
            PG8_STAGE(PG8_SB(1, 1), b3 + hstepB, voffB);
            PG8_WAIT_V(6); PG8_BAR; PG8_MMA(1, 1, At, B1); PG8_BAR;
        }
        { int fr_e = fr, fq_e = fq; asm volatile("" : "+v"(fr_e), "+v"(fq_e));
          E(acc, cur, wr, wc, fr_e, fq_e); }
        if (!has_next) break;
#pragma unroll
        for (int a = 0; a < 2; ++a)
#pragma unroll
            for (int b = 0; b < 2; ++b)
#pragma unroll
                for (int m = 0; m < 4; ++m)
#pragma unroll
                    for (int n = 0; n < 2; ++n) acc[a][b][m][n] = (f32x4){0.f, 0.f, 0.f, 0.f};
        cur = nxt; cA = nA; cB = nB; ++ui;
    }
    PG8_WAIT_V(0);
    if (wr == 0) PG8_BAR;
    PG8_BAR;
#undef PG8_SA
#undef PG8_SB
#undef PG8_STAGE
#undef PG8_LDA
#undef PG8_LDB
#undef PG8_MMA
#undef PG8_WAIT_V
#undef PG8_WAIT_L
#undef PG8_BAR
#undef PG8_SCHED
}

typedef const f32x4 (&AccRef)[2][2][4][2];
struct EpiG1 {
    static constexpr bool PERM = true;
    const float* rstd; const float* bgate; bf16_t *CB, *V, *SU, *G;
    __device__ __forceinline__ void operator()(AccRef acc, const Unit& u, int wr, int wc, int fr, int fq) const {
        const int pn = u.pn, c0 = wc * 32 + 8 * fq;
#pragma unroll
        for (int ai = 0; ai < 2; ++ai)
#pragma unroll
            for (int m = 0; m < 4; ++m) {
                const int row = u.pm * BM + ai * HALF + wr * 64 + m * 16 + fr; const float rs = rstd[row];
                if (pn < 3) {
#pragma unroll
                    for (int bj = 0; bj < 2; ++bj) *(u32x4*)(CB + (size_t)row * CONV_CH + pn * 256 + bj * HALF + c0) = pack8(acc[ai][bj][m][0] * rs, acc[ai][bj][m][1] * rs);
                } else if (pn < 9) {
                    const f32x4 v0 = (acc[ai][0][m][0] * rs) * (acc[ai][1][m][0] * rs), v1 = (acc[ai][0][m][1] * rs) * (acc[ai][1][m][1] * rs);
                    *(u32x4*)(V + (size_t)row * CONV_CH + (pn - 3) * HALF + c0) = pack8(v0, v1);
                } else if (pn == 9) {
#pragma unroll
                    for (int bj = 0; bj < 2; ++bj) { const int c = bj * HALF + c0, gq = c >> 4, h0 = c & 15;
                        *(u32x4*)(SU + ((size_t)(gq * NCHUNK + (row >> 6))) * SUK + (row & 63) * 16 + h0) = pack8(acc[ai][bj][m][0] * rs, acc[ai][bj][m][1] * rs); }
                } else {
#pragma unroll
                    for (int bj = 0; bj < 2; ++bj) { const int col = (pn - 10) * 256 + bj * HALF + c0;
                        const f32x4 b0 = *(const f32x4*)(bgate + col), b1 = *(const f32x4*)(bgate + col + 4);
                        f32x4 v0 = acc[ai][bj][m][0] * rs + b0, v1 = acc[ai][bj][m][1] * rs + b1;
#pragma unroll
                        for (int e = 0; e < 4; ++e) { v0[e] = sigm(v0[e]); v1[e] = sigm(v1[e]); }
                        *(u32x4*)(G + (size_t)row * 2048 + col) = pack8(v0, v1); }
                }
            }
    }
};
struct EpiP {
    static constexpr bool PERM = true;
    const bf16_t* G; bf16_t* P;
    __device__ __forceinline__ void operator()(AccRef acc, const Unit& u, int wr, int wc, int fr, int fq) const {
#pragma unroll
        for (int ai = 0; ai < 2; ++ai)
#pragma unroll
            for (int m = 0; m < 4; ++m) { const int row = u.pm * BM + ai * HALF + wr * 64 + m * 16 + fr;
#pragma unroll
                for (int bj = 0; bj < 2; ++bj) { const int col = u.pn * BM + bj * HALF + wc * 32 + 8 * fq;
                    const u32x4 gg = *(const u32x4*)(G + (size_t)row * 2048 + col);
                    f32x4 v0 = acc[ai][bj][m][0], v1 = acc[ai][bj][m][1];
                    v0[0] *= bflo(gg.x); v0[1] *= bfhi(gg.x); v0[2] *= bflo(gg.y); v0[3] *= bfhi(gg.y); v1[0] *= bflo(gg.z); v1[1] *= bfhi(gg.z); v1[2] *= bflo(gg.w); v1[3] *= bfhi(gg.w);
                    *(u32x4*)(P + (size_t)row * D + col) = pack8(v0, v1); } }
    }
};
struct EpiE {
    static constexpr bool PERM = false;
    float* E;
    __device__ __forceinline__ void operator()(AccRef acc, const Unit& u, int wr, int wc, int fr, int fq) const {
#pragma unroll
        for (int ai = 0; ai < 2; ++ai)
#pragma unroll
            for (int m = 0; m < 4; ++m) { const int row = u.pm * BM + ai * HALF + wr * 64 + m * 16 + fr;
#pragma unroll
                for (int n = 0; n < 2; ++n) *(f32x4*)(E + ((size_t)u.z * NCHUNK + row) * 128 + wc * 32 + n * 16 + 4 * fq) = acc[ai][0][m][n]; }
    }
};
struct EpiY {
    static constexpr bool PERM = true;
    const bf16_t* SU; const float* dskip; bf16_t* Z;
    __device__ __forceinline__ void operator()(AccRef acc, const Unit& u, int wr, int wc, int fr, int fq) const {
#pragma unroll
        for (int ai = 0; ai < 2; ++ai)
#pragma unroll
            for (int m = 0; m < 4; ++m) { const int chunk = u.pm * BM + ai * HALF + wr * 64 + m * 16 + fr;
#pragma unroll
                for (int bj = 0; bj < 2; ++bj) { const int col = u.pn * BM + bj * HALF + wc * 32 + 8 * fq, j = col >> 4, h0 = col & 15;
                    const u32x4 uu = *(const u32x4*)(SU + ((size_t)u.z * NCHUNK + chunk) * SUK + j * 16 + h0);
                    const f32x4 d0 = *(const f32x4*)(dskip + u.z * 16 + h0), d1 = *(const f32x4*)(dskip + u.z * 16 + h0 + 4);
                    f32x4 v0 = acc[ai][bj][m][0], v1 = acc[ai][bj][m][1];
                    v0[0] += d0[0] * bflo(uu.x); v0[1] += d0[1] * bfhi(uu.x); v0[2] += d0[2] * bflo(uu.y); v0[3] += d0[3] * bfhi(uu.y);
                    v1[0] += d1[0] * bflo(uu.z); v1[1] += d1[1] * bfhi(uu.z); v1[2] += d1[2] * bflo(uu.w); v1[3] += d1[3] * bfhi(uu.w);
#pragma unroll
                    for (int e = 0; e < 4; ++e) { v0[e] = gelu_exact(v0[e]); v1[e] = gelu_exact(v1[e]); }
                    *(u32x4*)(Z + ((size_t)chunk * 64 + j) * 256 + u.z * 16 + h0) = pack8(v0, v1); } }
    }
};
struct EpiGlu {
    static constexpr bool PERM = true;
    const bf16_t* Z; const float* bglu; bf16_t* S5;
    __device__ __forceinline__ void operator()(AccRef acc, const Unit& u, int wr, int wc, int fr, int fq) const {
#pragma unroll
        for (int ai = 0; ai < 2; ++ai)
#pragma unroll
            for (int m = 0; m < 4; ++m) { const int row = u.pm * BM + ai * HALF + wr * 64 + m * 16 + fr;
#pragma unroll
                for (int bj = 0; bj < 2; ++bj) { const int col = bj * HALF + wc * 32 + 8 * fq;
                    const u32x4 zz = *(const u32x4*)(Z + (size_t)row * 256 + col);
                    const f32x4 b0 = *(const f32x4*)(bglu + col), b1 = *(const f32x4*)(bglu + col + 4);
                    f32x4 v0 = acc[ai][bj][m][0] + b0, v1 = acc[ai][bj][m][1] + b1;
                    v0[0] = bflo(zz.x) * sigm(v0[0]); v0[1] = bfhi(zz.x) * sigm(v0[1]); v0[2] = bflo(zz.y) * sigm(v0[2]); v0[3] = bfhi(zz.y) * sigm(v0[3]);
                    v1[0] = bflo(zz.z) * sigm(v1[0]); v1[1] = bfhi(zz.z) * sigm(v1[1]); v1[2] = bflo(zz.w) * sigm(v1[2]); v1[3] = bfhi(zz.w) * sigm(v1[3]);
                    *(u32x4*)(S5 + (size_t)row * 256 + col) = pack8(v0, v1); } }
    }
};
struct EpiMerge {
    static constexpr bool PERM = true;
    const bf16_t* G; const bf16_t* P; bf16_t* MG;
    __device__ __forceinline__ void operator()(AccRef acc, const Unit& u, int wr, int wc, int fr, int fq) const {
#pragma unroll
        for (int ai = 0; ai < 2; ++ai)
#pragma unroll
            for (int m = 0; m < 4; ++m) { const int row = u.pm * BM + ai * HALF + wr * 64 + m * 16 + fr;
#pragma unroll
                for (int bj = 0; bj < 2; ++bj) { const int col = u.pn * BM + bj * HALF + wc * 32 + 8 * fq;
                    const u32x4 gg = *(const u32x4*)(G + (size_t)row * 2048 + D + col); const u32x4 pp = *(const u32x4*)(P + (size_t)row * D + col);
                    f32x4 v0 = acc[ai][bj][m][0], v1 = acc[ai][bj][m][1];
                    v0[0] = bflo(pp.x) + bflo(gg.x) * v0[0]; v0[1] = bfhi(pp.x) + bfhi(gg.x) * v0[1]; v0[2] = bflo(pp.y) + bflo(gg.y) * v0[2]; v0[3] = bfhi(pp.y) + bfhi(gg.y) * v0[3];
                    v1[0] = bflo(pp.z) + bflo(gg.z) * v1[0]; v1[1] = bfhi(pp.z) + bfhi(gg.z) * v1[1]; v1[2] = bflo(pp.w) + bflo(gg.w) * v1[2]; v1[3] = bfhi(pp.w) + bfhi(gg.w) * v1[3];
                    *(u32x4*)(MG + (size_t)row * D + col) = pack8(v0, v1); } }
    }
};
struct EpiX1 {
    static constexpr bool PERM = true;
    const float* x; float* X1; bf16_t* X1B; float* RS2P;
    __device__ __forceinline__ void operator()(AccRef acc, const Unit& u, int wr, int wc, int fr, int fq) const {
#pragma unroll
        for (int ai = 0; ai < 2; ++ai)
#pragma unroll
            for (int m = 0; m < 4; ++m) { const int row = u.pm * BM + ai * HALF + wr * 64 + m * 16 + fr; float ss = 0.f;
#pragma unroll
                for (int bj = 0; bj < 2; ++bj) { const int col = u.pn * BM + bj * HALF + wc * 32 + 8 * fq; const size_t o = (size_t)row * D + col;
                    const f32x4 v0 = acc[ai][bj][m][0] + *(const f32x4*)(x + o), v1 = acc[ai][bj][m][1] + *(const f32x4*)(x + o + 4);
                    *(f32x4*)(X1 + o) = v0; *(f32x4*)(X1 + o + 4) = v1; *(u32x4*)(X1B + o) = pack8(v0, v1);
                    ss += (v0[0] * v0[0] + v0[1] * v0[1]) + (v0[2] * v0[2] + v0[3] * v0[3]) + (v1[0] * v1[0] + v1[1] * v1[1]) + (v1[2] * v1[2] + v1[3] * v1[3]); }
                ss += __shfl_xor(ss, 16); ss += __shfl_xor(ss, 32);
                if (fq == 0) RS2P[(size_t)row * 16 + u.pn * 4 + wc] = ss; }
    }
};
struct EpiSC {
    static constexpr bool PERM = false;
    float* SC; int row0;
    __device__ __forceinline__ void operator()(AccRef acc, const Unit& u, int wr, int wc, int fr, int fq) const {
#pragma unroll
        for (int ai = 0; ai < 2; ++ai)
#pragma unroll
            for (int m = 0; m < 4; ++m) { const int row = u.pm * BM + ai * HALF + wr * 64 + m * 16 + fr - row0;
#pragma unroll
                for (int bj = 0; bj < 2; ++bj)
#pragma unroll
                    for (int n = 0; n < 2; ++n) *(f32x4*)(SC + (size_t)row * 2048 + u.pn * BM + bj * HALF + wc * 32 + n * 16 + 4 * fq) = acc[ai][bj][m][n]; }
    }
};

__device__ __forceinline__ void transpose_item(const float* W, int ldw, int src_col0, bf16_t* WT, int ldt, int dst_row0, int k0, const float* scale, LAS float* scr, int lane) {
#pragma unroll 8
    for (int i = 0; i < 32; ++i) { const int kk = 2 * i + (lane >> 5); float v = W[(size_t)(k0 + kk) * ldw + src_col0 + (lane & 31)]; if (scale) v *= scale[k0 + kk]; scr[kk * 33 + (lane & 31)] = v; }
    asm volatile("s_waitcnt lgkmcnt(0)" ::: "memory");
    const int c = lane & 7;
#pragma unroll
    for (int j = 0; j < 4; ++j) { const int n = (lane >> 3) + 8 * j; const LAS float* s = scr + (8 * c) * 33 + n;
        u32x4 o; o.x = pk2bf(s[0 * 33], s[1 * 33]); o.y = pk2bf(s[2 * 33], s[3 * 33]); o.z = pk2bf(s[4 * 33], s[5 * 33]); o.w = pk2bf(s[6 * 33], s[7 * 33]);
        *(u32x4*)(WT + (size_t)(dst_row0 + n) * ldt + k0 + 8 * c) = o; }
    asm volatile("s_waitcnt lgkmcnt(0)" ::: "memory");
}
__device__ __forceinline__ int win_src_col(int n) {
    if (n < 768 || n >= 2304) return n;
    const int q = n - 768, j = q >> 8, r = q & 255;
    return r < 128 ? 768 + j * 128 + r : 1536 + j * 128 + (r - 128);
}
__device__ __forceinline__ void phase_prologue(const Params& p, LAS unsigned char* lds) {
    int tid = threadIdx.x; asm volatile("" : "+v"(tid));
    const int lane = tid & 63, wave = __builtin_amdgcn_readfirstlane(tid >> 6), gw = blockIdx.x * NWAVE + wave;
    unsigned char* ws = p.ws;
    const float* x = p.in[0]; const float* g_mix = p.in[1]; const float* w_in = p.in[2];
    const float* lam_re = p.in[6]; const float* lam_im = p.in[7]; const float* log_dt = p.in[8]; const float* b_re = p.in[9]; const float* b_im = p.in[10];
    const float* w_glu = p.in[14]; const float* w_a = p.in[16]; const float* w_b = p.in[17]; const float* w_out = p.in[18]; const float* g_ffn = p.in[19]; const float* w_q = p.in[20];
    const float* k1 = p.in[21]; const float* k2 = p.in[22]; const float* eu = p.in[23]; const float* ev = p.in[24];
    if (gw < 1024) {
        const int hs = gw >> 6, dblk = (gw >> 2) & 15, jq = gw & 3, d = dblk * 64 + lane;
        const float* keys = (hs & 1) ? k2 : k1;
        f32x4 wq[32];
#pragma unroll
        for (int i = 0; i < 32; ++i) wq[i] = *(const f32x4*)(w_q + (size_t)d * 2048 + hs * 128 + i * 4);
        const float gd = g_ffn[d];
        bf16_t* WS = (bf16_t*)(ws + WS_WS);
        for (int j = jq * 32; j < jq * 32 + 32; ++j) {
            const float* kp = keys + j * 128; float s = 0.f;
#pragma unroll
            for (int i = 0; i < 32; ++i) { const f32x4 kk = *(const f32x4*)(kp + i * 4); s = fmaf(wq[i][0], kk[0], s); s = fmaf(wq[i][1], kk[1], s); s = fmaf(wq[i][2], kk[2], s); s = fmaf(wq[i][3], kk[3], s); }
            WS[(size_t)(hs * 128 + j) * D + d] = (bf16_t)(pk2bf(s * gd, 0.f) & 0xffffu);
        }
    }
    {
        LAS float* scr = (LAS float*)(lds + wave * 16384);
        constexpr int I_IN = 16 * 144, I_A = 12 * 32, I_B = 4 * 32, I_O = 16 * 32, I_G = 4 * 8, NIT = I_IN + I_A + I_B + I_O + I_G;
        for (int it = gw; it < NIT; it += NGW) {
            int r = it;
            if (r < I_IN) { const int kb = r / 144, nb = r % 144; transpose_item(w_in, IN_COLS, win_src_col(nb * 32), (bf16_t*)(ws + WS_WIN), 1024, nb * 32, kb * 64, g_mix, scr, lane); continue; } r -= I_IN;
            if (r < I_A) { const int kb = r / 32, nb = r % 32; transpose_item(w_a, 1024, nb * 32, (bf16_t*)(ws + WS_WA), 768, nb * 32, kb * 64, nullptr, scr, lane); continue; } r -= I_A;
            if (r < I_B) { const int kb = r / 32, nb = r % 32; transpose_item(w_b, 1024, nb * 32, (bf16_t*)(ws + WS_WB), 256, nb * 32, kb * 64, nullptr, scr, lane); continue; } r -= I_B;
            if (r < I_O) { const int kb = r / 32, nb = r % 32; transpose_item(w_out, 1024, nb * 32, (bf16_t*)(ws + WS_WOUT), 1024, nb * 32, kb * 64, nullptr, scr, lane); continue; } r -= I_O;
            { const int kb = r / 8, nb = r % 8; transpose_item(w_glu, 256, nb * 32, (bf16_t*)(ws + WS_WGLU), 256, nb * 32, kb * 64, nullptr, scr, lane); }
        }
    }
    {
        bf16_t* XB = (bf16_t*)(ws + WS_XB); float* RS = (float*)(ws + WS_RSTD1);
        for (int t = gw; t < T; t += NGW) {
            const float* xr = x + (size_t)t * D;
            const f32x4 a0 = *(const f32x4*)(xr + lane * 8), a1 = *(const f32x4*)(xr + lane * 8 + 4), b0 = *(const f32x4*)(xr + 512 + lane * 8), b1 = *(const f32x4*)(xr + 512 + lane * 8 + 4);
            float s = (a0[0] * a0[0] + a0[1] * a0[1]) + (a0[2] * a0[2] + a0[3] * a0[3]) + (a1[0] * a1[0] + a1[1] * a1[1]) + (a1[2] * a1[2] + a1[3] * a1[3])
                    + (b0[0] * b0[0] + b0[1] * b0[1]) + (b0[2] * b0[2] + b0[3] * b0[3]) + (b1[0] * b1[0] + b1[1] * b1[1]) + (b1[2] * b1[2] + b1[3] * b1[3]);
            s = wave_sum(s);
            if (lane == 0) RS[t] = rsqrtf(s * (1.0f / D) + RMS_EPS);
            *(u32x4*)(XB + (size_t)t * D + lane * 8) = pack8(a0, a1); *(u32x4*)(XB + (size_t)t * D + 512 + lane * 8) = pack8(b0, b1);
        }
    }
    {
        const size_t gt = (size_t)blockIdx.x * NTHR + tid, NT = (size_t)NBLK * NTHR, NI = (size_t)16384 * 1024 / 8;
        _Float16* UH = (_Float16*)(ws + WS_UH); _Float16* VH = (_Float16*)(ws + WS_VH);
        for (size_t i = gt; i < 2 * NI; i += NT) {
            const bool isv = i >= NI; const size_t e = (isv ? i - NI : i) * 8; const float* src = (isv ? ev : eu) + e;
            f32x4 a = *(const f32x4*)src, b = *(const f32x4*)(src + 4);
            if (!isv) { const int d = (int)(e & 1023); a = a * *(const f32x4*)(g_ffn + d); b = b * *(const f32x4*)(g_ffn + d + 4); }
            h2 o0 = {(_Float16)a[0], (_Float16)a[1]}, o1 = {(_Float16)a[2], (_Float16)a[3]}, o2 = {(_Float16)b[0], (_Float16)b[1]}, o3 = {(_Float16)b[2], (_Float16)b[3]};
            u32x4 w; w.x = __builtin_bit_cast(unsigned, o0); w.y = __builtin_bit_cast(unsigned, o1); w.z = __builtin_bit_cast(unsigned, o2); w.w = __builtin_bit_cast(unsigned, o3);
            *(u32x4*)((isv ? VH : UH) + e) = w;
        }
    }
    {
        const int gt = blockIdx.x * NTHR + tid;
        float* POW = (float*)(ws + WS_POW); float* BBAR = (float*)(ws + WS_BBAR);
        if (gt < 16 * 65 * 64) {
            const int g = gt / (65 * 64), d = (gt / 64) % 65, pp = gt & 63, gp = g * 64 + pp;
            const float lr = lam_re[gp], li = lam_im[gp], dt = expf(log_dt[g]);
            const float mag = expf(lr * dt * (float)d); float sn, cs; sincosf(li * dt * (float)d, &sn, &cs);
            POW[(size_t)gt * 2] = mag * cs; POW[(size_t)gt * 2 + 1] = mag * sn;
        }
        if (gt < 16 * 64 * 16) {
            const int gp = gt >> 4, g = gp >> 6;
            const float lr = lam_re[gp], li = lam_im[gp], dt = expf(log_dt[g]);
            const float mag = expf(lr * dt), ang = li * dt, ar = mag * cosf(ang), ai = mag * sinf(ang);
            const float den = lr * lr + li * li, nr = ar - 1.0f, ni = ai, kr = (nr * lr + ni * li) / den, ki = (ni * lr - nr * li) / den;
            const float br = b_re[gt], bi = b_im[gt];
            BBAR[(size_t)gt * 2] = kr * br - ki * bi; BBAR[(size_t)gt * 2 + 1] = kr * bi + ki * br;
        }
    }
}

__device__ __forceinline__ void phase_ssm_tables(const Params& p) {
    unsigned char* ws = p.ws; const float* c_re = p.in[11]; const float* c_im = p.in[12];
    const float* POW = (const float*)(ws + WS_POW); const float* BBAR = (const float*)(ws + WS_BBAR);
    float* KC = (float*)(ws + WS_KC); bf16_t* MEND = (bf16_t*)(ws + WS_MEND);
    int tid = threadIdx.x; asm volatile("" : "+v"(tid));
    const int gt = blockIdx.x * NTHR + tid, NT = NBLK * NTHR;
    for (int i = gt; i < 16 * 64 * 256; i += NT) {
        const int g = i >> 14, d = (i >> 8) & 63, h = (i >> 4) & 15, hp = i & 15;
        float s = 0.f;
        for (int pp = 0; pp < 64; ++pp) {
            const float cr = c_re[(g * 16 + h) * 64 + pp], ci = c_im[(g * 16 + h) * 64 + pp];
            const float pr = POW[((size_t)(g * 65 + d) * 64 + pp) * 2], pi = POW[((size_t)(g * 65 + d) * 64 + pp) * 2 + 1];
            const float br = BBAR[((size_t)(g * 64 + pp) * 16 + hp) * 2], bi = BBAR[((size_t)(g * 64 + pp) * 16 + hp) * 2 + 1];
            const float wr_ = cr * pr - ci * pi, wi_ = cr * pi + ci * pr;
            s += wr_ * br - wi_ * bi;
        }
        KC[i] = s;
    }
    for (int i = gt; i < 16 * 256 * 128; i += NT) {
        const int g = i >> 15, n = (i >> 7) & 255, k8 = (i & 127) * 8, jp = k8 >> 4, h0 = k8 & 15;
        u32x4 o = (u32x4){0u, 0u, 0u, 0u};
        if (n < 128) {
            const int pp = n & 63; const float pr = POW[((size_t)(g * 65 + 63 - jp) * 64 + pp) * 2], pi = POW[((size_t)(g * 65 + 63 - jp) * 64 + pp) * 2 + 1];
            float v[8];
#pragma unroll
            for (int e = 0; e < 8; ++e) { const float br = BBAR[((size_t)(g * 64 + pp) * 16 + h0 + e) * 2], bi = BBAR[((size_t)(g * 64 + pp) * 16 + h0 + e) * 2 + 1];
                v[e] = n < 64 ? pr * br - pi * bi : pr * bi + pi * br; }
            o.x = pk2bf(v[0], v[1]); o.y = pk2bf(v[2], v[3]); o.z = pk2bf(v[4], v[5]); o.w = pk2bf(v[6], v[7]);
        }
        *(u32x4*)(MEND + (size_t)i * 8) = o;
    }
}

__device__ __forceinline__ void phase_conv_my(const Params& p) {
    unsigned char* ws = p.ws; const float* conv_w = p.in[4]; const float* conv_b = p.in[5]; const float* c_re = p.in[11]; const float* c_im = p.in[12];
    const bf16_t* CB = (const bf16_t*)(ws + WS_CB); const bf16_t* V = (const bf16_t*)(ws + WS_V); bf16_t* A2 = (bf16_t*)(ws + WS_A2);
    const float* KC = (const float*)(ws + WS_KC); const float* POW = (const float*)(ws + WS_POW); bf16_t* MY = (bf16_t*)(ws + WS_MY);
    int tid = threadIdx.x; asm volatile("" : "+v"(tid));
    const int gt = blockIdx.x * NTHR + tid, NT = NBLK * NTHR;
    for (int i = gt; i < T * 96; i += NT) {
        const int t = i / 96, j8 = (i % 96) * 8, tl = t & (SEQ - 1); const size_t o = (size_t)t * CONV_CH + j8;
        const u32x4 cb = *(const u32x4*)(CB + o), v2 = *(const u32x4*)(V + o);
        u32x4 v1 = (u32x4){0u, 0u, 0u, 0u}, v0 = (u32x4){0u, 0u, 0u, 0u};
        if (tl >= 1) v1 = *(const u32x4*)(V + o - CONV_CH);
        if (tl >= 2) v0 = *(const u32x4*)(V + o - 2 * CONV_CH);
        float r[8];
#pragma unroll
        for (int e = 0; e < 8; ++e) {
            const unsigned dc = e < 2 ? cb.x : e < 4 ? cb.y : e < 6 ? cb.z : cb.w, d2 = e < 2 ? v2.x : e < 4 ? v2.y : e < 6 ? v2.z : v2.w;
            const unsigned d1 = e < 2 ? v1.x : e < 4 ? v1.y : e < 6 ? v1.z : v1.w, d0 = e < 2 ? v0.x : e < 4 ? v0.y : e < 6 ? v0.z : v0.w;
            const float fc = (e & 1) ? bfhi(dc) : bflo(dc), f2 = (e & 1) ? bfhi(d2) : bflo(d2), f1 = (e & 1) ? bfhi(d1) : bflo(d1), f0 = (e & 1) ? bfhi(d0) : bflo(d0);
            const float y = conv_b[j8 + e] + conv_w[j8 + e] * f0 + conv_w[CONV_CH + j8 + e] * f1 + conv_w[2 * CONV_CH + j8 + e] * f2;
            r[e] = fc * y;
        }
        u32x4 w; w.x = pk2bf(r[0], r[1]); w.y = pk2bf(r[2], r[3]); w.z = pk2bf(r[4], r[5]); w.w = pk2bf(r[6], r[7]);
        *(u32x4*)(A2 + o) = w;
    }
    for (int i = gt; i < 16 * 1024 * 144; i += NT) {
        const int g = i / (1024 * 144), rem = i % (1024 * 144), row = rem / 144, k8 = (rem % 144) * 8, j = row >> 4, h = row & 15;
        float v[8];
        if (k8 < 1024) {
            const int jp = k8 >> 4, h0 = k8 & 15;
            if (j >= jp) { const float* src = KC + ((size_t)(g * 64 + (j - jp)) * 16 + h) * 16 + h0;
#pragma unroll
                for (int e = 0; e < 8; ++e) v[e] = src[e]; }
            else {
#pragma unroll
                for (int e = 0; e < 8; ++e) v[e] = 0.f; }
        } else {
            const int q0 = k8 - 1024;
#pragma unroll
            for (int e = 0; e < 8; ++e) { const int q = q0 + e, pp = q & 63;
                const float cr = c_re[(g * 16 + h) * 64 + pp], ci = c_im[(g * 16 + h) * 64 + pp];
                const float pr = POW[((size_t)(g * 65 + j + 1) * 64 + pp) * 2], pi = POW[((size_t)(g * 65 + j + 1) * 64 + pp) * 2 + 1];
                v[e] = q < 64 ? cr * pr - ci * pi : -(cr * pi + ci * pr); }
        }
        u32x4 w; w.x = pk2bf(v[0], v[1]); w.y = pk2bf(v[2], v[3]); w.z = pk2bf(v[4], v[5]); w.w = pk2bf(v[6], v[7]);
        *(u32x4*)(MY + (size_t)i * 8) = w;
    }
}

__device__ __forceinline__ void phase_carry(const Params& p) {
    int tid = threadIdx.x; asm volatile("" : "+v"(tid));
    const int gt = blockIdx.x * NTHR + tid;
    if (gt >= (T / SEQ) * 1024) return;
    unsigned char* ws = p.ws; const float* POW = (const float*)(ws + WS_POW); const float* E = (const float*)(ws + WS_E); bf16_t* SU = (bf16_t*)(ws + WS_SU);
    const int b = gt >> 10, g = (gt >> 6) & 15, pp = gt & 63;
    const float ar = POW[((size_t)(g * 65 + 64) * 64 + pp) * 2], ai = POW[((size_t)(g * 65 + 64) * 64 + pp) * 2 + 1];
    float sr = 0.f, si = 0.f;
#pragma unroll 8
    for (int c = 0; c < 128; ++c) {
        const size_t ch = (size_t)g * NCHUNK + b * 128 + c;
        SU[ch * SUK + 1024 + pp] = (bf16_t)(pk2bf(sr, 0.f) & 0xffffu); SU[ch * SUK + 1088 + pp] = (bf16_t)(pk2bf(si, 0.f) & 0xffffu);
        const float er = E[ch * 128 + pp], ei = E[ch * 128 + 64 + pp];
        const float nr = ar * sr - ai * si + er, ni = ar * si + ai * sr + ei;
        sr = nr; si = ni;
    }
}

__device__ __forceinline__ void ins16(float (&a)[16], float x) {
#pragma unroll
    for (int k = 15; k >= 1; --k) a[k] = __builtin_amdgcn_fmed3f(a[k - 1], a[k], x);
    a[0] = fmaxf(a[0], x);
}
__device__ __forceinline__ void phase_topk(const Params& p, int t0, LAS unsigned char* lds) {
    unsigned char* ws = p.ws; const float* SC = (const float*)(ws + WS_SC); const float* RS2P = (const float*)(ws + WS_RS2P);
    int* EIDX = (int*)(ws + WS_EIDX); float* GATE = (float*)(ws + WS_GATE);
    int tid = threadIdx.x; asm volatile("" : "+v"(tid));
    const int lane = tid & 63, wave = __builtin_amdgcn_readfirstlane(tid >> 6), gw = blockIdx.x * NWAVE + wave;
    LAS unsigned* myl = (LAS unsigned*)(lds + tid * 32);
    const float NINF = -__builtin_inff();
    for (int item = gw; item < (T / 2) * 16 / 64; item += NGW) {
        const int L = item * 64 + lane, tl = L >> 4, hs = L & 15, t = t0 + tl, h = hs >> 1, odd = lane & 1;
        const f32x4* row = (const f32x4*)(SC + (size_t)L * 128);
        float a[16];
#pragma unroll
        for (int k = 0; k < 16; ++k) a[k] = NINF;
#pragma unroll 4
        for (int c = 0; c < 32; ++c) { const f32x4 v = row[c];
#pragma unroll
            for (int e = 0; e < 4; ++e) ins16(a, __uint_as_float((__float_as_uint(v[e]) & ~127u) | (unsigned)(c * 4 + e))); }
        float A[16], B[16];
#pragma unroll
        for (int k = 0; k < 16; ++k) { const float o = __shfl_xor(a[k], 1); A[k] = odd ? o : a[k]; B[k] = odd ? a[k] : o; }
        float f[16];
#pragma unroll
        for (int k = 0; k < 16; ++k) f[k] = NINF;
#pragma unroll
        for (int ia = 0; ia < 16; ++ia)
#pragma unroll
            for (int ib = 0; ib < 16; ++ib)
                if ((ia + 1) * (ib + 1) <= 16) ins16(f, __uint_as_float((__float_as_uint(A[ia] + B[ib]) & ~255u) | (unsigned)(ia * 16 + ib)));
        u32x4 wa, wb;
        wa.x = (__float_as_uint(A[0]) & 127u) | ((__float_as_uint(A[1]) & 127u) << 8) | ((__float_as_uint(A[2]) & 127u) << 16) | ((__float_as_uint(A[3]) & 127u) << 24);
        wa.y = (__float_as_uint(A[4]) & 127u) | ((__float_as_uint(A[5]) & 127u) << 8) | ((__float_as_uint(A[6]) & 127u) << 16) | ((__float_as_uint(A[7]) & 127u) << 24);
        wa.z = (__float_as_uint(A[8]) & 127u) | ((__float_as_uint(A[9]) & 127u) << 8) | ((__float_as_uint(A[10]) & 127u) << 16) | ((__float_as_uint(A[11]) & 127u) << 24);
        wa.w = (__float_as_uint(A[12]) & 127u) | ((__float_as_uint(A[13]) & 127u) << 8) | ((__float_as_uint(A[14]) & 127u) << 16) | ((__float_as_uint(A[15]) & 127u) << 24);
        wb.x = (__float_as_uint(B[0]) & 127u) | ((__float_as_uint(B[1]) & 127u) << 8) | ((__float_as_uint(B[2]) & 127u) << 16) | ((__float_as_uint(B[3]) & 127u) << 24);
        wb.y = (__float_as_uint(B[4]) & 127u) | ((__float_as_uint(B[5]) & 127u) << 8) | ((__float_as_uint(B[6]) & 127u) << 16) | ((__float_as_uint(B[7]) & 127u) << 24);
        wb.z = (__float_as_uint(B[8]) & 127u) | ((__float_as_uint(B[9]) & 127u) << 8) | ((__float_as_uint(B[10]) & 127u) << 16) | ((__float_as_uint(B[11]) & 127u) << 24);
        wb.w = (__float_as_uint(B[12]) & 127u) | ((__float_as_uint(B[13]) & 127u) << 8) | ((__float_as_uint(B[14]) & 127u) << 16) | ((__float_as_uint(B[15]) & 127u) << 24);
        *(LAS u32x4*)myl = wa; *(LAS u32x4*)(myl + 4) = wb;
        float ssq = 0.f;
#pragma unroll
        for (int q = 0; q < 4; ++q) { const f32x4 pv = *(const f32x4*)(RS2P + (size_t)t * 16 + q * 4); ssq += (pv[0] + pv[1]) + (pv[2] + pv[3]); }
        const float rs = rsqrtf(ssq * (1.0f / D) + RMS_EPS);
        float ex[16], sum = 0.f;
#pragma unroll
        for (int k = 0; k < 16; ++k) { ex[k] = __expf(rs * (f[k] - f[0])); sum += ex[k]; }
        const float inv = 1.0f / sum;
        int eo[8]; float go[8]; const unsigned omask = odd ? 0xffffffffu : 0u;
        const LAS unsigned char* mb = (const LAS unsigned char*)myl;
#pragma unroll
        for (int r = 0; r < 8; ++r) {
            const unsigned code = ((__float_as_uint(f[8 + r]) & omask) | (__float_as_uint(f[r]) & ~omask)) & 255u;
            const unsigned i1 = mb[code >> 4], i2 = mb[16 + (code & 15u)];
            eo[r] = (int)(i1 * 128u + i2); go[r] = __uint_as_float((__float_as_uint(ex[8 + r]) & omask) | (__float_as_uint(ex[r]) & ~omask)) * inv;
        }
        const size_t ob = ((size_t)t * 8 + h) * 16 + odd * 8;
        *(int4*)(EIDX + ob) = make_int4(eo[0], eo[1], eo[2], eo[3]); *(int4*)(EIDX + ob + 4) = make_int4(eo[4], eo[5], eo[6], eo[7]);
        *(f32x4*)(GATE + ob) = (f32x4){go[0], go[1], go[2], go[3]}; *(f32x4*)(GATE + ob + 4) = (f32x4){go[4], go[5], go[6], go[7]};
    }
}

__device__ __forceinline__ h2 as_h2(unsigned v) { return __builtin_bit_cast(h2, v); }
__device__ __forceinline__ float dot8h(const u32x4 a, const u32x4 b, float s) {
    s = __builtin_amdgcn_fdot2(as_h2(a.x), as_h2(b.x), s, false);
    s = __builtin_amdgcn_fdot2(as_h2(a.y), as_h2(b.y), s, false);
    s = __builtin_amdgcn_fdot2(as_h2(a.z), as_h2(b.z), s, false);
    s = __builtin_amdgcn_fdot2(as_h2(a.w), as_h2(b.w), s, false);
    return s;
}
__device__ __forceinline__ u32x4 bf8_to_h8(const u32x4 v) {
    u32x4 o; h2 t;
    t = (h2){(_Float16)bflo(v.x), (_Float16)bfhi(v.x)}; o.x = __builtin_bit_cast(unsigned, t);
    t = (h2){(_Float16)bflo(v.y), (_Float16)bfhi(v.y)}; o.y = __builtin_bit_cast(unsigned, t);
    t = (h2){(_Float16)bflo(v.z), (_Float16)bfhi(v.z)}; o.z = __builtin_bit_cast(unsigned, t);
    t = (h2){(_Float16)bflo(v.w), (_Float16)bfhi(v.w)}; o.w = __builtin_bit_cast(unsigned, t);
    return o;
}
__device__ __forceinline__ void axpy8h(float (&acc)[8], const u32x4 v, float w) {
    const h2 p0 = as_h2(v.x), p1 = as_h2(v.y), p2 = as_h2(v.z), p3 = as_h2(v.w);
    acc[0] = fmaf((float)p0[0], w, acc[0]); acc[1] = fmaf((float)p0[1], w, acc[1]); acc[2] = fmaf((float)p1[0], w, acc[2]); acc[3] = fmaf((float)p1[1], w, acc[3]);
    acc[4] = fmaf((float)p2[0], w, acc[4]); acc[5] = fmaf((float)p2[1], w, acc[5]); acc[6] = fmaf((float)p3[0], w, acc[6]); acc[7] = fmaf((float)p3[1], w, acc[7]);
}
#define LANE_OF(j) ((((j) >> 3) & 1) * 32 + (((j) >> 2) & 1) * 16 + (((j) >> 1) & 1) * 8 + ((j) & 1) * 4)
__device__ __forceinline__ void phase_expert(const Params& p) {
    unsigned char* ws = p.ws;
    const bf16_t* X1B = (const bf16_t*)(ws + WS_X1B); const float* X1 = (const float*)(ws + WS_X1); const float* RS2P = (const float*)(ws + WS_RS2P);
    const int* EIDX = (const int*)(ws + WS_EIDX); const float* GATE = (const float*)(ws + WS_GATE);
    const _Float16* UH = (const _Float16*)(ws + WS_UH); const _Float16* VH = (const _Float16*)(ws + WS_VH);
    const float* gfin = p.in[25]; float* out = p.out;
    int tid = threadIdx.x; asm volatile("" : "+v"(tid));
    const int lane = tid & 63, wave = __builtin_amdgcn_readfirstlane(tid >> 6), gw = blockIdx.x * NWAVE + wave;
    const int jl = ((lane >> 5) & 1) * 8 + ((lane >> 4) & 1) * 4 + ((lane >> 3) & 1) * 2 + ((lane >> 2) & 1);
    const bool b32 = lane & 32, b16 = lane & 16, b8 = lane & 8, b4 = lane & 4;
    for (int t = gw; t < T; t += NGW) {
        const u32x4 xh0 = bf8_to_h8(*(const u32x4*)(X1B + (size_t)t * D + lane * 8)), xh1 = bf8_to_h8(*(const u32x4*)(X1B + (size_t)t * D + 512 + lane * 8));
        float ssq = (lane < 16) ? RS2P[(size_t)t * 16 + lane] : 0.f; ssq = wave_sum(ssq);
        const float rs = rsqrtf(ssq * (1.0f / D) + RMS_EPS);
        float acc0[8], acc1[8];
#pragma unroll
        for (int e = 0; e < 8; ++e) { acc0[e] = 0.f; acc1[e] = 0.f; }
        for (int b = 0; b < 8; ++b) {
            const int eb = EIDX[(size_t)t * 128 + b * 16 + jl]; const float gb = GATE[(size_t)t * 128 + b * 16 + jl];
            float pd[16];
#pragma unroll
            for (int j = 0; j < 16; ++j) { const int e = __builtin_amdgcn_readlane(eb, LANE_OF(j)); const _Float16* ur = UH + (size_t)e * D;
                const u32x4 u0 = *(const u32x4*)(ur + lane * 8), u1 = *(const u32x4*)(ur + 512 + lane * 8);
                pd[j] = dot8h(u1, xh1, dot8h(u0, xh0, 0.f)); }
            float q8[8], q4[4], q2[2];
#pragma unroll
            for (int j = 0; j < 8; ++j) { const float keep = b32 ? pd[8 + j] : pd[j], send = b32 ? pd[j] : pd[8 + j]; q8[j] = keep + __shfl_xor(send, 32); }
#pragma unroll
            for (int j = 0; j < 4; ++j) { const float keep = b16 ? q8[4 + j] : q8[j], send = b16 ? q8[j] : q8[4 + j]; q4[j] = keep + __shfl_xor(send, 16); }
#pragma unroll
            for (int j = 0; j < 2; ++j) { const float keep = b8 ? q4[2 + j] : q4[j], send = b8 ? q4[j] : q4[2 + j]; q2[j] = keep + __shfl_xor(send, 8); }
            float hsum; { const float keep = b4 ? q2[1] : q2[0], send = b4 ? q2[0] : q2[1]; hsum = keep + __shfl_xor(send, 4); }
            hsum += __shfl_xor(hsum, 2); hsum += __shfl_xor(hsum, 1);
            DBGC(if (t < 2048 && (lane & 3) == 0) ((float*)(ws + DBH_OFF))[(size_t)t * 128 + b * 16 + jl] = rs * hsum;)
            const float wv = gb * gelu_exact(rs * hsum);
#pragma unroll
            for (int j = 0; j < 16; ++j) { const int e = __builtin_amdgcn_readlane(eb, LANE_OF(j)); const float w = __uint_as_float((unsigned)__builtin_amdgcn_readlane((int)__float_as_uint(wv), LANE_OF(j))); const _Float16* vr = VH + (size_t)e * D;
                const u32x4 v0 = *(const u32x4*)(vr + lane * 8), v1 = *(const u32x4*)(vr + 512 + lane * 8);
                axpy8h(acc0, v0, w); axpy8h(acc1, v1, w); }
        }
        const float* xr = X1 + (size_t)t * D;
        const f32x4 r00 = *(const f32x4*)(xr + lane * 8), r01 = *(const f32x4*)(xr + lane * 8 + 4), r10 = *(const f32x4*)(xr + 512 + lane * 8), r11 = *(const f32x4*)(xr + 512 + lane * 8 + 4);
        float ss = 0.f;
#pragma unroll
        for (int e = 0; e < 4; ++e) { acc0[e] += r00[e]; acc0[4 + e] += r01[e]; acc1[e] += r10[e]; acc1[4 + e] += r11[e]; }
#pragma unroll
        for (int e = 0; e < 8; ++e) ss += acc0[e] * acc0[e] + acc1[e] * acc1[e];
        ss = wave_sum(ss);
        const float r = rsqrtf(ss * (1.0f / D) + RMS_EPS);
        const f32x4 g00 = *(const f32x4*)(gfin + lane * 8), g01 = *(const f32x4*)(gfin + lane * 8 + 4), g10 = *(const f32x4*)(gfin + 512 + lane * 8), g11 = *(const f32x4*)(gfin + 512 + lane * 8 + 4);
        float* orow = out + (size_t)t * D;
        *(f32x4*)(orow + lane * 8) = (f32x4){acc0[0] * r * g00[0], acc0[1] * r * g00[1], acc0[2] * r * g00[2], acc0[3] * r * g00[3]};
        *(f32x4*)(orow + lane * 8 + 4) = (f32x4){acc0[4] * r * g01[0], acc0[5] * r * g01[1], acc0[6] * r * g01[2], acc0[7] * r * g01[3]};
        *(f32x4*)(orow + 512 + lane * 8) = (f32x4){acc1[0] * r * g10[0], acc1[1] * r * g10[1], acc1[2] * r * g10[2], acc1[3] * r * g10[3]};
        *(f32x4*)(orow + 512 + lane * 8 + 4) = (f32x4){acc1[4] * r * g11[0], acc1[5] * r * g11[1], acc1[6] * r * g11[2], acc1[7] * r * g11[3]};
    }
}


#if DBG
constexpr int SSM_CH = 256, SSM_GROUPS = 16, SSM_STATE = 64, SSM_GROUP = 16;
constexpr int PEER_HEADS = 8, PEER_KEYS = 128, PEER_HALF = 128, PEER_TOPK = 16, PEER_QD = 2048;
__device__ __forceinline__ float sigm_n(float v) { return 1.0f / (1.0f + expf(-v)); }
__global__ void __launch_bounds__(256) ngemm(const float* __restrict__ A, int lda, const float* __restrict__ B, int ldb,
                                             float* __restrict__ C, int ldc, int M, int N, int K) {
    __shared__ float As[16][64 + 4];
    __shared__ float Bs[16][64 + 4];
    const int tx = threadIdx.x & 15, ty = threadIdx.x >> 4;
    const int bm = blockIdx.y * 64, bn = blockIdx.x * 64;
    float acc[4][4] = {};
    for (int k0 = 0; k0 < K; k0 += 16) {
        {
            const int r = threadIdx.x >> 2, c4 = (threadIdx.x & 3) * 4;
            const float4 v = *(const float4*)(A + (size_t)(bm + r) * lda + k0 + c4);
            As[c4 + 0][r] = v.x; As[c4 + 1][r] = v.y; As[c4 + 2][r] = v.z; As[c4 + 3][r] = v.w;
            const int rb = threadIdx.x >> 4, cb4 = (threadIdx.x & 15) * 4;
            const float4 w = *(const float4*)(B + (size_t)(k0 + rb) * ldb + bn + cb4);
            Bs[rb][cb4 + 0] = w.x; Bs[rb][cb4 + 1] = w.y; Bs[rb][cb4 + 2] = w.z; Bs[rb][cb4 + 3] = w.w;
        }
        __syncthreads();
#pragma unroll
        for (int k = 0; k < 16; ++k) {
            float a[4], b[4];
#pragma unroll
            for (int i = 0; i < 4; ++i) a[i] = As[k][ty * 4 + i];
#pragma unroll
            for (int j = 0; j < 4; ++j) b[j] = Bs[k][tx * 4 + j];
#pragma unroll
            for (int i = 0; i < 4; ++i)
#pragma unroll
                for (int j = 0; j < 4; ++j) acc[i][j] = fmaf(a[i], b[j], acc[i][j]);
        }
        __syncthreads();
    }
#pragma unroll
    for (int i = 0; i < 4; ++i) {
        float4 o = make_float4(acc[i][0], acc[i][1], acc[i][2], acc[i][3]);
        *(float4*)(C + (size_t)(bm + ty * 4 + i) * ldc + bn + tx * 4) = o;
    }
}

__global__ void __launch_bounds__(256) n_rmsnorm(const float* __restrict__ x, const float* __restrict__ g, float* __restrict__ y) {
    __shared__ float red[4];
    const size_t row = blockIdx.x;
    const float4 v = *(const float4*)(x + row * D + threadIdx.x * 4);
    float s = v.x * v.x + v.y * v.y + v.z * v.z + v.w * v.w;
    for (int o = 32; o > 0; o >>= 1) s += __shfl_xor(s, o);
    if ((threadIdx.x & 63) == 0) red[threadIdx.x >> 6] = s;
    __syncthreads();
    const float tot = red[0] + red[1] + red[2] + red[3];
    const float r = rsqrtf(tot * (1.0f / D) + RMS_EPS);
    const float4 gg = *(const float4*)(g + threadIdx.x * 4);
    float4 o = make_float4(v.x * r * gg.x, v.y * r * gg.y, v.z * r * gg.z, v.w * r * gg.w);
    *(float4*)(y + row * D + threadIdx.x * 4) = o;
}

__global__ void __launch_bounds__(256) n_conv(const float* __restrict__ proj, const float* __restrict__ cw, const float* __restrict__ cbias,
                                              float* __restrict__ am, int S) {
    const size_t i = (size_t)blockIdx.x * 256 + threadIdx.x;
    const int t = (int)(i / CONV_CH), j = (int)(i % CONV_CH);
    if (t >= S) return;
    const float* pr = proj + (size_t)t * IN_COLS;
    float y = cbias[j];
#pragma unroll
    for (int k = 0; k < 3; ++k) {
        const int tt = t - 2 + k;
        if (tt >= 0) { const float* q = proj + (size_t)tt * IN_COLS; y += cw[k * CONV_CH + j] * (q[CONV_CH + j] * q[2 * CONV_CH + j]); }
    }
    am[(size_t)t * CONV_CH + j] = pr[j] * y;
}

__global__ void n_ssm_const(const float* lam_re, const float* lam_im, const float* log_dt, float* cst) {
    const int i = blockIdx.x * blockDim.x + threadIdx.x;
    if (i >= 1024) return;
    const int g = i >> 6;
    const float lr = lam_re[i], li = lam_im[i], dt = expf(log_dt[g]);
    const float mag = expf(lr * dt), ang = li * dt;
    const float ar = mag * cosf(ang), ai = mag * sinf(ang);
    const float den = lr * lr + li * li, nr = ar - 1.0f, ni = ai;
    cst[i] = ar; cst[1024 + i] = ai; cst[2048 + i] = (nr * lr + ni * li) / den; cst[3072 + i] = (ni * lr - nr * li) / den;
}
__global__ void __launch_bounds__(256) n_ssm_x(const float* __restrict__ proj, const float* __restrict__ bre, const float* __restrict__ bim,
                                               const float* __restrict__ cst, float* __restrict__ xr, float* __restrict__ xi, int S) {
    const size_t i = (size_t)blockIdx.x * 256 + threadIdx.x;
    const int t = (int)(i >> 10), gp = (int)(i & 1023), g = gp >> 6;
    if (t >= S) return;
    const float* u = proj + (size_t)t * IN_COLS + 3 * CONV_CH + g * 16;
    float br = 0.f, bi = 0.f;
#pragma unroll
    for (int h = 0; h < 16; ++h) { br = fmaf(u[h], bre[gp * 16 + h], br); bi = fmaf(u[h], bim[gp * 16 + h], bi); }
    const float kr = cst[2048 + gp], ki = cst[3072 + gp];
    xr[i] = kr * br - ki * bi; xi[i] = kr * bi + ki * br;
}
__global__ void __launch_bounds__(256) n_ssm_scan(const float* __restrict__ cst, float* __restrict__ xr, float* __restrict__ xi, int S) {
    const int gp = blockIdx.x * 256 + threadIdx.x;
    const float ar = cst[gp], ai = cst[1024 + gp];
    float sr = 0.f, si = 0.f;
    for (int t = 0; t < S; ++t) {
        const size_t o = (size_t)t * 1024 + gp;
        const float a = xr[o], b = xi[o];
        const float nr = ar * sr - ai * si + a, ni = ar * si + ai * sr + b;
        sr = nr; si = ni; xr[o] = sr; xi[o] = si;
    }
}
__global__ void __launch_bounds__(256) n_ssm_y(const float* __restrict__ proj, const float* __restrict__ sr, const float* __restrict__ si,
                                               const float* __restrict__ cre, const float* __restrict__ cim, const float* __restrict__ dsk,
                                               float* __restrict__ z, int S) {
    const size_t i = (size_t)blockIdx.x * 256 + threadIdx.x;
    const int t = (int)(i >> 8), c = (int)(i & 255), g = c >> 4;
    if (t >= S) return;
    const float* a = sr + (size_t)t * 1024 + g * 64; const float* b = si + (size_t)t * 1024 + g * 64;
    float y = 0.f;
    for (int p = 0; p < 64; ++p) y += a[p] * cre[c * 64 + p] - b[p] * cim[c * 64 + p];
    y += dsk[c] * proj[(size_t)t * IN_COLS + 3 * CONV_CH + c];
    z[i] = gelu_exact(y);
}
__global__ void __launch_bounds__(256) n_glu(const float* __restrict__ z, const float* __restrict__ lin, const float* __restrict__ bglu, float* __restrict__ o, size_t n) {
    const size_t i = (size_t)blockIdx.x * 256 + threadIdx.x; if (i >= n) return;
    o[i] = z[i] * sigm_n(lin[i] + bglu[i & 255]);
}
__global__ void __launch_bounds__(256) n_merge(const float* __restrict__ proj, const float* __restrict__ bg, const float* __restrict__ ya,
                                               const float* __restrict__ yb, float* __restrict__ m, size_t n) {
    const size_t i = (size_t)blockIdx.x * 256 + threadIdx.x; if (i >= n) return;
    const size_t t = i >> 10; const int d = (int)(i & 1023);
    const float* gl = proj + t * IN_COLS + 3 * CONV_CH + SSM_CH;
    m[i] = sigm_n(gl[d] + bg[d]) * ya[i] + sigm_n(gl[D + d] + bg[D + d]) * yb[i];
}
__global__ void __launch_bounds__(256) n_add(const float* __restrict__ a, float* __restrict__ b, size_t n) {
    const size_t i = (size_t)blockIdx.x * 256 + threadIdx.x; if (i >= n) return; b[i] += a[i];
}

__device__ __forceinline__ void wave_argmax(float& v, int& idx) {
    for (int o = 32; o > 0; o >>= 1) {
        const float ov = __shfl_xor(v, o); const int oi = __shfl_xor(idx, o);
        if (ov > v || (ov == v && oi < idx)) { v = ov; idx = oi; }
    }
}
__global__ void __launch_bounds__(256) n_route(const float* __restrict__ q, const float* __restrict__ k1, const float* __restrict__ k2,
                                               int* __restrict__ eidx, float* __restrict__ gate) {
    __shared__ float qs[PEER_QD];
    __shared__ float sc[PEER_QD];
    __shared__ float tv[16][16]; __shared__ int ti[16][16];
    const size_t t = blockIdx.x; const int tid = threadIdx.x, lane = tid & 63, w = tid >> 6;
    for (int i = tid; i < PEER_QD; i += 256) qs[i] = q[t * PEER_QD + i];
    __syncthreads();
    for (int i = tid; i < PEER_QD; i += 256) {
        const int hs = i >> 7, n = i & 127, side = hs & 1;
        const float* kk = (side ? k2 : k1) + n * PEER_HALF; const float* qq = qs + hs * 128;
        float s = 0.f;
        for (int k = 0; k < 128; ++k) s = fmaf(qq[k], kk[k], s);
        sc[i] = s;
    }
    __syncthreads();
    for (int gi = 0; gi < 4; ++gi) {
        const int grp = w * 4 + gi;
        float a0 = sc[grp * 128 + lane], a1 = sc[grp * 128 + 64 + lane];
        for (int it = 0; it < 16; ++it) {
            float v; int idx;
            if (a0 >= a1) { v = a0; idx = lane; } else { v = a1; idx = lane + 64; }
            wave_argmax(v, idx);
            if (lane == 0) { tv[grp][it] = v; ti[grp][it] = idx; }
            if (idx == lane) a0 = -INFINITY; if (idx == lane + 64) a1 = -INFINITY;
        }
    }
    __syncthreads();
    for (int hh = 0; hh < 2; ++hh) {
        const int h = w * 2 + hh;
        float c[4]; int ci[4];
#pragma unroll
        for (int j = 0; j < 4; ++j) { const int pos = j * 64 + lane, a = pos >> 4, b = pos & 15; c[j] = tv[2 * h][a] + tv[2 * h + 1][b]; ci[j] = pos; }
        float bestv = 0.f; int beste = 0; float mx = 0.f;
        for (int it = 0; it < 16; ++it) {
            float v = c[0]; int idx = ci[0];
#pragma unroll
            for (int j = 1; j < 4; ++j) if (c[j] > v) { v = c[j]; idx = ci[j]; }
            wave_argmax(v, idx);
#pragma unroll
            for (int j = 0; j < 4; ++j) if (ci[j] == idx) c[j] = -INFINITY;
            if (it == 0) mx = v;
            if (lane == it) { bestv = v; beste = ti[2 * h][idx >> 4] * PEER_KEYS + ti[2 * h + 1][idx & 15]; }
        }
        float e = (lane < 16) ? expf(bestv - mx) : 0.f;
        float s = e; for (int o = 32; o > 0; o >>= 1) s += __shfl_xor(s, o);
        if (lane < 16) { eidx[t * 128 + h * 16 + lane] = beste; gate[t * 128 + h * 16 + lane] = e / s; }
    }
}

__global__ void __launch_bounds__(256) n_expert(const float* __restrict__ xn, const float* __restrict__ x1, const int* __restrict__ eidx,
                                                const float* __restrict__ gate, const float* __restrict__ eu, const float* __restrict__ ev,
                                                const float* __restrict__ gfin, float* __restrict__ out) {
    const size_t t = (size_t)blockIdx.x * 4 + (threadIdx.x >> 6); const int lane = threadIdx.x & 63;
    float4 xv[4], acc[4];
#pragma unroll
    for (int i = 0; i < 4; ++i) { xv[i] = *(const float4*)(xn + t * D + i * 256 + lane * 4); acc[i] = make_float4(0.f, 0.f, 0.f, 0.f); }
    for (int k = 0; k < 128; ++k) {
        const int e = eidx[t * 128 + k]; const float gt = gate[t * 128 + k];
        const float* ur = eu + (size_t)e * D; const float* vr = ev + (size_t)e * D;
        float s = 0.f;
#pragma unroll
        for (int i = 0; i < 4; ++i) { const float4 u = *(const float4*)(ur + i * 256 + lane * 4); s += u.x * xv[i].x + u.y * xv[i].y + u.z * xv[i].z + u.w * xv[i].w; }
        for (int o = 32; o > 0; o >>= 1) s += __shfl_xor(s, o);
        const float wgt = gt * gelu_exact(s);
#pragma unroll
        for (int i = 0; i < 4; ++i) { const float4 v = *(const float4*)(vr + i * 256 + lane * 4);
            acc[i].x = fmaf(wgt, v.x, acc[i].x); acc[i].y = fmaf(wgt, v.y, acc[i].y); acc[i].z = fmaf(wgt, v.z, acc[i].z); acc[i].w = fmaf(wgt, v.w, acc[i].w); }
    }
    float ss = 0.f;
#pragma unroll
    for (int i = 0; i < 4; ++i) { const float4 r = *(const float4*)(x1 + t * D + i * 256 + lane * 4);
        acc[i].x += r.x; acc[i].y += r.y; acc[i].z += r.z; acc[i].w += r.w;
        ss += acc[i].x * acc[i].x + acc[i].y * acc[i].y + acc[i].z * acc[i].z + acc[i].w * acc[i].w; }
    for (int o = 32; o > 0; o >>= 1) ss += __shfl_xor(ss, o);
    const float r = rsqrtf(ss * (1.0f / D) + RMS_EPS);
#pragma unroll
    for (int i = 0; i < 4; ++i) { const float4 g = *(const float4*)(gfin + i * 256 + lane * 4);
        *(float4*)(out + t * D + i * 256 + lane * 4) = make_float4(acc[i].x * r * g.x, acc[i].y * r * g.y, acc[i].z * r * g.z, acc[i].w * r * g.w); }
}


__device__ __forceinline__ float bf_at(const bf16_t* p, size_t i) { return __uint_as_float(((unsigned)p[i]) << 16); }
template <class F> __device__ __forceinline__ void dbg_cmp(unsigned char* ws, int id, int rows, int cols, F f) {
    float e2 = 0.f, r2 = 0.f;
    const size_t n = (size_t)rows * cols;
    int tid = threadIdx.x; asm volatile("" : "+v"(tid));
    for (size_t i = (size_t)blockIdx.x * NTHR + tid; i < n; i += (size_t)NBLK * NTHR) { float a, b; f((int)(i / cols), (int)(i % cols), a, b); e2 += (a - b) * (a - b); r2 += b * b; }
    e2 = wave_sum(e2); r2 = wave_sum(r2);
    if ((tid & 63) == 0) { atomicAdd((float*)(ws + DB_ACC) + id * 2, e2); atomicAdd((float*)(ws + DB_ACC) + id * 2 + 1, r2); }
}
__global__ void dbg_report(const float* acc, float* out, int n, int first_id) {
    float c = 0.f;
    for (int id = first_id; id < 32; ++id) { const float e2 = acc[id * 2], r2 = acc[id * 2 + 1]; if (r2 <= 0.f) continue; const float rel = sqrtf(e2 / r2);
        const float thr = id == 12 ? 0.22f : id == 13 ? 0.1f : 0.03f;
        if (rel > thr || !(rel == rel)) { int d = (rel == rel) ? (int)(-4.0f * log10f(fminf(rel, 1.0f)) + 0.5f) : 9; if (d > 9) d = 9; c = sqrtf((float)(id * 10 + d) - 1.0f); break; } }
    for (int i = blockIdx.x * blockDim.x + threadIdx.x; i < n; i += gridDim.x * blockDim.x) out[i] = c;
}
#endif
__global__ void __launch_bounds__(512, 2) fwd_megakernel(Params p) {
    extern __shared__ __attribute__((aligned(16))) unsigned char smem[];
    LAS unsigned char* lds = (LAS unsigned char*)smem;
    unsigned char* ws = p.ws;
    volatile LAS unsigned* bst = (volatile LAS unsigned*)(lds + LDS_MISC);
    if (threadIdx.x < 4) bst[threadIdx.x] = 0u;
    __syncthreads();
    XcdBarrier bar = xcd_barrier_post((unsigned*)(ws + WS_CTL), bst);
    Order S;
    phase_prologue(p, lds);
    xcd_barrier(bar);
    phase_ssm_tables(p);
    { Gemm g{(const bf16_t*)(ws + WS_XB), (const bf16_t*)(ws + WS_WIN), 1024, 1024, 1024, 0, 0}; S.init(T, IN_COLS, 1, 0);
      EpiG1 e{(const float*)(ws + WS_RSTD1), p.in[3], (bf16_t*)(ws + WS_CB), (bf16_t*)(ws + WS_V), (bf16_t*)(ws + WS_SU), (bf16_t*)(ws + WS_G)};
      gemm_phase(lds, g, S, e); }
    xcd_barrier(bar);
    DBGC({ const float* pj = (const float*)(ws + DB_PROJ); const float* bg = p.in[3];
      const bf16_t* CBp = (const bf16_t*)(ws + WS_CB); const bf16_t* Vp = (const bf16_t*)(ws + WS_V); const bf16_t* SUp = (const bf16_t*)(ws + WS_SU); const bf16_t* Gp = (const bf16_t*)(ws + WS_G);
      dbg_cmp(ws, 1, NB, 768, [=](int t, int c, float& a, float& b) { a = bf_at(CBp, (size_t)t * 768 + c); b = pj[(size_t)t * IN_COLS + c]; });
      dbg_cmp(ws, 2, NB, 768, [=](int t, int c, float& a, float& b) { a = bf_at(Vp, (size_t)t * 768 + c); b = pj[(size_t)t * IN_COLS + 768 + c] * pj[(size_t)t * IN_COLS + 1536 + c]; });
      dbg_cmp(ws, 3, NB, 256, [=](int t, int c, float& a, float& b) { a = bf_at(SUp, ((size_t)(c >> 4) * NCHUNK + (t >> 6)) * SUK + (t & 63) * 16 + (c & 15)); b = pj[(size_t)t * IN_COLS + 2304 + c]; });
      dbg_cmp(ws, 4, NB, 2048, [=](int t, int c, float& a, float& b) { a = bf_at(Gp, (size_t)t * 2048 + c); b = sigm_n(pj[(size_t)t * IN_COLS + 2560 + c] + bg[c]); }); })
    phase_conv_my(p);
    { Gemm g{(const bf16_t*)(ws + WS_SU), (const bf16_t*)(ws + WS_MEND), SUK, 1024, 1024, (long)NCHUNK * SUK, (long)256 * 1024}; S.init(NCHUNK, 256, 16, 0);
      EpiE e{(float*)(ws + WS_E)}; gemm_phase(lds, g, S, e); }
    xcd_barrier(bar);
    DBGC({ const bf16_t* A2p = (const bf16_t*)(ws + WS_A2); const float* am = (const float*)(ws + DB_AM);
      dbg_cmp(ws, 5, NB, 768, [=](int t, int c, float& a, float& b) { a = bf_at(A2p, (size_t)t * 768 + c); b = am[(size_t)t * 768 + c]; }); })
    phase_carry(p);
    { Gemm g{(const bf16_t*)(ws + WS_A2), (const bf16_t*)(ws + WS_WA), 768, 768, 768, 0, 0}; S.init(T, 1024, 1, 0);
      EpiP e{(const bf16_t*)(ws + WS_G), (bf16_t*)(ws + WS_P)}; gemm_phase(lds, g, S, e); }
    xcd_barrier(bar);
    DBGC({ const bf16_t* Pp = (const bf16_t*)(ws + WS_P); const float* ya = (const float*)(ws + DB_YA); const float* pj = (const float*)(ws + DB_PROJ); const float* bg = p.in[3];
      dbg_cmp(ws, 6, NB, 1024, [=](int t, int c, float& a, float& b) { a = bf_at(Pp, (size_t)t * 1024 + c); b = ya[(size_t)t * 1024 + c] * sigm_n(pj[(size_t)t * IN_COLS + 2560 + c] + bg[c]); }); })
    { Gemm g{(const bf16_t*)(ws + WS_SU), (const bf16_t*)(ws + WS_MY), SUK, SUK, SUK, (long)NCHUNK * SUK, (long)1024 * SUK}; S.init(NCHUNK, 1024, 16, 0);
      EpiY e{(const bf16_t*)(ws + WS_SU), p.in[13], (bf16_t*)(ws + WS_Z)}; gemm_phase(lds, g, S, e); }
    xcd_barrier(bar);
    DBGC({ const bf16_t* Zp = (const bf16_t*)(ws + WS_Z); const float* zn = (const float*)(ws + DB_Z);
      dbg_cmp(ws, 7, NB, 256, [=](int t, int c, float& a, float& b) { a = bf_at(Zp, (size_t)t * 256 + c); b = zn[(size_t)t * 256 + c]; }); })
    { Gemm g{(const bf16_t*)(ws + WS_Z), (const bf16_t*)(ws + WS_WGLU), 256, 256, 256, 0, 0}; S.init(T, 256, 1, 0);
      EpiGlu e{(const bf16_t*)(ws + WS_Z), p.in[15], (bf16_t*)(ws + WS_S5)}; gemm_phase(lds, g, S, e); }
    xcd_barrier(bar);
    DBGC({ const bf16_t* Sp = (const bf16_t*)(ws + WS_S5); const float* sn = (const float*)(ws + DB_S5);
      dbg_cmp(ws, 8, NB, 256, [=](int t, int c, float& a, float& b) { a = bf_at(Sp, (size_t)t * 256 + c); b = sn[(size_t)t * 256 + c]; }); })
    { Gemm g{(const bf16_t*)(ws + WS_S5), (const bf16_t*)(ws + WS_WB), 256, 256, 256, 0, 0}; S.init(T, 1024, 1, 0);
      EpiMerge e{(const bf16_t*)(ws + WS_G), (const bf16_t*)(ws + WS_P), (bf16_t*)(ws + WS_MG)}; gemm_phase(lds, g, S, e); }
    xcd_barrier(bar);
    DBGC({ const bf16_t* Mp = (const bf16_t*)(ws + WS_MG); const float* mn = (const float*)(ws + DB_MG);
      dbg_cmp(ws, 9, NB, 1024, [=](int t, int c, float& a, float& b) { a = bf_at(Mp, (size_t)t * 1024 + c); b = mn[(size_t)t * 1024 + c]; }); })
    { Gemm g{(const bf16_t*)(ws + WS_MG), (const bf16_t*)(ws + WS_WOUT), 1024, 1024, 1024, 0, 0}; S.init(T, 1024, 1, 0);
      EpiX1 e{p.in[0], (float*)(ws + WS_X1), (bf16_t*)(ws + WS_X1B), (float*)(ws + WS_RS2P)}; gemm_phase(lds, g, S, e); }
    xcd_barrier(bar);
    DBGC({ const float* Xp = (const float*)(ws + WS_X1); const float* xn1 = (const float*)(ws + DB_X1);
      dbg_cmp(ws, 10, NB, 1024, [=](int t, int c, float& a, float& b) { a = Xp[(size_t)t * 1024 + c]; b = xn1[(size_t)t * 1024 + c]; }); })
    for (int half = 0; half < 2; ++half) {
        { Gemm g{(const bf16_t*)(ws + WS_X1B), (const bf16_t*)(ws + WS_WS), 1024, 1024, 1024, 0, 0}; S.init(T / 2, 2048, 1, half * (T / 2 / BM));
          EpiSC e{(float*)(ws + WS_SC), half * (T / 2)}; gemm_phase(lds, g, S, e); }
        xcd_barrier(bar);
        DBGC(if (half == 0) { const float* SCp = (const float*)(ws + WS_SC); const float* qn = (const float*)(ws + DB_Q); const float* RSp = (const float*)(ws + WS_RS2P); const float* kk1 = p.in[21]; const float* kk2 = p.in[22];
          dbg_cmp(ws, 11, NB, 2048, [=](int t, int c, float& a, float& b) { float ss = 0.f; for (int i = 0; i < 16; ++i) ss += RSp[(size_t)t * 16 + i];
            a = SCp[(size_t)t * 2048 + c] * rsqrtf(ss * (1.0f / D) + RMS_EPS); const int hs = c >> 7, j = c & 127; const float* kp = ((hs & 1) ? kk2 : kk1) + j * 128; const float* qq = qn + (size_t)t * 2048 + hs * 128;
            float sr = 0.f; for (int k = 0; k < 128; ++k) sr += qq[k] * kp[k]; b = sr; }); })
        phase_topk(p, half * (T / 2), lds);
        xcd_barrier(bar);
        DBGC(if (half == 0) { const int* Ep = (const int*)(ws + WS_EIDX); const int* En = (const int*)(ws + DB_EIDX); const float* Gp2 = (const float*)(ws + WS_GATE); const float* Gn = (const float*)(ws + DB_GATE);
          dbg_cmp(ws, 12, NB, 128, [=](int t, int c, float& a, float& b) { const int e = Ep[(size_t)t * 128 + c]; const int* nn = En + (size_t)t * 128 + (c & ~15); int f = 0; for (int k = 0; k < 16; ++k) f |= (nn[k] == e); a = f ? 1.f : 0.f; b = 1.f; });
          dbg_cmp(ws, 13, NB, 128, [=](int t, int c, float& a, float& b) { const int e = Ep[(size_t)t * 128 + c]; const int* nn = En + (size_t)t * 128 + (c & ~15); a = Gp2[(size_t)t * 128 + c]; b = a; for (int k = 0; k < 16; ++k) if (nn[k] == e) b = Gn[(size_t)t * 128 + (c & ~15) + k]; }); })
    }
    phase_expert(p);
    DBGC(xcd_barrier(bar); { const float* On = (const float*)(ws + DB_OUT); const float* Op = p.out;
      { const float* Hp = (const float*)(ws + DB_H); const float* xnn = (const float*)(ws + DB_XN); const int* En2 = (const int*)(ws + WS_EIDX); const float* eu_ = p.in[23]; const float* ev_ = p.in[24]; const float* gf = p.in[19];
        const _Float16* UHp = (const _Float16*)(ws + WS_UH); const _Float16* VHp = (const _Float16*)(ws + WS_VH);
        dbg_cmp(ws, 15, NB, 128, [=](int t, int c, float& a, float& b) { a = Hp[(size_t)t * 128 + c]; const float* ur = eu_ + (size_t)En2[(size_t)t * 128 + c] * 1024; const float* xr = xnn + (size_t)t * 1024; float sr = 0.f; for (int k = 0; k < 1024; ++k) sr += ur[k] * xr[k]; b = sr; });
        dbg_cmp(ws, 16, 1024, 1024, [=](int t, int c, float& a, float& b) { a = (float)UHp[(size_t)(t * 16 + 3) * 1024 + c]; b = eu_[(size_t)(t * 16 + 3) * 1024 + c] * gf[c]; });
        dbg_cmp(ws, 17, 1024, 1024, [=](int t, int c, float& a, float& b) { a = (float)VHp[(size_t)(t * 16 + 5) * 1024 + c]; b = ev_[(size_t)(t * 16 + 5) * 1024 + c]; }); }
      dbg_cmp(ws, 14, NB, 1024, [=](int t, int c, float& a, float& b) { a = Op[(size_t)t * 1024 + c]; b = On[(size_t)t * 1024 + c]; }); })
}
}

extern "C" void kernel_launch(void* const* d_in, const int* in_sizes, int n_in, void* d_out, int out_size, void* d_ws, size_t ws_size, hipStream_t stream) {
    static int ready = 0;
    if (ready == 0) {
        if (n_in != 26 || out_size != 32768 * D || ws_size < WS_END) { fprintf(stderr, "kernel_launch: unexpected shapes (n_in %d out %d ws %zu need %zu)\n", n_in, out_size, ws_size, (size_t)WS_END); ready = -1; return; }
        if (hipFuncSetAttribute((const void*)fwd_megakernel, hipFuncAttributeMaxDynamicSharedMemorySize, LDS_BYTES) != hipSuccess) { fprintf(stderr, "kernel_launch: hipFuncSetAttribute failed\n"); ready = -1; return; }
        ready = 1;
    }
    if (ready < 0) return;
    (void)hipMemsetAsync((char*)d_ws + WS_CTL, 0, 65536, stream);
#if DBG
    {
        char* wsb = (char*)d_ws; const int S = NB;
        const float* x = (const float*)d_in[0];
        float* cst = (float*)(wsb + DB_CST); float* hn = (float*)(wsb + DB_HN); float* proj = (float*)(wsb + DB_PROJ); float* am = (float*)(wsb + DB_AM); float* ya = (float*)(wsb + DB_YA);
        float* xr = (float*)(wsb + DB_XR); float* xi = (float*)(wsb + DB_XI); float* z = (float*)(wsb + DB_Z); float* lin = (float*)(wsb + DB_LIN); float* s5 = (float*)(wsb + DB_S5);
        float* yb = (float*)(wsb + DB_YB); float* merged = (float*)(wsb + DB_MG); float* x1 = (float*)(wsb + DB_X1); float* xn = (float*)(wsb + DB_XN); float* q = (float*)(wsb + DB_Q);
        int* eidx = (int*)(wsb + DB_EIDX); float* gate = (float*)(wsb + DB_GATE); float* outn = (float*)(wsb + DB_OUT);
        auto F = [&](int i) { return (const float*)d_in[i]; };
        auto gemm = [&](const float* A, int lda, const float* B, int ldb, float* C, int ldc, int M, int N, int K) { ngemm<<<dim3(N / 64, M / 64), 256, 0, stream>>>(A, lda, B, ldb, C, ldc, M, N, K); };
        (void)hipMemsetAsync(wsb + DB_ACC, 0, 4096, stream);
        n_ssm_const<<<4, 256, 0, stream>>>(F(6), F(7), F(8), cst);
        n_rmsnorm<<<S, 256, 0, stream>>>(x, F(1), hn);
        gemm(hn, D, F(2), IN_COLS, proj, IN_COLS, S, IN_COLS, D);
        n_conv<<<(S * CONV_CH) / 256, 256, 0, stream>>>(proj, F(4), F(5), am, S);
        gemm(am, CONV_CH, F(16), D, ya, D, S, D, CONV_CH);
        n_ssm_x<<<(S * 1024) / 256, 256, 0, stream>>>(proj, F(9), F(10), cst, xr, xi, S);
        n_ssm_scan<<<4, 256, 0, stream>>>(cst, xr, xi, S);
        n_ssm_y<<<(S * 256) / 256, 256, 0, stream>>>(proj, xr, xi, F(11), F(12), F(13), z, S);
        gemm(z, 256, F(14), 256, lin, 256, S, 256, 256);
        n_glu<<<(S * 256) / 256, 256, 0, stream>>>(z, lin, F(15), s5, (size_t)S * 256);
        gemm(s5, 256, F(17), D, yb, D, S, D, 256);
        n_merge<<<(S * D) / 256, 256, 0, stream>>>(proj, F(3), ya, yb, merged, (size_t)S * D);
        gemm(merged, D, F(18), D, x1, D, S, D, D);
        n_add<<<(S * D) / 256, 256, 0, stream>>>(x, x1, (size_t)S * D);
        n_rmsnorm<<<S, 256, 0, stream>>>(x1, F(19), xn);
        gemm(xn, D, F(20), PEER_QD, q, PEER_QD, S, PEER_QD, D);
        n_route<<<S, 256, 0, stream>>>(q, F(21), F(22), eidx, gate);
        n_expert<<<S / 4, 256, 0, stream>>>(xn, x1, eidx, gate, F(23), F(24), F(25), outn);
    }
#endif
    Params p{};
    for (int i = 0; i < 26; ++i) p.in[i] = (const float*)d_in[i];
    p.out = (float*)d_out; p.ws = (unsigned char*)d_ws;
    hipLaunchKernelGGL(fwd_megakernel, dim3(NBLK), dim3(NTHR), LDS_BYTES, stream, p);
#if DBG
    dbg_report<<<1024, 256, 0, stream>>>((const float*)((char*)d_ws + DB_ACC), (float*)d_out, out_size, DBG_FIRST);
#endif
}
```

```cpp
#include <hip/hip_runtime.h>
#include <cstdint>
#include <cstddef>
#include <cstdio>

#define LAS __attribute__((address_space(3)))
#ifndef DBG
#define DBG 0
#endif
#ifndef TIMING
#define TIMING 0
#endif
#ifndef REP_J
#define REP_J 1
#endif
#ifndef REP_AH
#define REP_AH 1
#endif
#ifndef REP_I
#define REP_I 1
#endif
#ifndef REP_PH
#define REP_PH 0
#endif
#ifndef NULLG1
#define NULLG1 0
#endif
#ifndef SKIPA
#define SKIPA 0
#endif
#ifndef REP_TK
#define REP_TK 1
#endif
#ifndef TIME_A
#define TIME_A 13
#endif
#ifndef TIME_B
#define TIME_B 2
#endif
#ifndef DBG_THR
#define DBG_THR 0.03f
#endif
#ifndef DBG_FIRST
#define DBG_FIRST 1
#endif
#if TIMING
#define TSTAMP(k) do { if (blockIdx.x == 0 && threadIdx.x == 0) ((unsigned long long*)(p.ws + WS_RSTD1 - 1024))[k] = __builtin_amdgcn_s_memrealtime(); } while (0)
#else
#define TSTAMP(k)
#endif
#if DBG
#define DBGC(...) __VA_ARGS__
#else
#define DBGC(...)
#endif
namespace {
typedef unsigned short bf16_t;
typedef short bf16x8 __attribute__((ext_vector_type(8)));
typedef float f32x4 __attribute__((ext_vector_type(4)));
typedef unsigned u32x4 __attribute__((ext_vector_type(4)));
typedef unsigned u32x2 __attribute__((ext_vector_type(2)));
typedef _Float16 h2 __attribute__((ext_vector_type(2)));

constexpr int D = 1024, T = DBG ? 16384 : 32768, SEQ = 8192;
constexpr int CONV_CH = 768, IN_COLS = 4608;
constexpr float RMS_EPS = 1e-6f;
constexpr int NBLK = 256, NTHR = 512, NWAVE = 8, NGW = NBLK * NWAVE;
constexpr int CL = 32, LOGCL = 5, CK = CL * 16;
constexpr int SUK = CK + 128;
constexpr int NCHUNK = T / CL, CPS = SEQ / CL;

constexpr size_t MB = 1024 * 1024;
constexpr size_t WS_CTL = 0;
constexpr size_t WS_RSTD1 = WS_CTL + 65536;
constexpr size_t WS_RS2P = WS_RSTD1 + (size_t)T * 4;
constexpr size_t WS_WIN = WS_RS2P + (size_t)T * 64;
constexpr size_t WS_WA = WS_WIN + (size_t)4608 * 1024 * 2;
constexpr size_t WS_WB = WS_WA + (size_t)1024 * 768 * 2;
constexpr size_t WS_WOUT = WS_WB + (size_t)1024 * 256 * 2;
constexpr size_t WS_WGLU = WS_WOUT + (size_t)1024 * 1024 * 2;
constexpr size_t WS_WS = WS_WGLU + (size_t)256 * 256 * 2;
constexpr size_t WS_UH = WS_WS + (size_t)2048 * 1024 * 2;
constexpr size_t WS_USC = WS_UH + (size_t)16384 * 1024;
constexpr size_t WS_VH = WS_USC + (size_t)16384 * 4;
constexpr size_t WS_VSC = WS_VH + (size_t)16384 * 1024;
constexpr size_t WS_RINV = WS_VSC + (size_t)16384 * 4;
constexpr size_t WS_POW = WS_RINV + (size_t)T * 4;
constexpr size_t WS_BBAR = WS_POW + (size_t)16 * 65 * 64 * 2 * 4;
constexpr size_t WS_KC = WS_BBAR + (size_t)16 * 64 * 16 * 2 * 4;
constexpr size_t WS_E = WS_KC + (size_t)16 * 64 * 256 * 4;
constexpr size_t WS_MEND = WS_E + (size_t)16 * NCHUNK * 128 * 4;
constexpr size_t WS_MY = WS_MEND + (size_t)16 * 256 * CK * 2;
constexpr size_t WS_EIDX = WS_MY + (size_t)16 * CK * SUK * 2;
constexpr size_t WS_GATE = WS_EIDX + (size_t)T * 128 * 4;
constexpr size_t WS_XB = WS_GATE + (size_t)T * 128 * 4;
constexpr size_t WS_G = WS_XB + (size_t)T * 1024 * 2;
constexpr size_t WS_CB = WS_G + (size_t)T * 2048 * 2;
constexpr size_t WS_V = WS_CB + (size_t)T * 768 * 2;
constexpr size_t WS_SU = WS_V + (size_t)T * 768 * 2;
constexpr size_t WS_A2 = WS_SU + (size_t)16 * NCHUNK * SUK * 2;
constexpr size_t WS_END = WS_A2 + (size_t)T * 768 * 2;
constexpr size_t WS_XQ = WS_A2 + (size_t)T * 512;
constexpr size_t WS_P = WS_CB, WS_X1B = WS_XB, WS_X1 = WS_G, WS_MG = WS_CB, WS_SC = WS_CB, WS_Z = WS_V + (size_t)T * 256 * 2, WS_S5 = WS_V + (size_t)T * 512 * 2;
static_assert(WS_GATE + (size_t)T * 128 * 4 <= WS_XB, "EIDX/GATE placement");
static_assert(WS_SC + (size_t)T * 2048 * 2 <= WS_XQ && WS_XQ + (size_t)T * 1024 <= WS_END, "SC / XQ overlay");
static_assert(WS_END <= (size_t)512 * MB, "workspace");
static_assert(WS_MG + (size_t)T * 1024 * 2 <= WS_Z && WS_S5 + (size_t)T * 256 * 2 <= WS_SU, "Z/S5 placement");
#if DBG
constexpr int NB = 2048;
constexpr size_t DB_BASE = (WS_END + 4095) & ~(size_t)4095;
constexpr size_t DB_ACC = DB_BASE;
constexpr size_t DB_CST = DB_ACC + 4096;
constexpr size_t DB_HN = DB_CST + 16384;
constexpr size_t DB_PROJ = DB_HN + (size_t)NB * D * 4;
constexpr size_t DB_AM = DB_PROJ + (size_t)NB * IN_COLS * 4;
constexpr size_t DB_YA = DB_AM + (size_t)NB * CONV_CH * 4;
constexpr size_t DB_XR = DB_YA + (size_t)NB * D * 4;
constexpr size_t DB_XI = DB_XR + (size_t)NB * D * 4;
constexpr size_t DB_Z = DB_XI + (size_t)NB * D * 4;
constexpr size_t DB_LIN = DB_Z + (size_t)NB * 256 * 4;
constexpr size_t DB_S5 = DB_LIN + (size_t)NB * 256 * 4;
constexpr size_t DB_YB = DB_S5 + (size_t)NB * 256 * 4;
constexpr size_t DB_MG = DB_YB + (size_t)NB * D * 4;
constexpr size_t DB_X1 = DB_MG + (size_t)NB * D * 4;
constexpr size_t DB_XN = DB_X1 + (size_t)NB * D * 4;
constexpr size_t DB_Q = DB_XN + (size_t)NB * D * 4;
constexpr size_t DB_EIDX = DB_Q + (size_t)NB * 2048 * 4;
constexpr size_t DB_GATE = DB_EIDX + (size_t)NB * 128 * 4;
constexpr size_t DB_OUT = DB_GATE + (size_t)NB * 128 * 4;
constexpr size_t DB_H = DB_OUT + (size_t)NB * D * 4;
constexpr size_t DB_END = DB_H + (size_t)NB * 128 * 4;
static_assert(DB_END <= (size_t)512 * MB, "debug workspace");
constexpr size_t DBH_OFF = DB_H;
#endif

constexpr int LDS_STAGE = 131072, LDS_MISC = LDS_STAGE, LDS_GBIAS = LDS_STAGE + 4096, LDS_BYTES = LDS_GBIAS + 8192;

struct Params { const float* in[26]; float* out; unsigned char* ws; };

__device__ __forceinline__ unsigned pk2bf(float lo, float hi) { unsigned r; asm volatile("v_cvt_pk_bf16_f32 %0, %1, %2" : "=v"(r) : "v"(lo), "v"(hi)); return r; }
__device__ __forceinline__ int dot4z(unsigned a, int b) { int r; asm("v_dot4_i32_i8 %0, %1, %2, 0" : "=v"(r) : "v"(a), "v"(b)); return r; }
__device__ __forceinline__ h2 as_h2(unsigned v) { return __builtin_bit_cast(h2, v); }
__device__ __forceinline__ unsigned pk2h(float lo, float hi) { unsigned r; asm("v_cvt_pkrtz_f16_f32 %0, %1, %2" : "=v"(r) : "v"(lo), "v"(hi)); return r; }
__device__ __forceinline__ float bflo(unsigned d) { return __uint_as_float(d << 16); }
__device__ __forceinline__ float bfhi(unsigned d) { return __uint_as_float(d & 0xffff0000u); }
__device__ __forceinline__ float gelu_exact(float v) { return 0.5f * v * (1.0f + erff(v * 0.70710678118654752f)); }
__device__ __forceinline__ float ub0(unsigned w) { return (float)(w & 0xffu); }
__device__ __forceinline__ float ub1(unsigned w) { return (float)((w >> 8) & 0xffu); }
__device__ __forceinline__ float ub2(unsigned w) { return (float)((w >> 16) & 0xffu); }
__device__ __forceinline__ float ub3(unsigned w) { return (float)(w >> 24); }
__device__ __forceinline__ float sigm(float v) { return __builtin_amdgcn_rcpf(1.0f + __builtin_amdgcn_exp2f(v * -1.44269504089f)); }
__device__ __forceinline__ float sigm255(float v) { return __builtin_amdgcn_rcpf(fmaf(__builtin_amdgcn_exp2f(v * -1.44269504089f), 1.0f / 255.0f, 1.0f / 255.0f)); }
__device__ __forceinline__ u32x4 pack8(const f32x4 a, const f32x4 b) { u32x4 w; w.x = pk2bf(a[0], a[1]); w.y = pk2bf(a[2], a[3]); w.z = pk2bf(b[0], b[1]); w.w = pk2bf(b[2], b[3]); return w; }
__device__ __forceinline__ float wave_sum(float v) {
#pragma unroll
    for (int o = 1; o < 64; o <<= 1) v += __shfl_xor(v, o);
    return v;
}

#define XB_TMO      128
#define XB_XCNT(j)  (256  + 64 * (j))
#define XB_XSUB(j)  (1280 + 64 * (j))
#define XB_XGEN(j)  (2304 + 64 * (j))
#define XB_TOP      3328
#define XB_TOPGEN   3392
#define XCD_BAR_WORDS 3456
#define XB_SPIN_CAP (1u << 22)
__device__ __forceinline__ unsigned xb_ld(unsigned* p)              { return __hip_atomic_load(p, __ATOMIC_RELAXED, __HIP_MEMORY_SCOPE_AGENT); }
__device__ __forceinline__ unsigned xb_add(unsigned* p, unsigned v) { return __hip_atomic_fetch_add(p, v, __ATOMIC_RELAXED, __HIP_MEMORY_SCOPE_AGENT); }
__device__ __forceinline__ unsigned xb_xcc_id() { return (unsigned)__builtin_amdgcn_s_getreg((3 << 11) | 20) & 0xFu; }
#define XB_SPIN(cond, bar) do { unsigned _sp = 0; while (cond) { __builtin_amdgcn_s_sleep(1); \
    if ((++_sp & 255u) == 0u) { if (xb_ld(&(bar)[XB_TMO])) break; if (_sp > XB_SPIN_CAP) { atomicAdd(&(bar)[XB_TMO], 1u); break; } } } } while (0)
struct XcdBarrier { unsigned* bar; unsigned x; volatile LAS unsigned* st; };
__device__ __forceinline__ XcdBarrier xcd_barrier_post(unsigned* bar, volatile LAS unsigned* st) {
    XcdBarrier b; b.bar = bar; b.x = xb_xcc_id(); b.st = st;
    if (threadIdx.x == 0) (void)xb_add(&bar[XB_XCNT(b.x)], 1u);
    return b;
}
__device__ __forceinline__ void xcd_barrier_complete(unsigned* bar, unsigned x, unsigned& nloc, unsigned& nx) {
    const unsigned G = gridDim.x * gridDim.y * gridDim.z;
    unsigned sum, cnt, mine, sp = 0u;
    for (;;) {
        sum = 0u; cnt = 0u; mine = 0u;
#pragma unroll
        for (unsigned j = 0; j < 16; ++j) { const unsigned c = xb_ld(&bar[XB_XCNT(j)]); sum += c; cnt += (c > 0u) ? 1u : 0u; mine = (j == x) ? c : mine; }
        if (sum == G) break;
        __builtin_amdgcn_s_sleep(1);
        if ((++sp & 255u) == 0u) { if (xb_ld(&bar[XB_TMO])) break; if (sp > XB_SPIN_CAP) { atomicAdd(&bar[XB_TMO], 1u); break; } }
    }
    nloc = mine > 0u ? mine : 1u; nx = cnt > 0u ? cnt : 1u;
}
__device__ __forceinline__ void xcd_barrier(const XcdBarrier& b) {
    asm volatile("s_waitcnt vmcnt(0)" ::: "memory");
    __syncthreads();
    if (threadIdx.x == 0) {
        unsigned* bar = b.bar;
        __builtin_amdgcn_s_waitcnt(0);
        unsigned nloc = b.st[0], nx = b.st[1];
        if (nloc == 0u) { xcd_barrier_complete(bar, b.x, nloc, nx); b.st[0] = nloc; b.st[1] = nx; }
        const unsigned old = xb_add(&bar[XB_XSUB(b.x)], 1u);
        const unsigned gen = old / nloc;
        if (old + 1u == (gen + 1u) * nloc) {
            __builtin_amdgcn_fence(__ATOMIC_RELEASE, "agent");
            asm volatile("s_waitcnt vmcnt(0)" ::: "memory");
            const unsigned og = xb_add(&bar[XB_TOP], 1u);
            const unsigned tg = og / nx;
            if (og + 1u == (tg + 1u) * nx) xb_add(&bar[XB_TOPGEN], 1u);
            else XB_SPIN(xb_ld(&bar[XB_TOPGEN]) == tg, bar);
            __builtin_amdgcn_fence(__ATOMIC_ACQUIRE, "agent");
            xb_add(&bar[XB_XGEN(b.x)], 1u);
            asm volatile("s_waitcnt vmcnt(0)" ::: "memory");
        } else {
            XB_SPIN(xb_ld(&bar[XB_XGEN(b.x)]) == gen, bar);
            __builtin_amdgcn_fence(__ATOMIC_ACQUIRE, "agent");
            asm volatile("s_waitcnt vmcnt(0)" ::: "memory");
        }
    }
    __syncthreads();
}

constexpr int BM = 256, BK = 64, HALF = 128, HTB = HALF * BK * 2, NXCD = 8, WGM = 8;
__device__ __forceinline__ int lds_byte(int r, int c) { const int st = (r >> 4) * 2 + (c >> 5), rr = r & 15, cc = c & 31, ob = rr * 64 + cc * 2; return st * 1024 + (ob ^ (((ob >> 9) & 1) << 5)); }
__device__ __forceinline__ void stage_rc(int b, int& R, int& C) { const int st = b / 1024, sb = b % 1024, swz = sb ^ (((sb >> 9) & 1) << 5); R = (st >> 1) * 16 + swz / 64; C = (st & 1) * 32 + (swz % 64) / 2; }
__device__ __forceinline__ int perm32(int rho) { const int n = rho >> 4, i = rho & 15; return 8 * (i >> 2) + 4 * n + (i & 3); }

struct Unit { int pm, pn, z; };
struct Gemm { const bf16_t* A; const bf16_t* Bt; int lda, ldb, K; long sAz, sBz; };
struct Order {
    int nM, nN, nZ, G, c, pm_off; long u0, u1; int b0;
    __device__ void init(int M, int N, int Z, int pmo) { nM = M / BM; nN = N / BM; nZ = Z; G = gridDim.x; c = blockIdx.x; pm_off = pmo; u0 = 0; u1 = (long)nM * nN * nZ; b0 = 0; }
    __device__ void window(long first_unit, long end_unit, int first_block, int nblocks) { u0 = first_unit; u1 = end_unit; b0 = first_block; G = nblocks; }
    __device__ bool next(int i, Unit& u) const {
        if (c < b0 || c >= b0 + G) return false;
        const long L = u0 + (long)i * G + (c - b0); const int nwg = nM * nN;
        if (L >= u1) return false;
        if (nZ == 1) {
            int wgid = (int)L; { const int q = nwg / NXCD, r = nwg % NXCD, xcd = wgid % NXCD, off = wgid / NXCD; wgid = (xcd < r ? xcd * (q + 1) : r * (q + 1) + (xcd - r) * q) + off; }
            const int nig = WGM * nN, gid = wgid / nig, fm = gid * WGM, gsz = (nM - fm) < WGM ? (nM - fm) : WGM;
            u.pm = pm_off + fm + ((wgid % nig) % gsz); u.pn = (wgid % nig) / gsz; u.z = 0;
        } else { u.z = (int)(L / nwg); const int r = (int)(L % nwg); u.pm = r % nM; u.pn = r / nM; }
        return true;
    }
};

template <class Epi>
__device__ __forceinline__ void gemm_phase(LAS unsigned char* lds, const Gemm g, const Order& S, const Epi& E) {
    int tid = threadIdx.x; asm volatile("" : "+v"(tid));
    const int wid = __builtin_amdgcn_readfirstlane(tid >> 6), lane = tid & 63, wr = wid >> 2, wc = wid & 3, fr = lane & 15, fq = lane >> 4;
    const int K = g.K, nt = K / BK;
    unsigned voffA[2], voffB[2];
#pragma unroll
    for (int i = 0; i < 2; ++i) { int R, C; stage_rc(tid * 16 + i * 8192, R, C); const int Rb = Epi::PERM ? ((R & ~31) + perm32(R & 31)) : R;
        voffA[i] = (unsigned)(R * g.lda + C) * 2u; voffB[i] = (unsigned)(Rb * g.ldb + C) * 2u; }
    const size_t kstep = (size_t)(BK * 2);
    const size_t hstepA = (size_t)HALF * g.lda * 2, hstepB = (size_t)HALF * g.ldb * 2;
    const unsigned ldsw = (unsigned)wid * 1024u;
    const int aoff = lds_byte(wr * 64 + fr, fq * 8), boff = lds_byte(wc * 32 + fr, fq * 8);
#define PG8_SA(b, h) (((b) * 2 + (h)) * HTB)
#define PG8_SB(b, h) ((4 + (b) * 2 + (h)) * HTB)
#define PG8_STAGE(bufoff, gbase, voff) do { _Pragma("unroll") for (int _i = 0; _i < 2; ++_i) \
        __builtin_amdgcn_global_load_lds((const unsigned*)((const char*)(gbase) + (voff)[_i]), (LAS unsigned*)(lds + (bufoff) + ldsw + _i * 8192), 16, 0, 0); } while (0)
#define PG8_LDA(dst, b, h) do { _Pragma("unroll") for (int m = 0; m < 4; ++m) _Pragma("unroll") for (int k = 0; k < 2; ++k) dst[m][k] = *(const LAS bf16x8*)(lds + PG8_SA(b, h) + aoff + m * 2048 + k * 1024); } while (0)
#define PG8_LDB(dst, b, h) do { _Pragma("unroll") for (int n = 0; n < 2; ++n) _Pragma("unroll") for (int k = 0; k < 2; ++k) dst[n][k] = *(const LAS bf16x8*)(lds + PG8_SB(b, h) + boff + n * 2048 + k * 1024); } while (0)
#define PG8_MMA(ai, bj, At, Bt) do { __builtin_amdgcn_s_setprio(1); _Pragma("unroll") for (int m = 0; m < 4; ++m) _Pragma("unroll") for (int n = 0; n < 2; ++n) _Pragma("unroll") for (int k = 0; k < 2; ++k) \
        acc[ai][bj][m][n] = __builtin_amdgcn_mfma_f32_16x16x32_bf16(Bt[n][k], At[m][k], acc[ai][bj][m][n], 0, 0, 0); __builtin_amdgcn_s_setprio(0); } while (0)
#define PG8_WAIT_V(n) asm volatile("s_waitcnt vmcnt(" #n ")" ::: "memory")
#define PG8_WAIT_L(n) asm volatile("s_waitcnt lgkmcnt(" #n ")" ::: "memory")
#define PG8_BAR __builtin_amdgcn_s_barrier()
#define PG8_SCHED __builtin_amdgcn_sched_barrier(0)
    Unit cur, nxt; int ui = 0;
    if (!S.next(0, cur)) return;
    f32x4 acc[2][2][4][2];
#pragma unroll
    for (int a = 0; a < 2; ++a)
#pragma unroll
        for (int b = 0; b < 2; ++b)
#pragma unroll
            for (int m = 0; m < 4; ++m)
#pragma unroll
                for (int n = 0; n < 2; ++n) acc[a][b][m][n] = (f32x4){0.f, 0.f, 0.f, 0.f};
    bf16x8 At[4][2], B0[2][2], B1[2][2];
    const char* cA = (const char*)g.A + ((size_t)cur.z * g.sAz) * 2 + (size_t)cur.pm * 2 * hstepA;
    const char* cB = (const char*)g.Bt + ((size_t)cur.z * g.sBz) * 2 + (size_t)cur.pn * 2 * hstepB;
    PG8_STAGE(PG8_SB(0, 0), cB, voffB); PG8_STAGE(PG8_SB(0, 1), cB + hstepB, voffB); PG8_STAGE(PG8_SA(0, 0), cA, voffA); PG8_STAGE(PG8_SA(0, 1), cA + hstepA, voffA);
    if (wr == 1) PG8_BAR;
    PG8_WAIT_V(2); PG8_BAR;
    PG8_STAGE(PG8_SB(1, 0), cB + kstep, voffB); PG8_STAGE(PG8_SA(1, 0), cA + kstep, voffA); PG8_STAGE(PG8_SB(1, 1), cB + hstepB + kstep, voffB);
    PG8_WAIT_V(6); PG8_BAR;
    for (;;) {
        const bool has_next = S.next(ui + 1, nxt);
        const char* nA = has_next ? (const char*)g.A + ((size_t)nxt.z * g.sAz) * 2 + (size_t)nxt.pm * 2 * hstepA : cA;
        const char* nB = has_next ? (const char*)g.Bt + ((size_t)nxt.z * g.sBz) * 2 + (size_t)nxt.pn * 2 * hstepB : cB;
#pragma unroll 1
        for (int t = 0; t < nt; t += 2) {
            const bool last = (t == nt - 2);
            const char* a1 = cA + (size_t)(t + 1) * kstep;
            const char* a2 = last ? nA : cA + (size_t)(t + 2) * kstep; const char* b2 = last ? nB : cB + (size_t)(t + 2) * kstep;
            const char* a3 = a2 + kstep; const char* b3 = b2 + kstep;
            PG8_LDB(B0, 0, 0); PG8_LDB(B1, 0, 1); PG8_SCHED; PG8_LDA(At, 0, 0); PG8_STAGE(PG8_SA(1, 1), a1 + hstepA, voffA);
            PG8_WAIT_V(8); PG8_WAIT_L(0); PG8_BAR; PG8_MMA(0, 0, At, B0); PG8_MMA(0, 1, At, B1); PG8_BAR; PG8_SCHED;
            PG8_LDA(At, 0, 1); PG8_STAGE(PG8_SB(0, 0), b2, voffB); PG8_STAGE(PG8_SB(0, 1), b2 + hstepB, voffB); PG8_STAGE(PG8_SA(0, 0), a2, voffA);
            PG8_WAIT_V(8); PG8_WAIT_L(0); PG8_BAR; PG8_MMA(1, 0, At, B0); PG8_MMA(1, 1, At, B1); PG8_BAR; PG8_SCHED;
            PG8_LDB(B0, 1, 0); PG8_LDB(B1, 1, 1); PG8_SCHED; PG8_LDA(At, 1, 0); PG8_STAGE(PG8_SA(0, 1), a2 + hstepA, voffA);
            PG8_WAIT_V(8); PG8_WAIT_L(0); PG8_BAR; PG8_MMA(0, 0, At, B0); PG8_MMA(0, 1, At, B1); PG8_BAR; PG8_SCHED;
            PG8_LDA(At, 1, 1); PG8_STAGE(PG8_SB(1, 0), b3, voffB); PG8_STAGE(PG8_SB(1, 1), b3 + hstepB, voffB); PG8_STAGE(PG8_SA(1, 0), a3, voffA);
            PG8_WAIT_V(8); PG8_WAIT_L(0); PG8_BAR; PG8_MMA(1, 0, At, B0); PG8_MMA(1, 1, At, B1); PG8_BAR; PG8_SCHED;
        }
        if (wr == 0) PG8_BAR;
        { int fr_e = fr, fq_e = fq; asm volatile("" : "+v"(fr_e), "+v"(fq_e));
          E(acc, cur, wr, wc, fr_e, fq_e); }
        if (!has_next) break;
#pragma unroll
        for (int a = 0; a < 2; ++a)
#pragma unroll
            for (int b = 0; b < 2; ++b)
#pragma unroll
                for (int m = 0; m < 4; ++m)
#pragma unroll
                    for (int n = 0; n < 2; ++n) acc[a][b][m][n] = (f32x4){0.f, 0.f, 0.f, 0.f};
        cur = nxt; cA = nA; cB = nB; ++ui;
        if (wr == 1) PG8_BAR;
    }
    PG8_WAIT_V(0);
    PG8_BAR;
#undef PG8_SA
#undef PG8_SB
#undef PG8_STAGE
#undef PG8_LDA
#undef PG8_LDB
#undef PG8_MMA
#undef PG8_WAIT_V
#undef PG8_WAIT_L
#undef PG8_BAR
#undef PG8_SCHED
}

__device__ __forceinline__ u32x4 xpose16(const u32x4 v, int src_addr) {
    u32x4 r; r.x = (unsigned)__builtin_amdgcn_ds_bpermute(src_addr, (int)v.x); r.y = (unsigned)__builtin_amdgcn_ds_bpermute(src_addr, (int)v.y);
    r.z = (unsigned)__builtin_amdgcn_ds_bpermute(src_addr, (int)v.z); r.w = (unsigned)__builtin_amdgcn_ds_bpermute(src_addr, (int)v.w); return r;
}
typedef const f32x4 (&AccRef)[2][2][4][2];
template <bool NOST> struct EpiG1T {
    static constexpr bool PERM = true;
    const LAS float* bgate; bf16_t *CB, *V, *SU; unsigned char* G8;
    __device__ __forceinline__ void operator()(AccRef acc, const Unit& u, int wr, int wc, int fr, int fq) const {
        const int pn = u.pn, c0 = wc * 32 + 8 * fq;
        const int lane = fq * 16 + fr, sa = ((lane & 3) * 16 + (lane >> 2)) * 4, tr = lane >> 2, tc0 = wc * 32 + 8 * (lane & 3);
#pragma unroll
        for (int ai = 0; ai < 2; ++ai)
#pragma unroll
            for (int m = 0; m < 4; ++m) {
                const int row = u.pm * BM + ai * HALF + wr * 64 + m * 16 + tr;
                if (pn < 3) {
#pragma unroll
                    for (int bj = 0; bj < 2; ++bj) { const u32x4 w_ = xpose16(pack8(acc[ai][bj][m][0], acc[ai][bj][m][1]), sa); if (NOST) asm volatile("" :: "v"(w_)); else *(u32x4*)(CB + (size_t)row * CONV_CH + pn * 256 + bj * HALF + tc0) = w_; }
                } else if (pn < 9) {
                    { const u32x4 w_ = xpose16(pack8(acc[ai][0][m][0] * acc[ai][1][m][0], acc[ai][0][m][1] * acc[ai][1][m][1]), sa); if (NOST) asm volatile("" :: "v"(w_)); else *(u32x4*)(V + (size_t)row * CONV_CH + (pn - 3) * HALF + tc0) = w_; }
                } else if (pn == 9) {
#pragma unroll
                    for (int bj = 0; bj < 2; ++bj) { const int c = bj * HALF + tc0, gq = c >> 4, h0 = c & 15;
                        const u32x4 w_ = xpose16(pack8(acc[ai][bj][m][0], acc[ai][bj][m][1]), sa); if (NOST) asm volatile("" :: "v"(w_)); else *(u32x4*)(SU + ((size_t)(gq * NCHUNK + (row >> LOGCL))) * SUK + (row & (CL - 1)) * 16 + h0) = w_; }
                } else {
#pragma unroll
                    for (int bj = 0; bj < 2; ++bj) { const int col = (pn - 10) * 256 + bj * HALF + c0;
                        const f32x4 b0 = *(const LAS f32x4*)(bgate + col), b1 = *(const LAS f32x4*)(bgate + col + 4);
                        const f32x4 v0 = acc[ai][bj][m][0] + b0, v1 = acc[ai][bj][m][1] + b1; unsigned lo = 0u, hi = 0u;
#pragma unroll
                        for (int e = 0; e < 4; ++e) { lo = __builtin_amdgcn_cvt_pk_u8_f32(sigm255(v0[e]), e, lo); hi = __builtin_amdgcn_cvt_pk_u8_f32(sigm255(v1[e]), e, hi); }
                        const int rowd = u.pm * BM + ai * HALF + wr * 64 + m * 16 + fr; const u32x2 w_ = {lo, hi};
                        if (NOST) asm volatile("" :: "v"(w_)); else *(u32x2*)(G8 + (size_t)rowd * 2048 + col) = w_; }
                }
            }
    }
};
typedef EpiG1T<false> EpiG1;
struct EpiNull {
    static constexpr bool PERM = true;
    __device__ __forceinline__ void operator()(AccRef acc, const Unit& u, int wr, int wc, int fr, int fq) const {
#pragma unroll
        for (int ai = 0; ai < 2; ++ai)
#pragma unroll
            for (int bj = 0; bj < 2; ++bj)
#pragma unroll
                for (int m = 0; m < 4; ++m)
#pragma unroll
                    for (int n = 0; n < 2; ++n) asm volatile("" :: "v"(acc[ai][bj][m][n]));
    }
};
#define EPI_WAIT() asm volatile("s_waitcnt vmcnt(0)" ::: "memory")
struct EpiP {
    static constexpr bool PERM = true;
    const unsigned char* G8; bf16_t* P;
    __device__ __forceinline__ void operator()(AccRef acc, const Unit& u, int wr, int wc, int fr, int fq) const {
        const int col0 = u.pn * BM + wc * 32 + 8 * fq;
#pragma unroll
        for (int ai = 0; ai < 2; ++ai) {
            u32x2 gg[4][2];
#pragma unroll
            for (int m = 0; m < 4; ++m) { const int row = u.pm * BM + ai * HALF + wr * 64 + m * 16 + fr;
#pragma unroll
                for (int bj = 0; bj < 2; ++bj) gg[m][bj] = *(const u32x2*)(G8 + (size_t)row * 2048 + col0 + bj * HALF); }
            EPI_WAIT();
#pragma unroll
            for (int m = 0; m < 4; ++m) { const int row = u.pm * BM + ai * HALF + wr * 64 + m * 16 + fr;
#pragma unroll
                for (int bj = 0; bj < 2; ++bj) { const u32x2 g2 = gg[m][bj];
                    f32x4 v0 = acc[ai][bj][m][0], v1 = acc[ai][bj][m][1];
                    v0[0] *= ub0(g2.x); v0[1] *= ub1(g2.x); v0[2] *= ub2(g2.x); v0[3] *= ub3(g2.x); v1[0] *= ub0(g2.y); v1[1] *= ub1(g2.y); v1[2] *= ub2(g2.y); v1[3] *= ub3(g2.y);
                    *(u32x4*)(P + (size_t)row * D + col0 + bj * HALF) = pack8(v0, v1); } }
        }
    }
};
struct EpiE {
    static constexpr bool PERM = false;
    float* E;
    __device__ __forceinline__ void operator()(AccRef acc, const Unit& u, int wr, int wc, int fr, int fq) const {
#pragma unroll
        for (int ai = 0; ai < 2; ++ai)
#pragma unroll
            for (int m = 0; m < 4; ++m) { const int row = u.pm * BM + ai * HALF + wr * 64 + m * 16 + fr;
#pragma unroll
                for (int n = 0; n < 2; ++n) *(f32x4*)(E + ((size_t)u.z * NCHUNK + row) * 128 + wc * 32 + n * 16 + 4 * fq) = acc[ai][0][m][n]; }
    }
};
struct EpiY {
    static constexpr bool PERM = true;
    const bf16_t* SU; const float* dskip; bf16_t* Z;
    __device__ __forceinline__ void operator()(AccRef acc, const Unit& u, int wr, int wc, int fr, int fq) const {
        f32x4 d0[2], d1[2];
#pragma unroll
        for (int bj = 0; bj < 2; ++bj) { const int col = u.pn * BM + bj * HALF + wc * 32 + 8 * fq, h0 = col & 15; d0[bj] = *(const f32x4*)(dskip + u.z * 16 + h0); d1[bj] = *(const f32x4*)(dskip + u.z * 16 + h0 + 4); }
#pragma unroll
        for (int ai = 0; ai < 2; ++ai) {
            u32x4 uu[4][2];
#pragma unroll
            for (int m = 0; m < 4; ++m) { const int chunk = u.pm * BM + ai * HALF + wr * 64 + m * 16 + fr;
#pragma unroll
                for (int bj = 0; bj < 2; ++bj) { const int col = u.pn * BM + bj * HALF + wc * 32 + 8 * fq;
                    uu[m][bj] = *(const u32x4*)(SU + ((size_t)u.z * NCHUNK + chunk) * SUK + col); } }
            EPI_WAIT();
#pragma unroll
            for (int m = 0; m < 4; ++m) { const int chunk = u.pm * BM + ai * HALF + wr * 64 + m * 16 + fr;
#pragma unroll
                for (int bj = 0; bj < 2; ++bj) { const int col = u.pn * BM + bj * HALF + wc * 32 + 8 * fq, j = col >> 4, h0 = col & 15; const u32x4 u4 = uu[m][bj];
                    f32x4 v0 = acc[ai][bj][m][0], v1 = acc[ai][bj][m][1];
                    v0[0] += d0[bj][0] * bflo(u4.x); v0[1] += d0[bj][1] * bfhi(u4.x); v0[2] += d0[bj][2] * bflo(u4.y); v0[3] += d0[bj][3] * bfhi(u4.y);
                    v1[0] += d1[bj][0] * bflo(u4.z); v1[1] += d1[bj][1] * bfhi(u4.z); v1[2] += d1[bj][2] * bflo(u4.w); v1[3] += d1[bj][3] * bfhi(u4.w);
#pragma unroll
                    for (int e = 0; e < 4; ++e) { v0[e] = gelu_exact(v0[e]); v1[e] = gelu_exact(v1[e]); }
                    *(u32x4*)(Z + ((size_t)chunk * CL + j) * 256 + u.z * 16 + h0) = pack8(v0, v1); } }
        }
    }
};
struct EpiGlu {
    static constexpr bool PERM = true;
    const bf16_t* Z; const float* bglu; bf16_t* S5;
    __device__ __forceinline__ void operator()(AccRef acc, const Unit& u, int wr, int wc, int fr, int fq) const {
        f32x4 b0[2], b1[2];
#pragma unroll
        for (int bj = 0; bj < 2; ++bj) { const int col = bj * HALF + wc * 32 + 8 * fq; b0[bj] = *(const f32x4*)(bglu + col); b1[bj] = *(const f32x4*)(bglu + col + 4); }
#pragma unroll
        for (int ai = 0; ai < 2; ++ai) {
            u32x4 zz[4][2];
#pragma unroll
            for (int m = 0; m < 4; ++m) { const int row = u.pm * BM + ai * HALF + wr * 64 + m * 16 + fr;
#pragma unroll
                for (int bj = 0; bj < 2; ++bj) zz[m][bj] = *(const u32x4*)(Z + (size_t)row * 256 + bj * HALF + wc * 32 + 8 * fq); }
            EPI_WAIT();
#pragma unroll
            for (int m = 0; m < 4; ++m) { const int row = u.pm * BM + ai * HALF + wr * 64 + m * 16 + fr;
#pragma unroll
                for (int bj = 0; bj < 2; ++bj) { const int col = bj * HALF + wc * 32 + 8 * fq; const u32x4 z4 = zz[m][bj];
                    f32x4 v0 = acc[ai][bj][m][0] + b0[bj], v1 = acc[ai][bj][m][1] + b1[bj];
                    v0[0] = bflo(z4.x) * sigm(v0[0]); v0[1] = bfhi(z4.x) * sigm(v0[1]); v0[2] = bflo(z4.y) * sigm(v0[2]); v0[3] = bfhi(z4.y) * sigm(v0[3]);
                    v1[0] = bflo(z4.z) * sigm(v1[0]); v1[1] = bfhi(z4.z) * sigm(v1[1]); v1[2] = bflo(z4.w) * sigm(v1[2]); v1[3] = bfhi(z4.w) * sigm(v1[3]);
                    *(u32x4*)(S5 + (size_t)row * 256 + col) = pack8(v0, v1); } }
        }
    }
};
struct EpiMerge {
    static constexpr bool PERM = true;
    const unsigned char* G8; const bf16_t* P; bf16_t* MG;
    __device__ __forceinline__ void operator()(AccRef acc, const Unit& u, int wr, int wc, int fr, int fq) const {
        const int col0 = u.pn * BM + wc * 32 + 8 * fq;
#pragma unroll
        for (int ai = 0; ai < 2; ++ai) {
            u32x2 gg[4][2]; u32x4 pp[4][2];
#pragma unroll
            for (int m = 0; m < 4; ++m) { const int row = u.pm * BM + ai * HALF + wr * 64 + m * 16 + fr;
#pragma unroll
                for (int bj = 0; bj < 2; ++bj) { gg[m][bj] = *(const u32x2*)(G8 + (size_t)row * 2048 + D + col0 + bj * HALF); pp[m][bj] = *(const u32x4*)(P + (size_t)row * D + col0 + bj * HALF); } }
            EPI_WAIT();
#pragma unroll
            for (int m = 0; m < 4; ++m) { const int row = u.pm * BM + ai * HALF + wr * 64 + m * 16 + fr;
#pragma unroll
                for (int bj = 0; bj < 2; ++bj) { const u32x2 g2 = gg[m][bj]; const u32x4 p4 = pp[m][bj];
                    f32x4 v0 = acc[ai][bj][m][0], v1 = acc[ai][bj][m][1];
                    v0[0] = bflo(p4.x) + ub0(g2.x) * v0[0]; v0[1] = bfhi(p4.x) + ub1(g2.x) * v0[1]; v0[2] = bflo(p4.y) + ub2(g2.x) * v0[2]; v0[3] = bfhi(p4.y) + ub3(g2.x) * v0[3];
                    v1[0] = bflo(p4.z) + ub0(g2.y) * v1[0]; v1[1] = bfhi(p4.z) + ub1(g2.y) * v1[1]; v1[2] = bflo(p4.w) + ub2(g2.y) * v1[2]; v1[3] = bfhi(p4.w) + ub3(g2.y) * v1[3];
                    *(u32x4*)(MG + (size_t)row * D + col0 + bj * HALF) = pack8(v0, v1); } }
        }
    }
};
struct EpiX1 {
    static constexpr bool PERM = true;
    const float* RINV; bf16_t* X1B; float* RS2P;
    __device__ __forceinline__ void operator()(AccRef acc, const Unit& u, int wr, int wc, int fr, int fq) const {
        const int col0 = u.pn * BM + wc * 32 + 8 * fq;
#pragma unroll
        for (int ai = 0; ai < 2; ++ai) {
            u32x4 xb[4][2]; float ri[4];
#pragma unroll
            for (int m = 0; m < 4; ++m) { const int row = u.pm * BM + ai * HALF + wr * 64 + m * 16 + fr; ri[m] = RINV[row];
#pragma unroll
                for (int bj = 0; bj < 2; ++bj) xb[m][bj] = *(const u32x4*)(X1B + (size_t)row * D + col0 + bj * HALF); }
            EPI_WAIT();
#pragma unroll
            for (int m = 0; m < 4; ++m) { const int row = u.pm * BM + ai * HALF + wr * 64 + m * 16 + fr; float ss = 0.f; const float r_ = ri[m];
#pragma unroll
                for (int bj = 0; bj < 2; ++bj) { const size_t o = (size_t)row * D + col0 + bj * HALF; const u32x4 w = xb[m][bj];
                    const f32x4 v0 = acc[ai][bj][m][0] + (f32x4){bflo(w.x), bfhi(w.x), bflo(w.y), bfhi(w.y)} * r_, v1 = acc[ai][bj][m][1] + (f32x4){bflo(w.z), bfhi(w.z), bflo(w.w), bfhi(w.w)} * r_;
                    *(u32x4*)(X1B + o) = pack8(v0, v1);
                    ss += (v0[0] * v0[0] + v0[1] * v0[1]) + (v0[2] * v0[2] + v0[3] * v0[3]) + (v1[0] * v1[0] + v1[1] * v1[1]) + (v1[2] * v1[2] + v1[3] * v1[3]); }
                ss += __shfl_xor(ss, 16); ss += __shfl_xor(ss, 32);
                if (fq == 0) RS2P[(size_t)row * 16 + u.pn * 4 + wc] = ss; }
        }
    }
};
struct EpiSC {
    static constexpr bool PERM = true;
    unsigned short* SC;
    __device__ __forceinline__ void operator()(AccRef acc, const Unit& u, int wr, int wc, int fr, int fq) const {
        const int col0 = u.pn * BM + wc * 32 + 8 * fq;
#pragma unroll
        for (int ai = 0; ai < 2; ++ai)
#pragma unroll
            for (int m = 0; m < 4; ++m) { const int row = u.pm * BM + ai * HALF + wr * 64 + m * 16 + fr;
#pragma unroll
                for (int bj = 0; bj < 2; ++bj) { const f32x4 v0 = acc[ai][bj][m][0], v1 = acc[ai][bj][m][1]; u32x4 o;
                    o.x = pk2h(v0[0], v0[1]); o.y = pk2h(v0[2], v0[3]); o.z = pk2h(v1[0], v1[1]); o.w = pk2h(v1[2], v1[3]);
                    *(u32x4*)(SC + (size_t)row * 2048 + col0 + bj * HALF) = o; } }
    }
};

__device__ __forceinline__ void transpose_item(const float* W, int ldw, int src_col0, bf16_t* WT, int ldt, int dst_row0, int k0, const float* scale, LAS float* scr, int lane, float cs = 1.0f) {
#pragma unroll
    for (int i = 0; i < 32; ++i) { const int kk = 2 * i + (lane >> 5); float v = W[(size_t)(k0 + kk) * ldw + src_col0 + (lane & 31)] * cs; if (scale) v *= scale[k0 + kk]; scr[kk * 33 + (lane & 31)] = v; }
    asm volatile("s_waitcnt lgkmcnt(0)" ::: "memory");
    const int c = lane & 7;
#pragma unroll
    for (int j = 0; j < 4; ++j) { const int n = (lane >> 3) + 8 * j; const LAS float* s = scr + (8 * c) * 33 + n;
        u32x4 o; o.x = pk2bf(s[0 * 33], s[1 * 33]); o.y = pk2bf(s[2 * 33], s[3 * 33]); o.z = pk2bf(s[4 * 33], s[5 * 33]); o.w = pk2bf(s[6 * 33], s[7 * 33]);
        *(u32x4*)(WT + (size_t)(dst_row0 + n) * ldt + k0 + 8 * c) = o; }
    asm volatile("s_waitcnt lgkmcnt(0)" ::: "memory");
}
__device__ __forceinline__ int win_src_col(int n) {
    if (n < 768 || n >= 2304) return n;
    const int q = n - 768, j = q >> 8, r = q & 255;
    return r < 128 ? 768 + j * 128 + r : 1536 + j * 128 + (r - 128);
}
__device__ __forceinline__ void phase_prologue(const Params& p, LAS unsigned char* lds, int skip) {
    int tid = threadIdx.x; asm volatile("" : "+v"(tid));
    const int lane = tid & 63, wave = __builtin_amdgcn_readfirstlane(tid >> 6), gw = blockIdx.x * NWAVE + wave;
    unsigned char* ws = p.ws;
    const float* x = p.in[0]; const float* g_mix = p.in[1]; const float* w_in = p.in[2];
    const float* lam_re = p.in[6]; const float* lam_im = p.in[7]; const float* log_dt = p.in[8]; const float* b_re = p.in[9]; const float* b_im = p.in[10];
    const float* w_glu = p.in[14]; const float* w_a = p.in[16]; const float* w_b = p.in[17]; const float* w_out = p.in[18]; const float* g_ffn = p.in[19]; const float* w_q = p.in[20];
    const float* k1 = p.in[21]; const float* k2 = p.in[22]; const float* eu = p.in[23]; const float* ev = p.in[24];
    const int hw = wave & 3, ghw = blockIdx.x * 4 + hw;
    { const int hs_b = (blockIdx.x * 4) >> 6; const float* keys = (hs_b & 1) ? k2 : k1;
      if (!(skip & 1)) { for (int i = tid; i < 128 * 32; i += NTHR) *(LAS f32x4*)(lds + (size_t)i * 16) = *(const f32x4*)(keys + i * 4); }
      __syncthreads(); }
    if (wave >= 4) {
    if (!(skip & 1)) {
        const int hs = ghw >> 6, dblk = (ghw >> 2) & 15, jq = ghw & 3, d = dblk * 64 + lane;
        f32x4 wq[32];
#pragma unroll
        for (int i = 0; i < 32; ++i) wq[i] = *(const f32x4*)(w_q + (size_t)d * 2048 + hs * 128 + i * 4);
        const float gd = g_ffn[d];
        bf16_t* WS = (bf16_t*)(ws + WS_WS);
        for (int j = jq * 32; j < jq * 32 + 32; ++j) {
            const LAS f32x4* kp = (const LAS f32x4*)(lds + (size_t)j * 512); float s0 = 0.f, s1 = 0.f;
#pragma unroll
            for (int i = 0; i < 32; i += 2) { const f32x4 ka = kp[i], kb = kp[i + 1];
                s0 = fmaf(wq[i][0], ka[0], s0); s0 = fmaf(wq[i][1], ka[1], s0); s0 = fmaf(wq[i][2], ka[2], s0); s0 = fmaf(wq[i][3], ka[3], s0);
                s1 = fmaf(wq[i + 1][0], kb[0], s1); s1 = fmaf(wq[i + 1][1], kb[1], s1); s1 = fmaf(wq[i + 1][2], kb[2], s1); s1 = fmaf(wq[i + 1][3], kb[3], s1); }
            WS[(size_t)(hs * 128 + j) * D + d] = (bf16_t)(pk2bf((s0 + s1) * gd, 0.f) & 0xffffu);
        }
    }
    if (!(skip & 2)) {
        LAS float* scr = (LAS float*)(lds + 65536 + hw * 16384);
        constexpr int I_IN = 16 * 144, I_A = 12 * 32, I_B = 4 * 32, I_O = 16 * 32, I_G = 4 * 8, NIT = I_IN + I_A + I_B + I_O + I_G;
        for (int it = ghw; it < NIT; it += NGW / 2) {
            int r = it;
            if (r < I_IN) { const int kb = r / 144, nb = r % 144; transpose_item(w_in, IN_COLS, win_src_col(nb * 32), (bf16_t*)(ws + WS_WIN), 1024, nb * 32, kb * 64, g_mix, scr, lane); continue; } r -= I_IN;
            if (r < I_A) { const int kb = r / 32, nb = r % 32; transpose_item(w_a, 1024, nb * 32, (bf16_t*)(ws + WS_WA), 768, nb * 32, kb * 64, nullptr, scr, lane, 1.0f / 255.0f); continue; }     r -= I_A;
            if (r < I_B) { const int kb = r / 32, nb = r % 32; transpose_item(w_b, 1024, nb * 32, (bf16_t*)(ws + WS_WB), 256, nb * 32, kb * 64, nullptr, scr, lane, 1.0f / 255.0f); continue; } r -= I_B;
            if (r < I_O) { const int kb = r / 32, nb = r % 32; transpose_item(w_out, 1024, nb * 32, (bf16_t*)(ws + WS_WOUT), 1024, nb * 32, kb * 64, nullptr, scr, lane); continue; } r -= I_O;
            { const int kb = r / 8, nb = r % 8; transpose_item(w_glu, 256, nb * 32, (bf16_t*)(ws + WS_WGLU), 256, nb * 32, kb * 64, nullptr, scr, lane); }
        }
    }
    if (!(skip & 16)) {
        const int g = blockIdx.x >> 4, h = blockIdx.x & 15;
        const float dt = expf(log_dt[g]);
        bf16_t* MEND = (bf16_t*)(ws + WS_MEND); bf16_t* MY = (bf16_t*)(ws + WS_MY);
        {
            const int gp = g * 64 + lane; const float lr = lam_re[gp], li = lam_im[gp];
            float sn1, cs1; sincosf(li * dt, &sn1, &cs1); const float mag1 = expf(lr * dt), ar = mag1 * cs1, ai = mag1 * sn1;
            const float den = lr * lr + li * li, nr = ar - 1.0f, ni = ai, kr = (nr * lr + ni * li) / den, ki = (ni * lr - nr * li) / den;
            float bbr[16], bbi[16];
#pragma unroll
            for (int q = 0; q < 4; ++q) { const f32x4 br = *(const f32x4*)(b_re + (size_t)gp * 16 + q * 4), bi = *(const f32x4*)(b_im + (size_t)gp * 16 + q * 4);
#pragma unroll
                for (int c = 0; c < 4; ++c) { bbr[q * 4 + c] = kr * br[c] - ki * bi[c]; bbi[q * 4 + c] = kr * bi[c] + ki * br[c]; } }
            const float cr = p.in[11][(g * 16 + h) * 64 + lane], ci = p.in[12][(g * 16 + h) * 64 + lane];
            const bool b32 = lane & 32, b16 = lane & 16, b8 = lane & 8, b4 = lane & 4;
            const int jl = ((lane >> 5) & 1) * 8 + ((lane >> 4) & 1) * 4 + ((lane >> 3) & 1) * 2 + ((lane >> 2) & 1);
            LAS float* KCL = (LAS float*)(lds + 77824);
            float pr, pi; { const float d0 = (float)(hw * (CL / 4)); float sn, cs; sincosf(li * dt * d0, &sn, &cs); const float mg = expf(lr * dt * d0); pr = mg * cs; pi = mg * sn; }
#pragma unroll 1
            for (int d = hw * (CL / 4); d < (hw + 1) * (CL / 4); ++d) {
                const float wr_ = cr * pr - ci * pi, wi_ = cr * pi + ci * pr;
                float pd[16];
#pragma unroll
                for (int e = 0; e < 16; ++e) pd[e] = wr_ * bbr[e] - wi_ * bbi[e];
                float q8[8], q4[4], q2[2];
#pragma unroll
                for (int j = 0; j < 8; ++j) { const float keep = b32 ? pd[8 + j] : pd[j], send = b32 ? pd[j] : pd[8 + j]; q8[j] = keep + __shfl_xor(send, 32); }
#pragma unroll
                for (int j = 0; j < 4; ++j) { const float keep = b16 ? q8[4 + j] : q8[j], send = b16 ? q8[j] : q8[4 + j]; q4[j] = keep + __shfl_xor(send, 16); }
#pragma unroll
                for (int j = 0; j < 2; ++j) { const float keep = b8 ? q4[2 + j] : q4[j], send = b8 ? q4[j] : q4[2 + j]; q2[j] = keep + __shfl_xor(send, 8); }
                float hsum; { const float keep = b4 ? q2[1] : q2[0], send = b4 ? q2[0] : q2[1]; hsum = keep + __shfl_xor(send, 4); }
                hsum += __shfl_xor(hsum, 2); hsum += __shfl_xor(hsum, 1);
                if ((lane & 3) == 0) KCL[d * 16 + jl] = hsum;
                const float npr = pr * ar - pi * ai, npi = pr * ai + pi * ar; pr = npr; pi = npi;
            }
        }
        {
            constexpr int JP = CL / 16;
            const int it = tid - 256, n = 16 * h + (it >> 4), jseg = it & 15;
            bf16_t* rowp = MEND + (size_t)(g * 256 + n) * CK;
            if (n < 128) {
                const int gp = g * 64 + (n & 63); const float lr = lam_re[gp], li = lam_im[gp];
                float sn1, cs1; sincosf(li * dt, &sn1, &cs1); const float mag1 = expf(lr * dt), ar = mag1 * cs1, ai = mag1 * sn1;
                const float den = lr * lr + li * li, nr = ar - 1.0f, ni = ai, kr = (nr * lr + ni * li) / den, ki = (ni * lr - nr * li) / den;
                float bbr[16], bbi[16];
#pragma unroll
                for (int q = 0; q < 4; ++q) { const f32x4 br = *(const f32x4*)(b_re + (size_t)gp * 16 + q * 4), bi = *(const f32x4*)(b_im + (size_t)gp * 16 + q * 4);
#pragma unroll
                    for (int c = 0; c < 4; ++c) { bbr[q * 4 + c] = kr * br[c] - ki * bi[c]; bbi[q * 4 + c] = kr * bi[c] + ki * br[c]; } }
                float pr, pi; { const float d0 = (float)(CL - 1 - (jseg * JP + JP - 1)); float sn, cs; sincosf(li * dt * d0, &sn, &cs); const float mg = expf(lr * dt * d0); pr = mg * cs; pi = mg * sn; }
#pragma unroll
                for (int jj = JP - 1; jj >= 0; --jj) { const int jp = jseg * JP + jj;
                    float v[16];
#pragma unroll
                    for (int e = 0; e < 16; ++e) v[e] = n < 64 ? pr * bbr[e] - pi * bbi[e] : pr * bbi[e] + pi * bbr[e];
                    u32x4 o; o.x = pk2bf(v[0], v[1]); o.y = pk2bf(v[2], v[3]); o.z = pk2bf(v[4], v[5]); o.w = pk2bf(v[6], v[7]); *(u32x4*)(rowp + jp * 16) = o;
                    o.x = pk2bf(v[8], v[9]); o.y = pk2bf(v[10], v[11]); o.z = pk2bf(v[12], v[13]); o.w = pk2bf(v[14], v[15]); *(u32x4*)(rowp + jp * 16 + 8) = o;
                    const float npr = pr * ar - pi * ai, npi = pr * ai + pi * ar; pr = npr; pi = npi; }
            } else {
#pragma unroll
                for (int jj = 0; jj < JP; ++jj) { *(u32x4*)(rowp + (jseg * JP + jj) * 16) = (u32x4){0u, 0u, 0u, 0u}; *(u32x4*)(rowp + (jseg * JP + jj) * 16 + 8) = (u32x4){0u, 0u, 0u, 0u}; }
            }
        }
        {
            const int it = tid - 256, pp = it & 63, jseg = it >> 6, gp = g * 64 + pp; const float lr = lam_re[gp], li = lam_im[gp];
            float sn1, cs1; sincosf(li * dt, &sn1, &cs1); const float mag1 = expf(lr * dt), ar = mag1 * cs1, ai = mag1 * sn1;
            const float cr = p.in[11][(g * 16 + h) * 64 + pp], ci = p.in[12][(g * 16 + h) * 64 + pp];
            float pr, pi; { const float d0 = (float)(jseg * (CL / 4) + 1); float sn, cs; sincosf(li * dt * d0, &sn, &cs); const float mg = expf(lr * dt * d0); pr = mg * cs; pi = mg * sn; }
#pragma unroll 1
            for (int j = jseg * (CL / 4); j < (jseg + 1) * (CL / 4); ++j) {
                bf16_t* rowp = MY + ((size_t)(g * CK + j * 16 + h)) * SUK;
                rowp[CK + pp] = (bf16_t)(pk2bf(cr * pr - ci * pi, 0.f) & 0xffffu); rowp[CK + 64 + pp] = (bf16_t)(pk2bf(-(cr * pi + ci * pr), 0.f) & 0xffffu);
                const float npr = pr * ar - pi * ai, npi = pr * ai + pi * ar; pr = npr; pi = npi;
            }
        }
    }
    }
    if (wave < 4) {
    if (!(skip & 4)) {
        bf16_t* XB = (bf16_t*)(ws + WS_XB); float* RINV = (float*)(ws + WS_RINV);
        for (int t0 = ghw; t0 < T; t0 += 2 * NGW) {
            f32x4 a[4][4];
#pragma unroll
            for (int u = 0; u < 4; ++u) { const float* xr = x + (size_t)(t0 + u * (NGW / 2)) * D;
                a[u][0] = *(const f32x4*)(xr + lane * 8); a[u][1] = *(const f32x4*)(xr + lane * 8 + 4); a[u][2] = *(const f32x4*)(xr + 512 + lane * 8); a[u][3] = *(const f32x4*)(xr + 512 + lane * 8 + 4); }
#pragma unroll
            for (int u = 0; u < 4; ++u) { const int t = t0 + u * (NGW / 2); float sq = 0.f;
#pragma unroll
                for (int q = 0; q < 4; ++q) sq += (a[u][q][0] * a[u][q][0] + a[u][q][1] * a[u][q][1]) + (a[u][q][2] * a[u][q][2] + a[u][q][3] * a[u][q][3]);
                sq = wave_sum(sq);
                const float rsd = rsqrtf(sq * (1.0f / D) + RMS_EPS);
                if (lane == 0) RINV[t] = sqrtf(sq * (1.0f / D) + RMS_EPS);
                *(u32x4*)(XB + (size_t)t * D + lane * 8) = pack8(a[u][0] * rsd, a[u][1] * rsd); *(u32x4*)(XB + (size_t)t * D + 512 + lane * 8) = pack8(a[u][2] * rsd, a[u][3] * rsd); }
        }
    }
    if (!(skip & 8)) {
        unsigned char* UQ = ws + WS_UH; unsigned char* VQ = ws + WS_VH; float* USC = (float*)(ws + WS_USC); float* VSC = (float*)(ws + WS_VSC);
        f32x4 gf[4];
#pragma unroll
        for (int q = 0; q < 4; ++q) gf[q] = *(const f32x4*)(g_ffn + lane * 16 + q * 4);
        for (int r0 = ghw; r0 < 2 * 16384; r0 += 2 * NGW) {
            f32x4 v[4][4];
#pragma unroll
            for (int u = 0; u < 4; ++u) { const int r = r0 + u * (NGW / 2); const bool isv = r >= 16384; const int e = isv ? r - 16384 : r; const float* src = (isv ? ev : eu) + (size_t)e * D + lane * 16;
#pragma unroll
                for (int q = 0; q < 4; ++q) v[u][q] = *(const f32x4*)(src + q * 4); }
#pragma unroll
            for (int u = 0; u < 4; ++u) { const int r = r0 + u * (NGW / 2); const bool isv = r >= 16384; const int e = isv ? r - 16384 : r;
                float mx = 0.f;
#pragma unroll
                for (int q = 0; q < 4; ++q) { if (!isv) v[u][q] = v[u][q] * gf[q];
#pragma unroll
                    for (int c = 0; c < 4; ++c) mx = fmaxf(mx, fabsf(v[u][q][c])); }
#pragma unroll
                for (int o = 1; o < 64; o <<= 1) mx = fmaxf(mx, __shfl_xor(mx, o));
                const float sc = mx > 0.f ? mx * (1.0f / 127.0f) : 1.0f, inv = 1.0f / sc;
                u32x4 w;
#pragma unroll
                for (int q = 0; q < 4; ++q) { unsigned d = 0;
#pragma unroll
                    for (int c = 0; c < 4; ++c) { int qi = (int)rintf(v[u][q][c] * inv); qi = qi > 127 ? 127 : (qi < -127 ? -127 : qi); d |= ((unsigned)qi & 0xffu) << (8 * c); }
                    w[q] = d; }
                *(u32x4*)((isv ? VQ : UQ) + ((size_t)(lane >> 3) * 16384 + e) * 128 + (lane & 7) * 16) = w;
                if (lane == 0) (isv ? VSC : USC)[e] = sc; }
        }
    }
    }
    asm volatile("s_waitcnt lgkmcnt(0)" ::: "memory");
    __syncthreads();
    if (!(skip & 16)) {
        const int g = blockIdx.x >> 4, h = blockIdx.x & 15; bf16_t* MY = (bf16_t*)(ws + WS_MY); const LAS float* KCL = (const LAS float*)(lds + 77824);
        for (int it = tid; it < CL * (CK / 8); it += NTHR) {
            const int j = it / (CK / 8), kc = it % (CK / 8), jp = kc >> 1, h0 = (kc & 1) * 8;
            u32x4 w = (u32x4){0u, 0u, 0u, 0u};
            if (j >= jp) { const LAS f32x4* src = (const LAS f32x4*)(KCL + (j - jp) * 16 + h0); const f32x4 a = src[0], b = src[1]; w = pack8(a, b); }
            *(u32x4*)(MY + ((size_t)(g * CK + j * 16 + h)) * SUK + kc * 8) = w;
        }
    }
}

__device__ __forceinline__ void phase_ssm_tables(const Params& p) {
    unsigned char* ws = p.ws; const float* c_re = p.in[11]; const float* c_im = p.in[12];
    const float* POW = (const float*)(ws + WS_POW); const float* BBAR = (const float*)(ws + WS_BBAR);
    float* KC = (float*)(ws + WS_KC); bf16_t* MEND = (bf16_t*)(ws + WS_MEND);
    int tid = threadIdx.x; asm volatile("" : "+v"(tid));
    const int gt = blockIdx.x * NTHR + tid, NT = NBLK * NTHR;
    {
        const int lane = tid & 63, wave = __builtin_amdgcn_readfirstlane(tid >> 6), gw = blockIdx.x * NWAVE + wave;
        const bool b32 = lane & 32, b16 = lane & 16, b8 = lane & 8, b4 = lane & 4;
        const int jl = ((lane >> 5) & 1) * 8 + ((lane >> 4) & 1) * 4 + ((lane >> 3) & 1) * 2 + ((lane >> 2) & 1);
        for (int it = gw; it < 16 * 64 * 16; it += NGW) {
            const int g = it >> 10, d = (it >> 4) & 63, h = it & 15;
            const float cr = c_re[(g * 16 + h) * 64 + lane], ci = c_im[(g * 16 + h) * 64 + lane];
            const float pr = POW[((size_t)(g * 65 + d) * 64 + lane) * 2], pi = POW[((size_t)(g * 65 + d) * 64 + lane) * 2 + 1];
            const float wr_ = cr * pr - ci * pi, wi_ = cr * pi + ci * pr;
            const f32x4* bb = (const f32x4*)(BBAR + (size_t)(g * 64 + lane) * 32);
            float pd[16];
#pragma unroll
            for (int q = 0; q < 8; ++q) { const f32x4 v = bb[q]; pd[2 * q] = wr_ * v[0] - wi_ * v[1]; pd[2 * q + 1] = wr_ * v[2] - wi_ * v[3]; }
            float q8[8], q4[4], q2[2];
#pragma unroll
            for (int j = 0; j < 8; ++j) { const float keep = b32 ? pd[8 + j] : pd[j], send = b32 ? pd[j] : pd[8 + j]; q8[j] = keep + __shfl_xor(send, 32); }
#pragma unroll
            for (int j = 0; j < 4; ++j) { const float keep = b16 ? q8[4 + j] : q8[j], send = b16 ? q8[j] : q8[4 + j]; q4[j] = keep + __shfl_xor(send, 16); }
#pragma unroll
            for (int j = 0; j < 2; ++j) { const float keep = b8 ? q4[2 + j] : q4[j], send = b8 ? q4[j] : q4[2 + j]; q2[j] = keep + __shfl_xor(send, 8); }
            float hsum; { const float keep = b4 ? q2[1] : q2[0], send = b4 ? q2[0] : q2[1]; hsum = keep + __shfl_xor(send, 4); }
            hsum += __shfl_xor(hsum, 2); hsum += __shfl_xor(hsum, 1);
            if ((lane & 3) == 0) KC[(size_t)it * 16 + jl] = hsum;
        }
    }
    for (int i = gt; i < 16 * 256 * 128; i += NT) {
        const int g = i >> 15, n = (i >> 7) & 255, k8 = (i & 127) * 8, jp = k8 >> 4, h0 = k8 & 15;
        u32x4 o = (u32x4){0u, 0u, 0u, 0u};
        if (n < 128) {
            const int pp = n & 63; const float pr = POW[((size_t)(g * 65 + 63 - jp) * 64 + pp) * 2], pi = POW[((size_t)(g * 65 + 63 - jp) * 64 + pp) * 2 + 1];
            float v[8];
#pragma unroll
            for (int e = 0; e < 8; ++e) { const float br = BBAR[((size_t)(g * 64 + pp) * 16 + h0 + e) * 2], bi = BBAR[((size_t)(g * 64 + pp) * 16 + h0 + e) * 2 + 1];
                v[e] = n < 64 ? pr * br - pi * bi : pr * bi + pi * br; }
            o.x = pk2bf(v[0], v[1]); o.y = pk2bf(v[2], v[3]); o.z = pk2bf(v[4], v[5]); o.w = pk2bf(v[6], v[7]);
        }
        *(u32x4*)(MEND + (size_t)i * 8) = o;
    }
}

__device__ __forceinline__ void phase_conv_my(const Params& p, int first_block) {
    if ((int)blockIdx.x < first_block) return;
    unsigned char* ws = p.ws; const float* conv_w = p.in[4]; const float* conv_b = p.in[5]; const float* c_re = p.in[11]; const float* c_im = p.in[12];
    const bf16_t* CB = (const bf16_t*)(ws + WS_CB); const bf16_t* V = (const bf16_t*)(ws + WS_V); bf16_t* A2 = (bf16_t*)(ws + WS_A2);
    const float* KC = (const float*)(ws + WS_KC); const float* POW = (const float*)(ws + WS_POW); bf16_t* MY = (bf16_t*)(ws + WS_MY);
    int tid = threadIdx.x; asm volatile("" : "+v"(tid));
    const int nb = NBLK - first_block, gt = ((int)blockIdx.x - first_block) * NTHR + tid, NT = nb * NTHR;
    const int lane = tid & 63, wave = __builtin_amdgcn_readfirstlane(tid >> 6), gw = ((int)blockIdx.x - first_block) * NWAVE + wave, NW = nb * NWAVE;
    for (int i = gt; i < 96 * (T / 32); i += NT) {
        const int j8 = (i % 96) * 8, t0 = (i / 96) * 32;
        float w0[8], w1[8], w2[8], bb[8];
#pragma unroll
        for (int e = 0; e < 8; ++e) { w0[e] = conv_w[j8 + e]; w1[e] = conv_w[CONV_CH + j8 + e]; w2[e] = conv_w[2 * CONV_CH + j8 + e]; bb[e] = conv_b[j8 + e]; }
        u32x4 vm2 = (u32x4){0u, 0u, 0u, 0u}, vm1 = (u32x4){0u, 0u, 0u, 0u};
        if ((t0 & (SEQ - 1)) != 0) { vm2 = *(const u32x4*)(V + (size_t)(t0 - 2) * CONV_CH + j8); vm1 = *(const u32x4*)(V + (size_t)(t0 - 1) * CONV_CH + j8); }
#pragma unroll 4
        for (int tt = 0; tt < 32; ++tt) {
            const size_t o = (size_t)(t0 + tt) * CONV_CH + j8;
            const u32x4 cb = *(const u32x4*)(CB + o), v0 = *(const u32x4*)(V + o);
            float r[8];
#pragma unroll
            for (int e = 0; e < 8; ++e) {
                const unsigned dc = cb[e >> 1], d0 = v0[e >> 1], d1 = vm1[e >> 1], d2 = vm2[e >> 1];
                const float fc = (e & 1) ? bfhi(dc) : bflo(dc), f0 = (e & 1) ? bfhi(d0) : bflo(d0), f1 = (e & 1) ? bfhi(d1) : bflo(d1), f2 = (e & 1) ? bfhi(d2) : bflo(d2);
                r[e] = fc * (bb[e] + w0[e] * f2 + w1[e] * f1 + w2[e] * f0);
            }
            u32x4 w; w.x = pk2bf(r[0], r[1]); w.y = pk2bf(r[2], r[3]); w.z = pk2bf(r[4], r[5]); w.w = pk2bf(r[6], r[7]);
            *(u32x4*)(A2 + o) = w;
            vm2 = vm1; vm1 = v0;
        }
    }
}

__device__ __forceinline__ void phase_carry(const Params& p) {
    constexpr int NPL = CPS / 64;
    int tid = threadIdx.x; asm volatile("" : "+v"(tid));
    const int lane = tid & 63, wave = __builtin_amdgcn_readfirstlane(tid >> 6), gw = blockIdx.x * NWAVE + wave;
    unsigned char* ws = p.ws; const float* E = (const float*)(ws + WS_E); bf16_t* SU = (bf16_t*)(ws + WS_SU);
    for (int it = gw; it < (T / SEQ) * 1024; it += NGW) {
        const int b = it >> 10, g = (it >> 6) & 15, pp = it & 63;
        float ar, ai; { const float lr = p.in[6][g * 64 + pp], li = p.in[7][g * 64 + pp], dt = expf(p.in[8][g]); float sn, cs; sincosf(li * dt * (float)CL, &sn, &cs); const float mg = expf(lr * dt * (float)CL); ar = mg * cs; ai = mg * sn; }
        const size_t ch0 = (size_t)g * NCHUNK + b * CPS + NPL * lane;
        float er[NPL], ei[NPL];
#pragma unroll
        for (int k = 0; k < NPL; ++k) { er[k] = E[(ch0 + k) * 128 + pp]; ei[k] = E[(ch0 + k) * 128 + 64 + pp]; }
        float sr = 0.f, si = 0.f, mr = 1.f, mi = 0.f;
#pragma unroll
        for (int k = 0; k < NPL; ++k) { const float nr = ar * sr - ai * si + er[k], ni = ar * si + ai * sr + ei[k]; sr = nr; si = ni; const float tr = mr * ar - mi * ai, ti = mr * ai + mi * ar; mr = tr; mi = ti; }
#pragma unroll
        for (int d = 0; d < 6; ++d) { const int off = 1 << d; const float orr = __shfl_up(sr, off), oii = __shfl_up(si, off);
            if (lane >= off) { sr += mr * orr - mi * oii; si += mr * oii + mi * orr; }
            const float nmr = mr * mr - mi * mi, nmi = 2.0f * mr * mi; mr = nmr; mi = nmi; }
        float xr = __shfl_up(sr, 1), xi = __shfl_up(si, 1); if (lane == 0) { xr = 0.f; xi = 0.f; }
#pragma unroll
        for (int k = 0; k < NPL; ++k) {
            SU[(ch0 + k) * SUK + CK + pp] = (bf16_t)(pk2bf(xr, 0.f) & 0xffffu); SU[(ch0 + k) * SUK + CK + 64 + pp] = (bf16_t)(pk2bf(xi, 0.f) & 0xffffu);
            const float nr = ar * xr - ai * xi + er[k], ni = ar * xi + ai * xr + ei[k]; xr = nr; xi = ni; }
    }
}

__device__ __forceinline__ void ins16(float (&a)[16], float x, float big) {
#pragma unroll
    for (int k = 15; k >= 1; --k) a[k] = __builtin_amdgcn_fmed3f(a[k - 1], a[k], x);
    a[0] = __builtin_amdgcn_fmed3f(a[0], x, big);
}
__device__ __forceinline__ void ins16r(float (&a)[16], float x, float big, int R) {
#pragma unroll
    for (int k = 15; k >= 1; --k) if (k >= R) a[k] = __builtin_amdgcn_fmed3f(a[k - 1], a[k], x);
    if (R == 0) a[0] = __builtin_amdgcn_fmed3f(a[0], x, big);
}
__device__ __forceinline__ void phase_topk(const Params& p, LAS unsigned char* lds) {
    unsigned char* ws = p.ws; const unsigned short* SC = (const unsigned short*)(ws + WS_SC); const float* RS2P = (const float*)(ws + WS_RS2P);
    unsigned short* EIDX = (unsigned short*)(ws + WS_EIDX); unsigned short* GATE = (unsigned short*)(ws + WS_GATE);
    int tid = threadIdx.x; asm volatile("" : "+v"(tid));
    const int lane = tid & 63, wave = __builtin_amdgcn_readfirstlane(tid >> 6);
    LAS unsigned char* wst = lds + wave * 17408;
    LAS unsigned* myl = (LAS unsigned*)(wst + lane * 32);
    const float NINF = -__builtin_inff(); float BIG = 3.0e38f; asm volatile("" : "+s"(BIG));
    const int tw0 = blockIdx.x * (T / NBLK) + wave * (T / NGW);
#define TK_LOAD(it_) do { _Pragma("unroll") for (int i = 0; i < 16; ++i)     \
        r[i] = *(const u32x4*)(SC + (size_t)(tw0 + (it_) * 4 + (i >> 2)) * 2048 + (4 * (i & 3) + (lane >> 4)) * 128 + (lane & 15) * 8); } while (0)
    u32x4 r[16];
    TK_LOAD(0);
#pragma unroll 1
    for (int item = 0; item < (T / NGW) / 4; ++item) {
        const int t = tw0 + item * 4 + (lane >> 4), hs = lane & 15, h = hs >> 1, odd = lane & 1;
        f32x4 pv4[4];
#pragma unroll
        for (int q = 0; q < 4; ++q) pv4[q] = *(const f32x4*)(RS2P + (size_t)t * 16 + q * 4);
        float a[16];
#pragma unroll
        for (int k = 0; k < 16; ++k) a[k] = NINF;
        {
#pragma unroll
            for (int i = 0; i < 16; ++i) *(LAS u32x4*)(wst + (lane >> 4) * 272 + (lane & 15) * 16 + i * 1088) = r[i];
            if (item + 1 < (T / NGW) / 4) TK_LOAD(item + 1);
#pragma unroll
            for (int c = 0; c < 16; ++c) { const u32x4 v = *(const LAS u32x4*)(wst + lane * 272 + c * 16);
                float w[4];
#pragma unroll
                for (int e = 0; e < 4; ++e) { const h2 hv = as_h2(v[e]);
                    const float k0 = __uint_as_float(__float_as_uint((float)hv[0]) | (unsigned)(c * 8 + 2 * e)), k1 = __uint_as_float(__float_as_uint((float)hv[1]) | (unsigned)(c * 8 + 2 * e + 1));
                    w[e] = __builtin_amdgcn_fmed3f(k0, k1, BIG); }
                ins16(a, __builtin_amdgcn_fmed3f(w[0], w[1], BIG), BIG); ins16(a, __builtin_amdgcn_fmed3f(w[2], w[3], BIG), BIG);
                __builtin_amdgcn_sched_barrier(0); }
            { unsigned pi[15]; float l2[15];
#pragma unroll
              for (int k = 0; k < 15; ++k) pi[k] = ((__float_as_uint(a[k]) & 127u) >> 1) ^ 1u;
#pragma unroll
              for (int k = 0; k < 15; ++k) { const h2 hv = as_h2(*(const LAS unsigned*)(wst + lane * 272 + pi[k] * 4));
                  const float k0 = __uint_as_float(__float_as_uint((float)hv[0]) | (pi[k] * 2u)), k1 = __uint_as_float(__float_as_uint((float)hv[1]) | (pi[k] * 2u + 1u));
                  l2[k] = __builtin_amdgcn_fmed3f(k0, k1, BIG); }
#pragma unroll
              for (int k = 0; k < 15; ++k) ins16r(a, l2[k], BIG, k + 1); }
            unsigned li[15]; float lk[15];
#pragma unroll
            for (int k = 0; k < 15; ++k) li[k] = (__float_as_uint(a[k]) & 127u) ^ 1u;
#pragma unroll
            for (int k = 0; k < 15; ++k) { const unsigned short hb = *(const LAS unsigned short*)(wst + lane * 272 + li[k] * 2); lk[k] = __uint_as_float(__float_as_uint((float)__builtin_bit_cast(_Float16, hb)) | li[k]); }
#pragma unroll
            for (int k = 0; k < 15; ++k) ins16r(a, lk[k], BIG, k + 1);
        }
        float A[16], B[16];
#pragma unroll
        for (int k = 0; k < 16; ++k) { const float o = __shfl_xor(a[k], 1); A[k] = odd ? o : a[k]; B[k] = odd ? a[k] : o; }
        float f[16];
#pragma unroll
        for (int k = 0; k < 16; ++k) f[k] = NINF;
#pragma unroll
        for (int ia = 0; ia < 16; ++ia)
#pragma unroll
            for (int ib = 0; ib < 16; ++ib)
                if ((ia + 1) * (ib + 1) <= 16) {
                    const unsigned sb = __float_as_uint(A[ia] + B[ib]), sg = (unsigned)((int)sb >> 31);
                    ins16r(f, __uint_as_float((sb & ~255u) | ((sg ^ (255u - (unsigned)(ia * 16 + ib))) & 255u)), BIG, (ia + 1) * (ib + 1) - 1); }
        u32x4 wa, wb;
        wa.x = (__float_as_uint(A[0]) & 127u) | ((__float_as_uint(A[1]) & 127u) << 8) | ((__float_as_uint(A[2]) & 127u) << 16) | ((__float_as_uint(A[3]) & 127u) << 24);
        wa.y = (__float_as_uint(A[4]) & 127u) | ((__float_as_uint(A[5]) & 127u) << 8) | ((__float_as_uint(A[6]) & 127u) << 16) | ((__float_as_uint(A[7]) & 127u) << 24);
        wa.z = (__float_as_uint(A[8]) & 127u) | ((__float_as_uint(A[9]) & 127u) << 8) | ((__float_as_uint(A[10]) & 127u) << 16) | ((__float_as_uint(A[11]) & 127u) << 24);
        wa.w = (__float_as_uint(A[12]) & 127u) | ((__float_as_uint(A[13]) & 127u) << 8) | ((__float_as_uint(A[14]) & 127u) << 16) | ((__float_as_uint(A[15]) & 127u) << 24);
        wb.x = (__float_as_uint(B[0]) & 127u) | ((__float_as_uint(B[1]) & 127u) << 8) | ((__float_as_uint(B[2]) & 127u) << 16) | ((__float_as_uint(B[3]) & 127u) << 24);
        wb.y = (__float_as_uint(B[4]) & 127u) | ((__float_as_uint(B[5]) & 127u) << 8) | ((__float_as_uint(B[6]) & 127u) << 16) | ((__float_as_uint(B[7]) & 127u) << 24);
        wb.z = (__float_as_uint(B[8]) & 127u) | ((__float_as_uint(B[9]) & 127u) << 8) | ((__float_as_uint(B[10]) & 127u) << 16) | ((__float_as_uint(B[11]) & 127u) << 24);
        wb.w = (__float_as_uint(B[12]) & 127u) | ((__float_as_uint(B[13]) & 127u) << 8) | ((__float_as_uint(B[14]) & 127u) << 16) | ((__float_as_uint(B[15]) & 127u) << 24);
        *(LAS u32x4*)myl = wa; *(LAS u32x4*)(myl + 4) = wb;
        float ssq = 0.f;
#pragma unroll
        for (int q = 0; q < 4; ++q) { const f32x4 pv = pv4[q]; ssq += (pv[0] + pv[1]) + (pv[2] + pv[3]); }
        const float rs = rsqrtf(ssq * (1.0f / D) + RMS_EPS);
        float ex[16], sum = 0.f;
#pragma unroll
        for (int k = 0; k < 16; ++k) { ex[k] = __expf(rs * (f[k] - f[0])); sum += ex[k]; }
        const float inv = 1.0f / sum;
        int eo[8]; float go[8]; const unsigned omask = odd ? 0xffffffffu : 0u;
        const LAS unsigned char* mb = (const LAS unsigned char*)myl;
#pragma unroll
        for (int r = 0; r < 8; ++r) {
            const unsigned fsel = (__float_as_uint(f[8 + r]) & omask) | (__float_as_uint(f[r]) & ~omask);
            const unsigned code = ~(fsel ^ (unsigned)((int)fsel >> 31)) & 255u;
            const unsigned i1 = mb[code >> 4], i2 = mb[16 + (code & 15u)];
            eo[r] = (int)(i1 * 128u + i2); go[r] = __uint_as_float((__float_as_uint(ex[8 + r]) & omask) | (__float_as_uint(ex[r]) & ~omask)) * inv;
        }
        const size_t ob = ((size_t)t * 8 + h) * 16 + odd * 8;
        *(u32x4*)(EIDX + ob) = (u32x4){(unsigned)eo[0] | ((unsigned)eo[1] << 16), (unsigned)eo[2] | ((unsigned)eo[3] << 16), (unsigned)eo[4] | ((unsigned)eo[5] << 16), (unsigned)eo[6] | ((unsigned)eo[7] << 16)};
        *(u32x4*)(GATE + ob) = (u32x4){pk2h(go[0], go[1]), pk2h(go[2], go[3]), pk2h(go[4], go[5]), pk2h(go[6], go[7])};
    }
}

#undef TK_LOAD
#define LANE_OF(j) ((((j) >> 3) & 1) * 32 + (((j) >> 2) & 1) * 16 + (((j) >> 1) & 1) * 8 + ((j) & 1) * 4)
__device__ __forceinline__ void axpy4u(float* acc, unsigned d, float w) {
    acc[0] = fmaf((float)(d & 0xffu), w, acc[0]); acc[1] = fmaf((float)((d >> 8) & 0xffu), w, acc[1]);
    acc[2] = fmaf((float)((d >> 16) & 0xffu), w, acc[2]); acc[3] = fmaf((float)(d >> 24), w, acc[3]);
}
constexpr int TPB = T / NBLK, TPW = TPB / NWAVE;
constexpr int EX_EL = 0, EX_HA = TPB * 128 * 2, EX_HS = EX_HA + TPB * 128 * 4, EX_WS = EX_HS + TPB * 4, EX_SS = EX_WS + TPB * 4;
static_assert(EX_SS + TPB * 4 <= LDS_STAGE && NWAVE * 17408 <= LDS_BYTES, "expert phase / routing LDS");
__device__ __forceinline__ void phase_expert(const Params& p, LAS unsigned char* lds) {
    unsigned char* ws = p.ws;
    const bf16_t* X1B = (const bf16_t*)(ws + WS_X1B); const float* RS2P = (const float*)(ws + WS_RS2P);
    const unsigned short* EIDX = (const unsigned short*)(ws + WS_EIDX); const unsigned short* GATE = (const unsigned short*)(ws + WS_GATE);
    const unsigned char* UQ = ws + WS_UH; const unsigned char* VQ = ws + WS_VH; const float* USC = (const float*)(ws + WS_USC); const float* VSC = (const float*)(ws + WS_VSC);
    unsigned char* XQ = ws + WS_XQ;
    const float* gfin = p.in[25]; float* out = p.out;
    unsigned char* const SCb = ws + WS_SC;
    auto x2tmp = [=](size_t t) -> bf16_t* { return (bf16_t*)(SCb + t * 4096); };
    int tid = threadIdx.x; asm volatile("" : "+v"(tid));
    const int lane = tid & 63, wave = __builtin_amdgcn_readfirstlane(tid >> 6);
    const int g = lane >> 3, ch = lane & 7;
    const bool b1 = lane & 1, b2 = lane & 2, b4 = lane & 4, b8 = lane & 8, b16 = lane & 16, b32 = lane & 32;
    LAS unsigned short* EL = (LAS unsigned short*)(lds + EX_EL); LAS int* HA = (LAS int*)(lds + EX_HA);
    LAS float* HS = (LAS float*)(lds + EX_HS); LAS float* WSUM = (LAS float*)(lds + EX_WS); LAS float* SSQ = (LAS float*)(lds + EX_SS);
    const int tl0 = wave * TPW, tg0 = blockIdx.x * TPB;
#pragma unroll 1
    for (int q0 = 0; q0 < TPW; q0 += 4) {
        u32x4 xa4[4], xb4[4]; float sq4[4]; unsigned ew4[4];
#pragma unroll
        for (int u = 0; u < 4; ++u) { const size_t t = (size_t)(tg0 + tl0 + q0 + u);
            xa4[u] = *(const u32x4*)(X1B + t * D + lane * 16); xb4[u] = *(const u32x4*)(X1B + t * D + lane * 16 + 8);
            sq4[u] = (lane < 16) ? RS2P[t * 16 + lane] : 0.f; ew4[u] = *(const unsigned*)(EIDX + t * 128 + 2 * lane); }
#pragma unroll
        for (int u = 0; u < 4; ++u) { const int tl = tl0 + q0 + u; const size_t t = (size_t)(tg0 + tl); const u32x4 xa = xa4[u], xb = xb4[u];
            float xf[16];
            xf[0] = bflo(xa.x); xf[1] = bfhi(xa.x); xf[2] = bflo(xa.y); xf[3] = bfhi(xa.y); xf[4] = bflo(xa.z); xf[5] = bfhi(xa.z); xf[6] = bflo(xa.w); xf[7] = bfhi(xa.w);
            xf[8] = bflo(xb.x); xf[9] = bfhi(xb.x); xf[10] = bflo(xb.y); xf[11] = bfhi(xb.y); xf[12] = bflo(xb.z); xf[13] = bfhi(xb.z); xf[14] = bflo(xb.w); xf[15] = bfhi(xb.w);
            float mx = 0.f;
#pragma unroll
            for (int i = 0; i < 16; ++i) mx = fmaxf(mx, fabsf(xf[i]));
#pragma unroll
            for (int o = 1; o < 64; o <<= 1) mx = fmaxf(mx, __shfl_xor(mx, o));
            const float xsc = mx > 0.f ? mx * (1.0f / 127.0f) : 1.0f, xinv = 1.0f / xsc;
            u32x4 xq;
#pragma unroll
            for (int k = 0; k < 4; ++k) { unsigned d = 0;
#pragma unroll
                for (int c = 0; c < 4; ++c) d |= ((unsigned)(int)rintf(xf[k * 4 + c] * xinv) & 0xffu) << (8 * c);
                xq[k] = d; }
            *(u32x4*)(XQ + t * D + lane * 16) = xq;
            const float ssq = wave_sum(sq4[u]);
            if (lane == 0) { HS[tl] = rsqrtf(ssq * (1.0f / D) + RMS_EPS) * xsc; SSQ[tl] = 0.f; }
            *(LAS unsigned*)(EL + tl * 128 + 2 * lane) = ew4[u];
            HA[tl * 128 + lane] = 0; HA[tl * 128 + 64 + lane] = 0; }
    }
    asm volatile("s_waitcnt vmcnt(0) lgkmcnt(0)" ::: "memory");
    __syncthreads();
#define EXU_LOAD(R, XS, q_) do { const int tl_ = tl0 + (q_); XS = *(const u32x4*)(XQ + (size_t)(tg0 + tl_) * D + s * 128 + ch * 16); \
        _Pragma("unroll") for (int i = 0; i < 16; ++i) { const int e_ = EL[tl_ * 128 + 8 * i + g]; R[i] = *(const u32x4*)(usl + (unsigned)(e_ * 128 + ch * 16)); } } while (0)
#define EXU_COMP(R, XS, q_) do { const int tl_ = tl0 + (q_); int pd[16]; \
        _Pragma("unroll") for (int i = 0; i < 16; ++i) { int sd = dot4z(R[i].x, (int)XS.x); sd = __builtin_amdgcn_sdot4((int)R[i].y, (int)XS.y, sd, false); \
            sd = __builtin_amdgcn_sdot4((int)R[i].z, (int)XS.z, sd, false); sd = __builtin_amdgcn_sdot4((int)R[i].w, (int)XS.w, sd, false); pd[i] = sd; } \
        int q8[8], q4[4], q2[2]; \
        _Pragma("unroll") for (int j = 0; j < 8; ++j) { const int keep = b4 ? pd[8 + j] : pd[j], send = b4 ? pd[j] : pd[8 + j]; q8[j] = keep + __shfl_xor(send, 4); } \
        _Pragma("unroll") for (int j = 0; j < 4; ++j) { const int keep = b2 ? q8[4 + j] : q8[j], send = b2 ? q8[j] : q8[4 + j]; q4[j] = keep + __shfl_xor(send, 2); } \
        _Pragma("unroll") for (int j = 0; j < 2; ++j) { const int keep = b1 ? q4[2 + j] : q4[j], send = b1 ? q4[j] : q4[2 + j]; q2[j] = keep + __shfl_xor(send, 1); } \
        HA[tl_ * 128 + 16 * ch + g] += q2[0]; HA[tl_ * 128 + 16 * ch + 8 + g] += q2[1]; } while (0)
#pragma unroll 1
    for (int s = 0; s < 8; ++s) {
        u32x4 ra[16], rb[16], xsa, xsb; const unsigned char* usl = UQ + (size_t)s * (16384 * 128);
        EXU_LOAD(ra, xsa, 0);
#pragma unroll 1
        for (int q = 0; q < TPW; q += 2) {
            EXU_LOAD(rb, xsb, q + 1);
            EXU_COMP(ra, xsa, q);
            if (q + 2 < TPW) EXU_LOAD(ra, xsa, q + 2);
            EXU_COMP(rb, xsb, q + 1);
        }
    }
#undef EXU_LOAD
#undef EXU_COMP
#pragma unroll 1
    for (int q0 = 0; q0 < TPW; q0 += 4) {
        float hv[4][2], us[4][2], vs[4][2], gt[4][2];
#pragma unroll
        for (int u = 0; u < 4; ++u) { const int tl = tl0 + q0 + u; const size_t t = (size_t)(tg0 + tl);
#pragma unroll
            for (int hlf = 0; hlf < 2; ++hlf) { const int k = hlf * 64 + lane; const int e = EL[tl * 128 + k];
                hv[u][hlf] = (float)HA[tl * 128 + k]; us[u][hlf] = USC[e]; vs[u][hlf] = VSC[e]; gt[u][hlf] = (float)__builtin_bit_cast(_Float16, GATE[t * 128 + k]); } }
#pragma unroll
        for (int u = 0; u < 4; ++u) { const int tl = tl0 + q0 + u; const float hs = HS[tl];
            float w2[2];
#pragma unroll
            for (int hlf = 0; hlf < 2; ++hlf) w2[hlf] = gt[u][hlf] * gelu_exact(hv[u][hlf] * (hs * us[u][hlf])) * vs[u][hlf];
            float wm = fmaxf(fabsf(w2[0]), fabsf(w2[1]));
#pragma unroll
            for (int o = 1; o < 64; o <<= 1) wm = fmaxf(wm, __shfl_xor(wm, o));
            const float wsc = wm > 0.f ? wm * (1.0f / 127.0f) : 1.0f, winv = 1.0f / wsc;
            LAS signed char* WQ = (LAS signed char*)(HA + tl * 128);
#pragma unroll
            for (int hlf = 0; hlf < 2; ++hlf) { const int i = hlf * 8 + (lane >> 3), gg = lane & 7;
                WQ[((i >> 2) * 8 + gg) * 4 + (i & 3)] = (signed char)(int)rintf(w2[hlf] * winv); }
            if (lane == 0) WSUM[tl] = wsc; }
    }
#define EXV_LOAD(R, XR, q_) do { const int tl_ = tl0 + (q_); XR = *(const unsigned*)(X1B + (size_t)(tg0 + tl_) * D + s * 128 + ch * 16 + 2 * g); \
        _Pragma("unroll") for (int i = 0; i < 16; ++i) { const int e_ = EL[tl_ * 128 + 8 * i + g]; R[i] = *(const u32x4*)(vsl + (unsigned)(e_ * 128 + ch * 16)); } } while (0)
#define EXV_COMP(R, XR, q_) do { const int tl_ = tl0 + (q_); const size_t t_ = (size_t)(tg0 + tl_); int acc[16]; \
        _Pragma("unroll") for (int a = 0; a < 4; ++a) { const int wd = HA[tl_ * 128 + a * 8 + g]; \
            _Pragma("unroll") for (int c4 = 0; c4 < 4; ++c4) { const unsigned x0 = R[4 * a][c4], x1 = R[4 * a + 1][c4], x2 = R[4 * a + 2][c4], x3 = R[4 * a + 3][c4]; \
                const unsigned p01l = __builtin_amdgcn_perm(x1, x0, 0x05010400u), p01h = __builtin_amdgcn_perm(x1, x0, 0x07030602u), p23l = __builtin_amdgcn_perm(x3, x2, 0x05010400u), p23h = __builtin_amdgcn_perm(x3, x2, 0x07030602u); \
                { const unsigned tb_ = __builtin_amdgcn_perm(p23l, p01l, 0x05040100u); acc[4 * c4 + 0] = (a == 0) ? dot4z(tb_, wd) : __builtin_amdgcn_sdot4((int)tb_, wd, acc[4 * c4 + 0], false); } \
                { const unsigned tb_ = __builtin_amdgcn_perm(p23l, p01l, 0x07060302u); acc[4 * c4 + 1] = (a == 0) ? dot4z(tb_, wd) : __builtin_amdgcn_sdot4((int)tb_, wd, acc[4 * c4 + 1], false); } \
                { const unsigned tb_ = __builtin_amdgcn_perm(p23h, p01h, 0x05040100u); acc[4 * c4 + 2] = (a == 0) ? dot4z(tb_, wd) : __builtin_amdgcn_sdot4((int)tb_, wd, acc[4 * c4 + 2], false); } \
                { const unsigned tb_ = __builtin_amdgcn_perm(p23h, p01h, 0x07060302u); acc[4 * c4 + 3] = (a == 0) ? dot4z(tb_, wd) : __builtin_amdgcn_sdot4((int)tb_, wd, acc[4 * c4 + 3], false); } } } \
        int r8[8], r4[4], r2[2]; \
        _Pragma("unroll") for (int j = 0; j < 8; ++j) { const int keep = b32 ? acc[8 + j] : acc[j], send = b32 ? acc[j] : acc[8 + j]; r8[j] = keep + __shfl_xor(send, 32); } \
        _Pragma("unroll") for (int j = 0; j < 4; ++j) { const int keep = b16 ? r8[4 + j] : r8[j], send = b16 ? r8[j] : r8[4 + j]; r4[j] = keep + __shfl_xor(send, 16); } \
        _Pragma("unroll") for (int j = 0; j < 2; ++j) { const int keep = b8 ? r4[2 + j] : r4[j], send = b8 ? r4[j] : r4[2 + j]; r2[j] = keep + __shfl_xor(send, 8); } \
        const size_t o_ = t_ * D + s * 128 + ch * 16 + 2 * g; const float wsc_ = WSUM[tl_];     \
        const unsigned xr_ = XR; \
        const float v0_ = bflo(xr_) + wsc_ * (float)r2[0], v1_ = bfhi(xr_) + wsc_ * (float)r2[1]; \
        *(unsigned*)(x2tmp(t_) + s * 128 + ch * 16 + 2 * g) = pk2bf(v0_, v1_);     \
        float ss_ = v0_ * v0_ + v1_ * v1_; ss_ = wave_sum(ss_); \
        if (lane == 0) SSQ[tl_] += ss_; } while (0)
#pragma unroll 1
    for (int s = 0; s < 8; ++s) {
        u32x4 ra[16], rb[16]; unsigned xra, xrb; const unsigned char* vsl = VQ + (size_t)s * (16384 * 128);
        EXV_LOAD(ra, xra, 0);
#pragma unroll 1
        for (int q = 0; q < TPW; q += 2) {
            EXV_LOAD(rb, xrb, q + 1);
            EXV_COMP(ra, xra, q);
            if (q + 2 < TPW) EXV_LOAD(ra, xra, q + 2);
            EXV_COMP(rb, xrb, q + 1);
        }
    }
#undef EXV_LOAD
#undef EXV_COMP
    asm volatile("s_waitcnt vmcnt(0) lgkmcnt(0)" ::: "memory");
    const f32x4 gn0 = *(const f32x4*)(gfin + lane * 16), gn1 = *(const f32x4*)(gfin + lane * 16 + 4), gn2 = *(const f32x4*)(gfin + lane * 16 + 8), gn3 = *(const f32x4*)(gfin + lane * 16 + 12);
#pragma unroll 1
    for (int q0 = 0; q0 < TPW; q0 += 4) {
        u32x4 xa4[4], xb4[4];
#pragma unroll
        for (int u = 0; u < 4; ++u) { const bf16_t* xrow = x2tmp((size_t)(tg0 + tl0 + q0 + u)) + lane * 16; xa4[u] = *(const u32x4*)xrow; xb4[u] = *(const u32x4*)(xrow + 8); }
#pragma unroll
        for (int u = 0; u < 4; ++u) { const int tl = tl0 + q0 + u; const size_t t = (size_t)(tg0 + tl); const u32x4 xa = xa4[u], xb = xb4[u];
            const float rn = rsqrtf(SSQ[tl] * (1.0f / D) + RMS_EPS);
            float* orow = out + t * D + lane * 16;
            *(f32x4*)(orow) = (f32x4){bflo(xa.x), bfhi(xa.x), bflo(xa.y), bfhi(xa.y)} * rn * gn0;
            *(f32x4*)(orow + 4) = (f32x4){bflo(xa.z), bfhi(xa.z), bflo(xa.w), bfhi(xa.w)} * rn * gn1;
            *(f32x4*)(orow + 8) = (f32x4){bflo(xb.x), bfhi(xb.x), bflo(xb.y), bfhi(xb.y)} * rn * gn2;
            *(f32x4*)(orow + 12) = (f32x4){bflo(xb.z), bfhi(xb.z), bflo(xb.w), bfhi(xb.w)} * rn * gn3; }
    }
}

#if DBG
constexpr int SSM_CH = 256, SSM_GROUPS = 16, SSM_STATE = 64, SSM_GROUP = 16;
constexpr int PEER_HEADS = 8, PEER_KEYS = 128, PEER_HALF = 128, PEER_TOPK = 16, PEER_QD = 2048;
__device__ __forceinline__ float sigm_n(float v) { return 1.0f / (1.0f + expf(-v)); }
__global__ void __launch_bounds__(256) ngemm(const float* __restrict__ A, int lda, const float* __restrict__ B, int ldb,
                                             float* __restrict__ C, int ldc, int M, int N, int K) {
    __shared__ float As[16][64 + 4];
    __shared__ float Bs[16][64 + 4];
    const int tx = threadIdx.x & 15, ty = threadIdx.x >> 4;
    const int bm = blockIdx.y * 64, bn = blockIdx.x * 64;
    float acc[4][4] = {};
    for (int k0 = 0; k0 < K; k0 += 16) {
        {
            const int r = threadIdx.x >> 2, c4 = (threadIdx.x & 3) * 4;
            const float4 v = *(const float4*)(A + (size_t)(bm + r) * lda + k0 + c4);
            As[c4 + 0][r] = v.x; As[c4 + 1][r] = v.y; As[c4 + 2][r] = v.z; As[c4 + 3][r] = v.w;
            const int rb = threadIdx.x >> 4, cb4 = (threadIdx.x & 15) * 4;
            const float4 w = *(const float4*)(B + (size_t)(k0 + rb) * ldb + bn + cb4);
            Bs[rb][cb4 + 0] = w.x; Bs[rb][cb4 + 1] = w.y; Bs[rb][cb4 + 2] = w.z; Bs[rb][cb4 + 3] = w.w;
        }
        __syncthreads();
#pragma unroll
        for (int k = 0; k < 16; ++k) {
            float a[4], b[4];
#pragma unroll
            for (int i = 0; i < 4; ++i) a[i] = As[k][ty * 4 + i];
#pragma unroll
            for (int j = 0; j < 4; ++j) b[j] = Bs[k][tx * 4 + j];
#pragma unroll
            for (int i = 0; i < 4; ++i)
#pragma unroll
                for (int j = 0; j < 4; ++j) acc[i][j] = fmaf(a[i], b[j], acc[i][j]);
        }
        __syncthreads();
    }
#pragma unroll
    for (int i = 0; i < 4; ++i) {
        float4 o = make_float4(acc[i][0], acc[i][1], acc[i][2], acc[i][3]);
        *(float4*)(C + (size_t)(bm + ty * 4 + i) * ldc + bn + tx * 4) = o;
    }
}

__global__ void __launch_bounds__(256) n_rmsnorm(const float* __restrict__ x, const float* __restrict__ g, float* __restrict__ y) {
    __shared__ float red[4];
    const size_t row = blockIdx.x;
    const float4 v = *(const float4*)(x + row * D + threadIdx.x * 4);
    float s = v.x * v.x + v.y * v.y + v.z * v.z + v.w * v.w;
    for (int o = 32; o > 0; o >>= 1) s += __shfl_xor(s, o);
    if ((threadIdx.x & 63) == 0) red[threadIdx.x >> 6] = s;
    __syncthreads();
    const float tot = red[0] + red[1] + red[2] + red[3];
    const float r = rsqrtf(tot * (1.0f / D) + RMS_EPS);
    const float4 gg = *(const float4*)(g + threadIdx.x * 4);
    float4 o = make_float4(v.x * r * gg.x, v.y * r * gg.y, v.z * r * gg.z, v.w * r * gg.w);
    *(float4*)(y + row * D + threadIdx.x * 4) = o;
}

__global__ void __launch_bounds__(256) n_conv(const float* __restrict__ proj, const float* __restrict__ cw, const float* __restrict__ cbias,
                                              float* __restrict__ am, int S) {
    const size_t i = (size_t)blockIdx.x * 256 + threadIdx.x;
    const int t = (int)(i / CONV_CH), j = (int)(i % CONV_CH);
    if (t >= S) return;
    const float* pr = proj + (size_t)t * IN_COLS;
    float y = cbias[j];
#pragma unroll
    for (int k = 0; k < 3; ++k) {
        const int tt = t - 2 + k;
        if (tt >= 0) { const float* q = proj + (size_t)tt * IN_COLS; y += cw[k * CONV_CH + j] * (q[CONV_CH + j] * q[2 * CONV_CH + j]); }
    }
    am[(size_t)t * CONV_CH + j] = pr[j] * y;
}

__global__ void n_ssm_const(const float* lam_re, const float* lam_im, const float* log_dt, float* cst) {
    const int i = blockIdx.x * blockDim.x + threadIdx.x;
    if (i >= 1024) return;
    const int g = i >> 6;
    const float lr = lam_re[i], li = lam_im[i], dt = expf(log_dt[g]);
    const float mag = expf(lr * dt), ang = li * dt;
    const float ar = mag * cosf(ang), ai = mag * sinf(ang);
    const float den = lr * lr + li * li, nr = ar - 1.0f, ni = ai;
    cst[i] = ar; cst[1024 + i] = ai; cst[2048 + i] = (nr * lr + ni * li) / den; cst[3072 + i] = (ni * lr - nr * li) / den;
}
__global__ void __launch_bounds__(256) n_ssm_x(const float* __restrict__ proj, const float* __restrict__ bre, const float* __restrict__ bim,
                                               const float* __restrict__ cst, float* __restrict__ xr, float* __restrict__ xi, int S) {
    const size_t i = (size_t)blockIdx.x * 256 + threadIdx.x;
    const int t = (int)(i >> 10), gp = (int)(i & 1023), g = gp >> 6;
    if (t >= S) return;
    const float* u = proj + (size_t)t * IN_COLS + 3 * CONV_CH + g * 16;
    float br = 0.f, bi = 0.f;
#pragma unroll
    for (int h = 0; h < 16; ++h) { br = fmaf(u[h], bre[gp * 16 + h], br); bi = fmaf(u[h], bim[gp * 16 + h], bi); }
    const float kr = cst[2048 + gp], ki = cst[3072 + gp];
    xr[i] = kr * br - ki * bi; xi[i] = kr * bi + ki * br;
}
__global__ void __launch_bounds__(256) n_ssm_scan(const float* __restrict__ cst, float* __restrict__ xr, float* __restrict__ xi, int S) {
    const int gp = blockIdx.x * 256 + threadIdx.x;
    const float ar = cst[gp], ai = cst[1024 + gp];
    float sr = 0.f, si = 0.f;
    for (int t = 0; t < S; ++t) {
        const size_t o = (size_t)t * 1024 + gp;
        const float a = xr[o], b = xi[o];
        const float nr = ar * sr - ai * si + a, ni = ar * si + ai * sr + b;
        sr = nr; si = ni; xr[o] = sr; xi[o] = si;
    }
}
__global__ void __launch_bounds__(256) n_ssm_y(const float* __restrict__ proj, const float* __restrict__ sr, const float* __restrict__ si,
                                               const float* __restrict__ cre, const float* __restrict__ cim, const float* __restrict__ dsk,
                                               float* __restrict__ z, int S) {
    const size_t i = (size_t)blockIdx.x * 256 + threadIdx.x;
    const int t = (int)(i >> 8), c = (int)(i & 255), g = c >> 4;
    if (t >= S) return;
    const float* a = sr + (size_t)t * 1024 + g * 64; const float* b = si + (size_t)t * 1024 + g * 64;
    float y = 0.f;
    for (int p = 0; p < 64; ++p) y += a[p] * cre[c * 64 + p] - b[p] * cim[c * 64 + p];
    y += dsk[c] * proj[(size_t)t * IN_COLS + 3 * CONV_CH + c];
    z[i] = gelu_exact(y);
}
__global__ void __launch_bounds__(256) n_glu(const float* __restrict__ z, const float* __restrict__ lin, const float* __restrict__ bglu, float* __restrict__ o, size_t n) {
    const size_t i = (size_t)blockIdx.x * 256 + threadIdx.x; if (i >= n) return;
    o[i] = z[i] * sigm_n(lin[i] + bglu[i & 255]);
}
__global__ void __launch_bounds__(256) n_merge(const float* __restrict__ proj, const float* __restrict__ bg, const float* __restrict__ ya,
                                               const float* __restrict__ yb, float* __restrict__ m, size_t n) {
    const size_t i = (size_t)blockIdx.x * 256 + threadIdx.x; if (i >= n) return;
    const size_t t = i >> 10; const int d = (int)(i & 1023);
    const float* gl = proj + t * IN_COLS + 3 * CONV_CH + SSM_CH;
    m[i] = sigm_n(gl[d] + bg[d]) * ya[i] + sigm_n(gl[D + d] + bg[D + d]) * yb[i];
}
__global__ void __launch_bounds__(256) n_add(const float* __restrict__ a, float* __restrict__ b, size_t n) {
    const size_t i = (size_t)blockIdx.x * 256 + threadIdx.x; if (i >= n) return; b[i] += a[i];
}

__device__ __forceinline__ void wave_argmax(float& v, int& idx) {
    for (int o = 32; o > 0; o >>= 1) {
        const float ov = __shfl_xor(v, o); const int oi = __shfl_xor(idx, o);
        if (ov > v || (ov == v && oi < idx)) { v = ov; idx = oi; }
    }
}
__global__ void __launch_bounds__(256) n_route(const float* __restrict__ q, const float* __restrict__ k1, const float* __restrict__ k2,
                                               int* __restrict__ eidx, float* __restrict__ gate) {
    __shared__ float qs[PEER_QD];
    __shared__ float sc[PEER_QD];
    __shared__ float tv[16][16]; __shared__ int ti[16][16];
    const size_t t = blockIdx.x; const int tid = threadIdx.x, lane = tid & 63, w = tid >> 6;
    for (int i = tid; i < PEER_QD; i += 256) qs[i] = q[t * PEER_QD + i];
    __syncthreads();
    for (int i = tid; i < PEER_QD; i += 256) {
        const int hs = i >> 7, n = i & 127, side = hs & 1;
        const float* kk = (side ? k2 : k1) + n * PEER_HALF; const float* qq = qs + hs * 128;
        float s = 0.f;
        for (int k = 0; k < 128; ++k) s = fmaf(qq[k], kk[k], s);
        sc[i] = s;
    }
    __syncthreads();
    for (int gi = 0; gi < 4; ++gi) {
        const int grp = w * 4 + gi;
        float a0 = sc[grp * 128 + lane], a1 = sc[grp * 128 + 64 + lane];
        for (int it = 0; it < 16; ++it) {
            float v; int idx;
            if (a0 >= a1) { v = a0; idx = lane; } else { v = a1; idx = lane + 64; }
            wave_argmax(v, idx);
            if (lane == 0) { tv[grp][it] = v; ti[grp][it] = idx; }
            if (idx == lane) a0 = -INFINITY; if (idx == lane + 64) a1 = -INFINITY;
        }
    }
    __syncthreads();
    for (int hh = 0; hh < 2; ++hh) {
        const int h = w * 2 + hh;
        float c[4]; int ci[4];
#pragma unroll
        for (int j = 0; j < 4; ++j) { const int pos = j * 64 + lane, a = pos >> 4, b = pos & 15; c[j] = tv[2 * h][a] + tv[2 * h + 1][b]; ci[j] = pos; }
        float bestv = 0.f; int beste = 0; float mx = 0.f;
        for (int it = 0; it < 16; ++it) {
            float v = c[0]; int idx = ci[0];
#pragma unroll
            for (int j = 1; j < 4; ++j) if (c[j] > v) { v = c[j]; idx = ci[j]; }
            wave_argmax(v, idx);
#pragma unroll
            for (int j = 0; j < 4; ++j) if (ci[j] == idx) c[j] = -INFINITY;
            if (it == 0) mx = v;
            if (lane == it) { bestv = v; beste = ti[2 * h][idx >> 4] * PEER_KEYS + ti[2 * h + 1][idx & 15]; }
        }
        float e = (lane < 16) ? expf(bestv - mx) : 0.f;
        float s = e; for (int o = 32; o > 0; o >>= 1) s += __shfl_xor(s, o);
        if (lane < 16) { eidx[t * 128 + h * 16 + lane] = beste; gate[t * 128 + h * 16 + lane] = e / s; }
    }
}

__global__ void __launch_bounds__(256) n_expert(const float* __restrict__ xn, const float* __restrict__ x1, const int* __restrict__ eidx,
                                                const float* __restrict__ gate, const float* __restrict__ eu, const float* __restrict__ ev,
                                                const float* __restrict__ gfin, float* __restrict__ out) {
    const size_t t = (size_t)blockIdx.x * 4 + (threadIdx.x >> 6); const int lane = threadIdx.x & 63;
    float4 xv[4], acc[4];
#pragma unroll
    for (int i = 0; i < 4; ++i) { xv[i] = *(const float4*)(xn + t * D + i * 256 + lane * 4); acc[i] = make_float4(0.f, 0.f, 0.f, 0.f); }
    for (int k = 0; k < 128; ++k) {
        const int e = eidx[t * 128 + k]; const float gt = gate[t * 128 + k];
        const float* ur = eu + (size_t)e * D; const float* vr = ev + (size_t)e * D;
        float s = 0.f;
#pragma unroll
        for (int i = 0; i < 4; ++i) { const float4 u = *(const float4*)(ur + i * 256 + lane * 4); s += u.x * xv[i].x + u.y * xv[i].y + u.z * xv[i].z + u.w * xv[i].w; }
        for (int o = 32; o > 0; o >>= 1) s += __shfl_xor(s, o);
        const float wgt = gt * gelu_exact(s);
#pragma unroll
        for (int i = 0; i < 4; ++i) { const float4 v = *(const float4*)(vr + i * 256 + lane * 4);
            acc[i].x = fmaf(wgt, v.x, acc[i].x); acc[i].y = fmaf(wgt, v.y, acc[i].y); acc[i].z = fmaf(wgt, v.z, acc[i].z); acc[i].w = fmaf(wgt, v.w, acc[i].w); }
    }
    float ss = 0.f;
#pragma unroll
    for (int i = 0; i < 4; ++i) { const float4 r = *(const float4*)(x1 + t * D + i * 256 + lane * 4);
        acc[i].x += r.x; acc[i].y += r.y; acc[i].z += r.z; acc[i].w += r.w;
        ss += acc[i].x * acc[i].x + acc[i].y * acc[i].y + acc[i].z * acc[i].z + acc[i].w * acc[i].w; }
    for (int o = 32; o > 0; o >>= 1) ss += __shfl_xor(ss, o);
    const float r = rsqrtf(ss * (1.0f / D) + RMS_EPS);
#pragma unroll
    for (int i = 0; i < 4; ++i) { const float4 g = *(const float4*)(gfin + i * 256 + lane * 4);
        *(float4*)(out + t * D + i * 256 + lane * 4) = make_float4(acc[i].x * r * g.x, acc[i].y * r * g.y, acc[i].z * r * g.z, acc[i].w * r * g.w); }
}


__device__ __forceinline__ float bf_at(const bf16_t* p, size_t i) { return __uint_as_float(((unsigned)p[i]) << 16); }
template <class F> __device__ __forceinline__ void dbg_cmp(unsigned char* ws, int id, int rows, int cols, F f) {
    float e2 = 0.f, r2 = 0.f;
    const size_t n = (size_t)rows * cols;
    int tid = threadIdx.x; asm volatile("" : "+v"(tid));
    for (size_t i = (size_t)blockIdx.x * NTHR + tid; i < n; i += (size_t)NBLK * NTHR) { float a, b; f((int)(i / cols), (int)(i % cols), a, b); e2 += (a - b) * (a - b); r2 += b * b; }
    e2 = wave_sum(e2); r2 = wave_sum(r2);
    if ((tid & 63) == 0) { atomicAdd((float*)(ws + DB_ACC) + id * 2, e2); atomicAdd((float*)(ws + DB_ACC) + id * 2 + 1, r2); }
}
__global__ void dbg_report(const float* acc, float* out, int n, int first_id) {
    float c = 0.f;
    for (int id = first_id; id < 32; ++id) { const float e2 = acc[id * 2], r2 = acc[id * 2 + 1]; if (r2 <= 0.f) continue; const float rel = sqrtf(e2 / r2);
        const float thr = id == 12 ? 0.22f : id == 13 ? 0.1f : DBG_THR;
        if (rel > thr || !(rel == rel)) { int d = (rel == rel) ? (int)(-4.0f * log10f(fminf(rel, 1.0f)) + 0.5f) : 9; if (d > 9) d = 9; c = sqrtf((float)(id * 10 + d) - 1.0f); break; } }
    for (int i = blockIdx.x * blockDim.x + threadIdx.x; i < n; i += gridDim.x * blockDim.x) out[i] = c;
}
#endif
__global__ void __launch_bounds__(512, 2) fwd_megakernel(Params p) {
    extern __shared__ __attribute__((aligned(16))) unsigned char smem[];
    LAS unsigned char* lds = (LAS unsigned char*)smem;
    unsigned char* ws = p.ws;
    volatile LAS unsigned* bst = (volatile LAS unsigned*)(lds + LDS_MISC);
    if (threadIdx.x < 4) bst[threadIdx.x] = 0u;
    *(LAS f32x4*)(lds + LDS_GBIAS + threadIdx.x * 16) = *(const f32x4*)(p.in[3] + threadIdx.x * 4);
    __syncthreads();
    XcdBarrier bar = xcd_barrier_post((unsigned*)(ws + WS_CTL), bst);
    Order S;
    TSTAMP(0);
    for (int rep_ah = 0; rep_ah < REP_AH; ++rep_ah) {
    for (int rp_ = 0; rp_ < (REP_PH == 1 ? 2 : 1); ++rp_) {
    phase_prologue(p, lds, rp_ ? SKIPA : 0);
    xcd_barrier(bar); TSTAMP(1);
    }
    for (int rp_ = 0; rp_ < (REP_PH == 2 ? 2 : 1); ++rp_) {
    { Gemm g{(const bf16_t*)(ws + WS_XB), (const bf16_t*)(ws + WS_WIN), 1024, 1024, 1024, 0, 0}; S.init(T, IN_COLS, 1, 0);
      EpiG1 e{(const LAS float*)(lds + LDS_GBIAS), (bf16_t*)(ws + WS_CB), (bf16_t*)(ws + WS_V), (bf16_t*)(ws + WS_SU), ws + WS_G};
      if (NULLG1 == 1 && rp_) { EpiNull en; gemm_phase(lds, g, S, en); } else if (NULLG1 == 2 && rp_) { EpiG1T<true> en{(const LAS float*)(lds + LDS_GBIAS), nullptr, nullptr, nullptr, nullptr}; gemm_phase(lds, g, S, en); } else
      gemm_phase(lds, g, S, e); }
    xcd_barrier(bar); TSTAMP(2);
    DBGC({ const float* pj = (const float*)(ws + DB_PROJ); const float* bg = p.in[3];
      const bf16_t* CBp = (const bf16_t*)(ws + WS_CB); const bf16_t* Vp = (const bf16_t*)(ws + WS_V); const bf16_t* SUp = (const bf16_t*)(ws + WS_SU); const bf16_t* Gp = (const bf16_t*)(ws + WS_G);
      dbg_cmp(ws, 1, NB, 768, [=](int t, int c, float& a, float& b) { a = bf_at(CBp, (size_t)t * 768 + c); b = pj[(size_t)t * IN_COLS + c]; });
      dbg_cmp(ws, 2, NB, 768, [=](int t, int c, float& a, float& b) { a = bf_at(Vp, (size_t)t * 768 + c); b = pj[(size_t)t * IN_COLS + 768 + c] * pj[(size_t)t * IN_COLS + 1536 + c]; });
      dbg_cmp(ws, 3, NB, 256, [=](int t, int c, float& a, float& b) { a = bf_at(SUp, ((size_t)(c >> 4) * NCHUNK + (t >> LOGCL)) * SUK + (t & (CL - 1)) * 16 + (c & 15)); b = pj[(size_t)t * IN_COLS + 2304 + c]; });
      dbg_cmp(ws, 4, NB, 2048, [=](int t, int c, float& a, float& b) { a = bf_at(Gp, (size_t)t * 2048 + c); b = sigm_n(pj[(size_t)t * IN_COLS + 2560 + c] + bg[c]); }); })
    }
    for (int rp_ = 0; rp_ < (REP_PH == 3 ? 2 : 1); ++rp_) {
    phase_conv_my(p, 16 * (NCHUNK / BM));
    { Gemm g{(const bf16_t*)(ws + WS_SU), (const bf16_t*)(ws + WS_MEND), SUK, CK, CK, (long)NCHUNK * SUK, (long)256 * CK}; S.init(NCHUNK, 256, 16, 0); S.window(0, S.u1, 0, 16 * (NCHUNK / BM));
      EpiE e{(float*)(ws + WS_E)}; gemm_phase(lds, g, S, e); }
    xcd_barrier(bar); TSTAMP(3);
    DBGC({ const bf16_t* A2p = (const bf16_t*)(ws + WS_A2); const float* am = (const float*)(ws + DB_AM);
      dbg_cmp(ws, 5, NB, 768, [=](int t, int c, float& a, float& b) { a = bf_at(A2p, (size_t)t * 768 + c); b = am[(size_t)t * 768 + c]; }); })
    }
    for (int rp_ = 0; rp_ < (REP_PH == 4 ? 2 : 1); ++rp_) {
    phase_carry(p);
    { Gemm g{(const bf16_t*)(ws + WS_A2), (const bf16_t*)(ws + WS_WA), 768, 768, 768, 0, 0}; S.init(T, 1024, 1, 0); S.window(0, S.u1 / 2, 0, NBLK);
      EpiP e{ws + WS_G, (bf16_t*)(ws + WS_P)}; gemm_phase(lds, g, S, e); }
    xcd_barrier(bar); TSTAMP(4);
    }
    for (int rp_ = 0; rp_ < (REP_PH == 5 ? 2 : 1); ++rp_) {
    { Gemm g{(const bf16_t*)(ws + WS_SU), (const bf16_t*)(ws + WS_MY), SUK, SUK, SUK, (long)NCHUNK * SUK, (long)CK * SUK}; S.init(NCHUNK, CK, 16, 0); S.window(0, S.u1, 0, NBLK / 2);
      EpiY e{(const bf16_t*)(ws + WS_SU), p.in[13], (bf16_t*)(ws + WS_Z)}; gemm_phase(lds, g, S, e); }
    { Gemm g{(const bf16_t*)(ws + WS_A2), (const bf16_t*)(ws + WS_WA), 768, 768, 768, 0, 0}; S.init(T, 1024, 1, 0); S.window(S.u1 / 2, S.u1, NBLK / 2, NBLK / 2);
      EpiP e{ws + WS_G, (bf16_t*)(ws + WS_P)}; gemm_phase(lds, g, S, e); }
    xcd_barrier(bar); TSTAMP(5);
    DBGC({ const bf16_t* Pp = (const bf16_t*)(ws + WS_P); const float* ya = (const float*)(ws + DB_YA); const float* pj = (const float*)(ws + DB_PROJ); const float* bg = p.in[3];
      dbg_cmp(ws, 6, NB, 1024, [=](int t, int c, float& a, float& b) { a = bf_at(Pp, (size_t)t * 1024 + c); b = ya[(size_t)t * 1024 + c] * sigm_n(pj[(size_t)t * IN_COLS + 2560 + c] + bg[c]); }); })
    DBGC({ const bf16_t* Zp = (const bf16_t*)(ws + WS_Z); const float* zn = (const float*)(ws + DB_Z);
      dbg_cmp(ws, 7, NB, 256, [=](int t, int c, float& a, float& b) { a = bf_at(Zp, (size_t)t * 256 + c); b = zn[(size_t)t * 256 + c]; }); })
    }
    for (int rp_ = 0; rp_ < (REP_PH == 6 ? 2 : 1); ++rp_) {
    { Gemm g{(const bf16_t*)(ws + WS_Z), (const bf16_t*)(ws + WS_WGLU), 256, 256, 256, 0, 0}; S.init(T, 256, 1, 0);
      EpiGlu e{(const bf16_t*)(ws + WS_Z), p.in[15], (bf16_t*)(ws + WS_S5)}; gemm_phase(lds, g, S, e); }
    xcd_barrier(bar); TSTAMP(6);
    DBGC({ const bf16_t* Sp = (const bf16_t*)(ws + WS_S5); const float* sn = (const float*)(ws + DB_S5);
      dbg_cmp(ws, 8, NB, 256, [=](int t, int c, float& a, float& b) { a = bf_at(Sp, (size_t)t * 256 + c); b = sn[(size_t)t * 256 + c]; }); })
    }
    for (int rp_ = 0; rp_ < (REP_PH == 7 ? 2 : 1); ++rp_) {
    { Gemm g{(const bf16_t*)(ws + WS_S5), (const bf16_t*)(ws + WS_WB), 256, 256, 256, 0, 0}; S.init(T, 1024, 1, 0);
      EpiMerge e{ws + WS_G, (const bf16_t*)(ws + WS_P), (bf16_t*)(ws + WS_MG)}; gemm_phase(lds, g, S, e); }
    xcd_barrier(bar); TSTAMP(7);
    DBGC({ const bf16_t* Mp = (const bf16_t*)(ws + WS_MG); const float* mn = (const float*)(ws + DB_MG);
      dbg_cmp(ws, 9, NB, 1024, [=](int t, int c, float& a, float& b) { a = bf_at(Mp, (size_t)t * 1024 + c); b = mn[(size_t)t * 1024 + c]; }); })
    }
    for (int rp_ = 0; rp_ < (REP_PH == 8 ? 2 : 1); ++rp_) {
    { Gemm g{(const bf16_t*)(ws + WS_MG), (const bf16_t*)(ws + WS_WOUT), 1024, 1024, 1024, 0, 0}; S.init(T, 1024, 1, 0);
      EpiX1 e{(const float*)(ws + WS_RINV), (bf16_t*)(ws + WS_X1B), (float*)(ws + WS_RS2P)}; gemm_phase(lds, g, S, e); }
    xcd_barrier(bar); TSTAMP(8);
    DBGC({ const bf16_t* Xp = (const bf16_t*)(ws + WS_X1B); const float* xn1 = (const float*)(ws + DB_X1);
      dbg_cmp(ws, 10, NB, 1024, [=](int t, int c, float& a, float& b) { a = bf_at(Xp, (size_t)t * 1024 + c); b = xn1[(size_t)t * 1024 + c]; }); })
    }
    }
    for (int hh = 0; hh < REP_I; ++hh) {
        { Gemm g{(const bf16_t*)(ws + WS_X1B), (const bf16_t*)(ws + WS_WS), 1024, 1024, 1024, 0, 0}; S.init(T, 2048, 1, 0);
          EpiSC e{(unsigned short*)(ws + WS_SC)}; gemm_phase(lds, g, S, e); }
        xcd_barrier(bar); TSTAMP(9);
    }
    DBGC({ const float* SCp = (const float*)(ws + WS_SC); const float* qn = (const float*)(ws + DB_Q); const float* RSp = (const float*)(ws + WS_RS2P); const float* kk1 = p.in[21]; const float* kk2 = p.in[22];
          dbg_cmp(ws, 11, NB, 2048, [=](int t, int c, float& a, float& b) { float ss = 0.f; for (int i = 0; i < 16; ++i) ss += RSp[(size_t)t * 16 + i];
            a = SCp[(size_t)t * 2048 + c] * rsqrtf(ss * (1.0f / D) + RMS_EPS); const int hs = c >> 7, j = c & 127; const float* kp = ((hs & 1) ? kk2 : kk1) + j * 128; const float* qq = qn + (size_t)t * 2048 + hs * 128;
            float sr = 0.f; for (int k = 0; k < 128; ++k) sr += qq[k] * kp[k]; b = sr; }); })
    for (int rep = 0; rep < REP_J; ++rep) { for (int rtk = 0; rtk < REP_TK; ++rtk) phase_topk(p, lds); asm volatile("s_waitcnt vmcnt(0) lgkmcnt(0)" ::: "memory"); __syncthreads();     phase_expert(p, lds); __syncthreads(); }
#if TIMING
    xcd_barrier(bar); TSTAMP(13);
    xcd_barrier(bar);
    { const unsigned long long* ts = (const unsigned long long*)(p.ws + WS_RSTD1 - 1024);
      const float ua = (float)(ts[TIME_A] - ts[TIME_A - 1]) * 0.01f, ub = (float)(ts[TIME_B] - ts[TIME_B - 1]) * 0.01f;
      const float c = sqrtf(ua);
      for (size_t i = (size_t)blockIdx.x * NTHR + threadIdx.x; i < (size_t)T * D; i += (size_t)NBLK * NTHR) p.out[i] = (i == 0) ? ub : c; }
#endif
    DBGC(xcd_barrier(bar); { const float* On = (const float*)(ws + DB_OUT); const float* Op = p.out;
      { const int* Ep = (const int*)(ws + WS_EIDX); const int* En = (const int*)(ws + DB_EIDX); const float* Gp2 = (const float*)(ws + WS_GATE); const float* Gn = (const float*)(ws + DB_GATE);
          dbg_cmp(ws, 12, NB, 128, [=](int t, int c, float& a, float& b) { const int e = Ep[(size_t)t * 128 + c]; const int* nn = En + (size_t)t * 128 + (c & ~15); int f = 0; for (int k = 0; k < 16; ++k) f |= (nn[k] == e); a = f ? 1.f : 0.f; b = 1.f; });
          dbg_cmp(ws, 13, NB, 128, [=](int t, int c, float& a, float& b) { const int e = Ep[(size_t)t * 128 + c]; const int* nn = En + (size_t)t * 128 + (c & ~15); a = Gp2[(size_t)t * 128 + c]; b = a; for (int k = 0; k < 16; ++k) if (nn[k] == e) b = Gn[(size_t)t * 128 + (c & ~15) + k]; }); }
      dbg_cmp(ws, 14, NB, 1024, [=](int t, int c, float& a, float& b) { a = Op[(size_t)t * 1024 + c]; b = On[(size_t)t * 1024 + c]; }); })
}
}

extern "C" void kernel_launch(void* const* d_in, const int* in_sizes, int n_in, void* d_out, int out_size, void* d_ws, size_t ws_size, hipStream_t stream) {
    static int ready = 0;
    if (ready == 0) {
        if (n_in != 26 || out_size != 32768 * D || ws_size < WS_END) { fprintf(stderr, "kernel_launch: unexpected shapes (n_in %d out %d ws %zu need %zu)\n", n_in, out_size, ws_size, (size_t)WS_END); ready = -1; return; }
        if (hipFuncSetAttribute((const void*)fwd_megakernel, hipFuncAttributeMaxDynamicSharedMemorySize, LDS_BYTES) != hipSuccess) { fprintf(stderr, "kernel_launch: hipFuncSetAttribute failed\n"); ready = -1; return; }
        ready = 1;
    }
    if (ready < 0) return;
    (void)hipMemsetAsync((char*)d_ws + WS_CTL, 0, 65536, stream);
#if DBG
    {
        char* wsb = (char*)d_ws; const int S = NB;
        const float* x = (const float*)d_in[0];
        float* cst = (float*)(wsb + DB_CST); float* hn = (float*)(wsb + DB_HN); float* proj = (float*)(wsb + DB_PROJ); float* am = (float*)(wsb + DB_AM); float* ya = (float*)(wsb + DB_YA);
        float* xr = (float*)(wsb + DB_XR); float* xi = (float*)(wsb + DB_XI); float* z = (float*)(wsb + DB_Z); float* lin = (float*)(wsb + DB_LIN); float* s5 = (float*)(wsb + DB_S5);
        float* yb = (float*)(wsb + DB_YB); float* merged = (float*)(wsb + DB_MG); float* x1 = (float*)(wsb + DB_X1); float* xn = (float*)(wsb + DB_XN); float* q = (float*)(wsb + DB_Q);
        int* eidx = (int*)(wsb + DB_EIDX); float* gate = (float*)(wsb + DB_GATE); float* outn = (float*)(wsb + DB_OUT);
        auto F = [&](int i) { return (const float*)d_in[i]; };
        auto gemm = [&](const float* A, int lda, const float* B, int ldb, float* C, int ldc, int M, int N, int K) { ngemm<<<dim3(N / 64, M / 64), 256, 0, stream>>>(A, lda, B, ldb, C, ldc, M, N, K); };
        (void)hipMemsetAsync(wsb + DB_ACC, 0, 4096, stream);
        n_ssm_const<<<4, 256, 0, stream>>>(F(6), F(7), F(8), cst);
        n_rmsnorm<<<S, 256, 0, stream>>>(x, F(1), hn);
        gemm(hn, D, F(2), IN_COLS, proj, IN_COLS, S, IN_COLS, D);
        n_conv<<<(S * CONV_CH) / 256, 256, 0, stream>>>(proj, F(4), F(5), am, S);
        gemm(am, CONV_CH, F(16), D, ya, D, S, D, CONV_CH);
        n_ssm_x<<<(S * 1024) / 256, 256, 0, stream>>>(proj, F(9), F(10), cst, xr, xi, S);
        n_ssm_scan<<<4, 256, 0, stream>>>(cst, xr, xi, S);
        n_ssm_y<<<(S * 256) / 256, 256, 0, stream>>>(proj, xr, xi, F(11), F(12), F(13), z, S);
        gemm(z, 256, F(14), 256, lin, 256, S, 256, 256);
        n_glu<<<(S * 256) / 256, 256, 0, stream>>>(z, lin, F(15), s5, (size_t)S * 256);
        gemm(s5, 256, F(17), D, yb, D, S, D, 256);
        n_merge<<<(S * D) / 256, 256, 0, stream>>>(proj, F(3), ya, yb, merged, (size_t)S * D);
        gemm(merged, D, F(18), D, x1, D, S, D, D);
        n_add<<<(S * D) / 256, 256, 0, stream>>>(x, x1, (size_t)S * D);
        n_rmsnorm<<<S, 256, 0, stream>>>(x1, F(19), xn);
        gemm(xn, D, F(20), PEER_QD, q, PEER_QD, S, PEER_QD, D);
        n_route<<<S, 256, 0, stream>>>(q, F(21), F(22), eidx, gate);
        n_expert<<<S / 4, 256, 0, stream>>>(xn, x1, eidx, gate, F(23), F(24), F(25), outn);
    }
#endif
    Params p{};
    for (int i = 0; i < 26; ++i) p.in[i] = (const float*)d_in[i];
    p.out = (float*)d_out; p.ws = (unsigned char*)d_ws;
    hipLaunchKernelGGL(fwd_megakernel, dim3(NBLK), dim3(NTHR), LDS_BYTES, stream, p);
#if DBG
    dbg_report<<<1024, 256, 0, stream>>>((const float*)((char*)d_ws + DB_ACC), (float*)d_out, out_size, DBG_FIRST);
#endif
}
```

```cpp
#include <hip/hip_runtime.h>
#include <cstdint>
#include <cstddef>
#include <cstdio>

#define LAS __attribute__((address_space(3)))
#ifndef DBG
#define DBG 0
#endif
#ifndef TIMING
#define TIMING 0
#endif
#ifndef REP_J
#define REP_J 1
#endif
#ifndef REP_AH
#define REP_AH 1
#endif
#ifndef REP_I
#define REP_I 1
#endif
#ifndef REP_PH
#define REP_PH 0
#endif
#ifndef NULLG1
#define NULLG1 0
#endif
#ifndef SKIPA
#define SKIPA 0
#endif
#ifndef REP_TK
#define REP_TK 1
#endif
#ifndef TIME_A
#define TIME_A 13
#endif
#ifndef TIME_B
#define TIME_B 2
#endif
#ifndef DBG_THR
#define DBG_THR 0.03f
#endif
#ifndef DBG_FIRST
#define DBG_FIRST 1
#endif
#if TIMING
#define TSTAMP(k) do { if (blockIdx.x == 0 && threadIdx.x == 0) ((unsigned long long*)(p.ws + WS_RSTD1 - 1024))[k] = __builtin_amdgcn_s_memrealtime(); } while (0)
#else
#define TSTAMP(k)
#endif
#if DBG
#define DBGC(...) __VA_ARGS__
#else
#define DBGC(...)
#endif
namespace {
typedef unsigned short bf16_t;
typedef short bf16x8 __attribute__((ext_vector_type(8)));
typedef float f32x4 __attribute__((ext_vector_type(4)));
typedef unsigned u32x4 __attribute__((ext_vector_type(4)));
typedef unsigned u32x2 __attribute__((ext_vector_type(2)));
typedef _Float16 h2 __attribute__((ext_vector_type(2)));

constexpr int D = 1024, T = DBG ? 16384 : 32768, SEQ = 8192;
constexpr int CONV_CH = 768, IN_COLS = 4608;
constexpr float RMS_EPS = 1e-6f;
constexpr int NBLK = 256, NTHR = 512, NWAVE = 8, NGW = NBLK * NWAVE;
constexpr int CL = 32, LOGCL = 5, CK = CL * 16;
constexpr int SUK = CK + 128;
constexpr int NCHUNK = T / CL, CPS = SEQ / CL;

constexpr size_t MB = 1024 * 1024;
constexpr size_t WS_CTL = 0;
constexpr size_t WS_RSTD1 = WS_CTL + 65536;
constexpr size_t WS_RS2P = WS_RSTD1 + (size_t)T * 4;
constexpr size_t WS_WIN = WS_RS2P + (size_t)T * 64;
constexpr size_t WS_WA = WS_WIN + (size_t)4608 * 1024 * 2;
constexpr size_t WS_WB = WS_WA + (size_t)1024 * 768 * 2;
constexpr size_t WS_WOUT = WS_WB + (size_t)1024 * 256 * 2;
constexpr size_t WS_WGLU = WS_WOUT + (size_t)1024 * 1024 * 2;
constexpr size_t WS_WS = WS_WGLU + (size_t)256 * 256 * 2;
constexpr size_t WS_UH = WS_WS + (size_t)2048 * 1024 * 2;
constexpr size_t WS_USC = WS_UH + (size_t)16384 * 1024;
constexpr size_t WS_VH = WS_USC + (size_t)16384 * 4;
constexpr size_t WS_VSC = WS_VH + (size_t)16384 * 1024;
constexpr size_t WS_RINV = WS_VSC + (size_t)16384 * 4;
constexpr size_t WS_POW = WS_RINV + (size_t)T * 4;
constexpr size_t WS_BBAR = WS_POW + (size_t)16 * 65 * 64 * 2 * 4;
constexpr size_t WS_KC = WS_BBAR + (size_t)16 * 64 * 16 * 2 * 4;
constexpr size_t WS_E = WS_KC + (size_t)16 * 64 * 256 * 4;
constexpr size_t WS_MEND = WS_E + (size_t)16 * NCHUNK * 128 * 4;
constexpr size_t WS_MY = WS_MEND + (size_t)16 * 256 * CK * 2;
constexpr size_t WS_EIDX = WS_MY + (size_t)16 * CK * SUK * 2;
constexpr size_t WS_GATE = WS_EIDX + (size_t)T * 128 * 4;
constexpr size_t WS_XB = WS_GATE + (size_t)T * 128 * 4;
constexpr size_t WS_G = WS_XB + (size_t)T * 1024 * 2;
constexpr size_t WS_CB = WS_G + (size_t)T * 2048 * 2;
constexpr size_t WS_V = WS_CB + (size_t)T * 768 * 2;
constexpr size_t WS_SU = WS_V + (size_t)T * 768 * 2;
constexpr size_t WS_A2 = WS_SU + (size_t)16 * NCHUNK * SUK * 2;
constexpr size_t WS_END = WS_A2 + (size_t)T * 768 * 2;
constexpr size_t WS_XQ = WS_A2 + (size_t)T * 512;
constexpr size_t WS_P = WS_CB, WS_X1B = WS_XB, WS_X1 = WS_G, WS_MG = WS_CB, WS_SC = WS_CB, WS_Z = WS_V + (size_t)T * 256 * 2, WS_S5 = WS_V + (size_t)T * 512 * 2;
static_assert(WS_GATE + (size_t)T * 128 * 4 <= WS_XB, "EIDX/GATE placement");
static_assert(WS_SC + (size_t)T * 2048 * 2 <= WS_XQ && WS_XQ + (size_t)T * 1024 <= WS_END, "SC / XQ overlay");
static_assert(WS_END <= (size_t)512 * MB, "workspace");
static_assert(WS_MG + (size_t)T * 1024 * 2 <= WS_Z && WS_S5 + (size_t)T * 256 * 2 <= WS_SU, "Z/S5 placement");
#if DBG
constexpr int NB = 2048;
constexpr size_t DB_BASE = (WS_END + 4095) & ~(size_t)4095;
constexpr size_t DB_ACC = DB_BASE;
constexpr size_t DB_CST = DB_ACC + 4096;
constexpr size_t DB_HN = DB_CST + 16384;
constexpr size_t DB_PROJ = DB_HN + (size_t)NB * D * 4;
constexpr size_t DB_AM = DB_PROJ + (size_t)NB * IN_COLS * 4;
constexpr size_t DB_YA = DB_AM + (size_t)NB * CONV_CH * 4;
constexpr size_t DB_XR = DB_YA + (size_t)NB * D * 4;
constexpr size_t DB_XI = DB_XR + (size_t)NB * D * 4;
constexpr size_t DB_Z = DB_XI + (size_t)NB * D * 4;
constexpr size_t DB_LIN = DB_Z + (size_t)NB * 256 * 4;
constexpr size_t DB_S5 = DB_LIN + (size_t)NB * 256 * 4;
constexpr size_t DB_YB = DB_S5 + (size_t)NB * 256 * 4;
constexpr size_t DB_MG = DB_YB + (size_t)NB * D * 4;
constexpr size_t DB_X1 = DB_MG + (size_t)NB * D * 4;
constexpr size_t DB_XN = DB_X1 + (size_t)NB * D * 4;
constexpr size_t DB_Q = DB_XN + (size_t)NB * D * 4;
constexpr size_t DB_EIDX = DB_Q + (size_t)NB * 2048 * 4;
constexpr size_t DB_GATE = DB_EIDX + (size_t)NB * 128 * 4;
constexpr size_t DB_OUT = DB_GATE + (size_t)NB * 128 * 4;
constexpr size_t DB_H = DB_OUT + (size_t)NB * D * 4;
constexpr size_t DB_END = DB_H + (size_t)NB * 128 * 4;
static_assert(DB_END <= (size_t)512 * MB, "debug workspace");
constexpr size_t DBH_OFF = DB_H;
#endif

constexpr int LDS_STAGE = 131072, LDS_MISC = LDS_STAGE, LDS_GBIAS = LDS_STAGE + 4096, LDS_BYTES = LDS_GBIAS + 8192;

struct Params { const float* in[26]; float* out; unsigned char* ws; };

__device__ __forceinline__ unsigned pk2bf(float lo, float hi) { unsigned r; asm volatile("v_cvt_pk_bf16_f32 %0, %1, %2" : "=v"(r) : "v"(lo), "v"(hi)); return r; }
__device__ __forceinline__ int dot4z(unsigned a, int b) { int r; asm("v_dot4_i32_i8 %0, %1, %2, 0" : "=v"(r) : "v"(a), "v"(b)); return r; }
__device__ __forceinline__ h2 as_h2(unsigned v) { return __builtin_bit_cast(h2, v); }
__device__ __forceinline__ unsigned pk2h(float lo, float hi) { unsigned r; asm("v_cvt_pkrtz_f16_f32 %0, %1, %2" : "=v"(r) : "v"(lo), "v"(hi)); return r; }
__device__ __forceinline__ float bflo(unsigned d) { return __uint_as_float(d << 16); }
__device__ __forceinline__ float bfhi(unsigned d) { return __uint_as_float(d & 0xffff0000u); }
__device__ __forceinline__ float gelu_exact(float v) { return 0.5f * v * (1.0f + erff(v * 0.70710678118654752f)); }
__device__ __forceinline__ float ub0(unsigned w) { return (float)(w & 0xffu); }
__device__ __forceinline__ float ub1(unsigned w) { return (float)((w >> 8) & 0xffu); }
__device__ __forceinline__ float ub2(unsigned w) { return (float)((w >> 16) & 0xffu); }
__device__ __forceinline__ float ub3(unsigned w) { return (float)(w >> 24); }
__device__ __forceinline__ float sigm(float v) { return __builtin_amdgcn_rcpf(1.0f + __builtin_amdgcn_exp2f(v * -1.44269504089f)); }
__device__ __forceinline__ float sigm255(float v) { return __builtin_amdgcn_rcpf(fmaf(__builtin_amdgcn_exp2f(v * -1.44269504089f), 1.0f / 255.0f, 1.0f / 255.0f)); }
__device__ __forceinline__ u32x4 pack8(const f32x4 a, const f32x4 b) { u32x4 w; w.x = pk2bf(a[0], a[1]); w.y = pk2bf(a[2], a[3]); w.z = pk2bf(b[0], b[1]); w.w = pk2bf(b[2], b[3]); return w; }
__device__ __forceinline__ float wave_sum(float v) {
#pragma unroll
    for (int o = 1; o < 64; o <<= 1) v += __shfl_xor(v, o);
    return v;
}

#define XB_TMO      128
#define XB_XCNT(j)  (256  + 64 * (j))
#define XB_XSUB(j)  (1280 + 64 * (j))
#define XB_XGEN(j)  (2304 + 64 * (j))
#define XB_TOP      3328
#define XB_TOPGEN   3392
#define XCD_BAR_WORDS 3456
#define XB_SPIN_CAP (1u << 22)
__device__ __forceinline__ unsigned xb_ld(unsigned* p)              { return __hip_atomic_load(p, __ATOMIC_RELAXED, __HIP_MEMORY_SCOPE_AGENT); }
__device__ __forceinline__ unsigned xb_add(unsigned* p, unsigned v) { return __hip_atomic_fetch_add(p, v, __ATOMIC_RELAXED, __HIP_MEMORY_SCOPE_AGENT); }
__device__ __forceinline__ unsigned xb_xcc_id() { return (unsigned)__builtin_amdgcn_s_getreg((3 << 11) | 20) & 0xFu; }
#define XB_SPIN(cond, bar) do { unsigned _sp = 0; while (cond) { __builtin_amdgcn_s_sleep(1); \
    if ((++_sp & 255u) == 0u) { if (xb_ld(&(bar)[XB_TMO])) break; if (_sp > XB_SPIN_CAP) { atomicAdd(&(bar)[XB_TMO], 1u); break; } } } } while (0)
struct XcdBarrier { unsigned* bar; unsigned x; volatile LAS unsigned* st; };
__device__ __forceinline__ XcdBarrier xcd_barrier_post(unsigned* bar, volatile LAS unsigned* st) {
    XcdBarrier b; b.bar = bar; b.x = xb_xcc_id(); b.st = st;
    if (threadIdx.x == 0) (void)xb_add(&bar[XB_XCNT(b.x)], 1u);
    return b;
}
__device__ __forceinline__ void xcd_barrier_complete(unsigned* bar, unsigned x, unsigned& nloc, unsigned& nx) {
    const unsigned G = gridDim.x * gridDim.y * gridDim.z;
    unsigned sum, cnt, mine, sp = 0u;
    for (;;) {
        sum = 0u; cnt = 0u; mine = 0u;
#pragma unroll
        for (unsigned j = 0; j < 16; ++j) { const unsigned c = xb_ld(&bar[XB_XCNT(j)]); sum += c; cnt += (c > 0u) ? 1u : 0u; mine = (j == x) ? c : mine; }
        if (sum == G) break;
        __builtin_amdgcn_s_sleep(1);
        if ((++sp & 255u) == 0u) { if (xb_ld(&bar[XB_TMO])) break; if (sp > XB_SPIN_CAP) { atomicAdd(&bar[XB_TMO], 1u); break; } }
    }
    nloc = mine > 0u ? mine : 1u; nx = cnt > 0u ? cnt : 1u;
}
__device__ __forceinline__ void xcd_barrier(const XcdBarrier& b) {
    asm volatile("s_waitcnt vmcnt(0)" ::: "memory");
    __syncthreads();
    if (threadIdx.x == 0) {
        unsigned* bar = b.bar;
        __builtin_amdgcn_s_waitcnt(0);
        unsigned nloc = b.st[0], nx = b.st[1];
        if (nloc == 0u) { xcd_barrier_complete(bar, b.x, nloc, nx); b.st[0] = nloc; b.st[1] = nx; }
        const unsigned old = xb_add(&bar[XB_XSUB(b.x)], 1u);
        const unsigned gen = old / nloc;
        if (old + 1u == (gen + 1u) * nloc) {
            __builtin_amdgcn_fence(__ATOMIC_RELEASE, "agent");
            asm volatile("s_waitcnt vmcnt(0)" ::: "memory");
            const unsigned og = xb_add(&bar[XB_TOP], 1u);
            const unsigned tg = og / nx;
            if (og + 1u == (tg + 1u) * nx) xb_add(&bar[XB_TOPGEN], 1u);
            else XB_SPIN(xb_ld(&bar[XB_TOPGEN]) == tg, bar);
            __builtin_amdgcn_fence(__ATOMIC_ACQUIRE, "agent");
            xb_add(&bar[XB_XGEN(b.x)], 1u);
            asm volatile("s_waitcnt vmcnt(0)" ::: "memory");
        } else {
            XB_SPIN(xb_ld(&bar[XB_XGEN(b.x)]) == gen, bar);
            __builtin_amdgcn_fence(__ATOMIC_ACQUIRE, "agent");
            asm volatile("s_waitcnt vmcnt(0)" ::: "memory");
        }
    }
    __syncthreads();
}

constexpr int BM = 256, BK = 64, HALF = 128, HTB = HALF * BK * 2, NXCD = 8, WGM = 8;
__device__ __forceinline__ int lds_byte(int r, int c) { const int st = (r >> 4) * 2 + (c >> 5), rr = r & 15, cc = c & 31, ob = rr * 64 + cc * 2; return st * 1024 + (ob ^ (((ob >> 9) & 1) << 5)); }
__device__ __forceinline__ void stage_rc(int b, int& R, int& C) { const int st = b / 1024, sb = b % 1024, swz = sb ^ (((sb >> 9) & 1) << 5); R = (st >> 1) * 16 + swz / 64; C = (st & 1) * 32 + (swz % 64) / 2; }
__device__ __forceinline__ int perm32(int rho) { const int n = rho >> 4, i = rho & 15; return 8 * (i >> 2) + 4 * n + (i & 3); }

struct Unit { int pm, pn, z; };
struct Gemm { const bf16_t* A; const bf16_t* Bt; int lda, ldb, K; long sAz, sBz; };
struct Order {
    int nM, nN, nZ, G, c, pm_off; long u0, u1; int b0;
    __device__ void init(int M, int N, int Z, int pmo) { nM = M / BM; nN = N / BM; nZ = Z; G = gridDim.x; c = blockIdx.x; pm_off = pmo; u0 = 0; u1 = (long)nM * nN * nZ; b0 = 0; }
    __device__ void window(long first_unit, long end_unit, int first_block, int nblocks) { u0 = first_unit; u1 = end_unit; b0 = first_block; G = nblocks; }
    __device__ bool next(int i, Unit& u) const {
        if (c < b0 || c >= b0 + G) return false;
        const long L = u0 + (long)i * G + (c - b0); const int nwg = nM * nN;
        if (L >= u1) return false;
        if (nZ == 1) {
            int wgid = (int)L; { const int q = nwg / NXCD, r = nwg % NXCD, xcd = wgid % NXCD, off = wgid / NXCD; wgid = (xcd < r ? xcd * (q + 1) : r * (q + 1) + (xcd - r) * q) + off; }
            const int nig = WGM * nN, gid = wgid / nig, fm = gid * WGM, gsz = (nM - fm) < WGM ? (nM - fm) : WGM;
            u.pm = pm_off + fm + ((wgid % nig) % gsz); u.pn = (wgid % nig) / gsz; u.z = 0;
        } else { u.z = (int)(L / nwg); const int r = (int)(L % nwg); u.pm = r % nM; u.pn = r / nM; }
        return true;
    }
};

template <class Epi>
__device__ __forceinline__ void gemm_phase(LAS unsigned char* lds, const Gemm g, const Order& S, const Epi& E) {
    int tid = threadIdx.x; asm volatile("" : "+v"(tid));
    const int wid = __builtin_amdgcn_readfirstlane(tid >> 6), lane = tid & 63, wr = wid >> 2, wc = wid & 3, fr = lane & 15, fq = lane >> 4;
    const int K = g.K, nt = K / BK;
    unsigned voffA[2], voffB[2];
#pragma unroll
    for (int i = 0; i < 2; ++i) { int R, C; stage_rc(tid * 16 + i * 8192, R, C); const int Rb = Epi::PERM ? ((R & ~31) + perm32(R & 31)) : R;
        voffA[i] = (unsigned)(R * g.lda + C) * 2u; voffB[i] = (unsigned)(Rb * g.ldb + C) * 2u; }
    const size_t kstep = (size_t)(BK * 2);
    const size_t hstepA = (size_t)HALF * g.lda * 2, hstepB = (size_t)HALF * g.ldb * 2;
    const unsigned ldsw = (unsigned)wid * 1024u;
    const int aoff = lds_byte(wr * 64 + fr, fq * 8), boff = lds_byte(wc * 32 + fr, fq * 8);
#define PG8_SA(b, h) (((b) * 2 + (h)) * HTB)
#define PG8_SB(b, h) ((4 + (b) * 2 + (h)) * HTB)
#define PG8_STAGE(bufoff, gbase, voff) do { _Pragma("unroll") for (int _i = 0; _i < 2; ++_i) \
        __builtin_amdgcn_global_load_lds((const unsigned*)((const char*)(gbase) + (voff)[_i]), (LAS unsigned*)(lds + (bufoff) + ldsw + _i * 8192), 16, 0, 0); } while (0)
#define PG8_LDA(dst, b, h) do { _Pragma("unroll") for (int m = 0; m < 4; ++m) _Pragma("unroll") for (int k = 0; k < 2; ++k) dst[m][k] = *(const LAS bf16x8*)(lds + PG8_SA(b, h) + aoff + m * 2048 + k * 1024); } while (0)
#define PG8_LDB(dst, b, h) do { _Pragma("unroll") for (int n = 0; n < 2; ++n) _Pragma("unroll") for (int k = 0; k < 2; ++k) dst[n][k] = *(const LAS bf16x8*)(lds + PG8_SB(b, h) + boff + n * 2048 + k * 1024); } while (0)
#define PG8_MMA(ai, bj, At, Bt) do { __builtin_amdgcn_s_setprio(1); _Pragma("unroll") for (int m = 0; m < 4; ++m) _Pragma("unroll") for (int n = 0; n < 2; ++n) _Pragma("unroll") for (int k = 0; k < 2; ++k) \
        acc[ai][bj][m][n] = __builtin_amdgcn_mfma_f32_16x16x32_bf16(Bt[n][k], At[m][k], acc[ai][bj][m][n], 0, 0, 0); __builtin_amdgcn_s_setprio(0); } while (0)
#define PG8_WAIT_V(n) asm volatile("s_waitcnt vmcnt(" #n ")" ::: "memory")
#define PG8_WAIT_L(n) asm volatile("s_waitcnt lgkmcnt(" #n ")" ::: "memory")
#define PG8_BAR __builtin_amdgcn_s_barrier()
#define PG8_SCHED __builtin_amdgcn_sched_barrier(0)
    Unit cur, nxt; int ui = 0;
    if (!S.next(0, cur)) return;
    f32x4 acc[2][2][4][2];
#pragma unroll
    for (int a = 0; a < 2; ++a)
#pragma unroll
        for (int b = 0; b < 2; ++b)
#pragma unroll
            for (int m = 0; m < 4; ++m)
#pragma unroll
                for (int n = 0; n < 2; ++n) acc[a][b][m][n] = (f32x4){0.f, 0.f, 0.f, 0.f};
    bf16x8 At[4][2], B0[2][2], B1[2][2];
    const char* cA = (const char*)g.A + ((size_t)cur.z * g.sAz) * 2 + (size_t)cur.pm * 2 * hstepA;
    const char* cB = (const char*)g.Bt + ((size_t)cur.z * g.sBz) * 2 + (size_t)cur.pn * 2 * hstepB;
    PG8_STAGE(PG8_SB(0, 0), cB, voffB); PG8_STAGE(PG8_SB(0, 1), cB + hstepB, voffB); PG8_STAGE(PG8_SA(0, 0), cA, voffA); PG8_STAGE(PG8_SA(0, 1), cA + hstepA, voffA);
    if (wr == 1) PG8_BAR;
    PG8_WAIT_V(2); PG8_BAR;
    PG8_STAGE(PG8_SB(1, 0), cB + kstep, voffB); PG8_STAGE(PG8_SA(1, 0), cA + kstep, voffA); PG8_STAGE(PG8_SB(1, 1), cB + hstepB + kstep, voffB);
    PG8_WAIT_V(6); PG8_BAR;
    for (;;) {
        const bool has_next = S.next(ui + 1, nxt);
        const char* nA = has_next ? (const char*)g.A + ((size_t)nxt.z * g.sAz) * 2 + (size_t)nxt.pm * 2 * hstepA : cA;
        const char* nB = has_next ? (const char*)g.Bt + ((size_t)nxt.z * g.sBz) * 2 + (size_t)nxt.pn * 2 * hstepB : cB;
#pragma unroll 1
        for (int t = 0; t < nt; t += 2) {
            const bool last = (t == nt - 2);
            const char* a1 = cA + (size_t)(t + 1) * kstep;
            const char* a2 = last ? nA : cA + (size_t)(t + 2) * kstep; const char* b2 = last ? nB : cB + (size_t)(t + 2) * kstep;
            const char* a3 = a2 + kstep; const char* b3 = b2 + kstep;
            PG8_LDB(B0, 0, 0); PG8_LDB(B1, 0, 1); PG8_SCHED; PG8_LDA(At, 0, 0); PG8_STAGE(PG8_SA(1, 1), a1 + hstepA, voffA);
            PG8_WAIT_V(8); PG8_WAIT_L(0); PG8_BAR; PG8_MMA(0, 0, At, B0); PG8_MMA(0, 1, At, B1); PG8_BAR; PG8_SCHED;
            PG8_LDA(At, 0, 1); PG8_STAGE(PG8_SB(0, 0), b2, voffB); PG8_STAGE(PG8_SB(0, 1), b2 + hstepB, voffB); PG8_STAGE(PG8_SA(0, 0), a2, voffA);
            PG8_WAIT_V(8); PG8_WAIT_L(0); PG8_BAR; PG8_MMA(1, 0, At, B0); PG8_MMA(1, 1, At, B1); PG8_BAR; PG8_SCHED;
            PG8_LDB(B0, 1, 0); PG8_LDB(B1, 1, 1); PG8_SCHED; PG8_LDA(At, 1, 0); PG8_STAGE(PG8_SA(0, 1), a2 + hstepA, voffA);
            PG8_WAIT_V(8); PG8_WAIT_L(0); PG8_BAR; PG8_MMA(0, 0, At, B0); PG8_MMA(0, 1, At, B1); PG8_BAR; PG8_SCHED;
            PG8_LDA(At, 1, 1); PG8_STAGE(PG8_SB(1, 0), b3, voffB); PG8_STAGE(PG8_SB(1, 1), b3 + hstepB, voffB); PG8_STAGE(PG8_SA(1, 0), a3, voffA);
            PG8_WAIT_V(8); PG8_WAIT_L(0); PG8_BAR; PG8_MMA(1, 0, At, B0); PG8_MMA(1, 1, At, B1); PG8_BAR; PG8_SCHED;
        }
        if (wr == 0) PG8_BAR;
        { int fr_e = fr, fq_e = fq; asm volatile("" : "+v"(fr_e), "+v"(fq_e));
          E(acc, cur, wr, wc, fr_e, fq_e); }
        if (!has_next) break;
#pragma unroll
        for (int a = 0; a < 2; ++a)
#pragma unroll
            for (int b = 0; b < 2; ++b)
#pragma unroll
                for (int m = 0; m < 4; ++m)
#pragma unroll
                    for (int n = 0; n < 2; ++n) acc[a][b][m][n] = (f32x4){0.f, 0.f, 0.f, 0.f};
        cur = nxt; cA = nA; cB = nB; ++ui;
        if (wr == 1) PG8_BAR;
    }
    PG8_WAIT_V(0);
    PG8_BAR;
#undef PG8_SA
#undef PG8_SB
#undef PG8_STAGE
#undef PG8_LDA
#undef PG8_LDB
#undef PG8_MMA
#undef PG8_WAIT_V
#undef PG8_WAIT_L
#undef PG8_BAR
#undef PG8_SCHED
}

__device__ __forceinline__ u32x4 xpose16(const u32x4 v, int src_addr) {
    u32x4 r; r.x = (unsigned)__builtin_amdgcn_ds_bpermute(src_addr, (int)v.x); r.y = (unsigned)__builtin_amdgcn_ds_bpermute(src_addr, (int)v.y);
    r.z = (unsigned)__builtin_amdgcn_ds_bpermute(src_addr, (int)v.z); r.w = (unsigned)__builtin_amdgcn_ds_bpermute(src_addr, (int)v.w); return r;
}
typedef const f32x4 (&AccRef)[2][2][4][2];
template <bool NOST> struct EpiG1T {
    static constexpr bool PERM = true;
    const LAS float* bgate; bf16_t *CB, *V, *SU; unsigned char* G8;
    __device__ __forceinline__ void operator()(AccRef acc, const Unit& u, int wr, int wc, int fr, int fq) const {
        const int pn = u.pn, c0 = wc * 32 + 8 * fq;
        const int lane = fq * 16 + fr, sa = ((lane & 3) * 16 + (lane >> 2)) * 4, tr = lane >> 2, tc0 = wc * 32 + 8 * (lane & 3);
#pragma unroll
        for (int ai = 0; ai < 2; ++ai)
#pragma unroll
            for (int m = 0; m < 4; ++m) {
                const int row = u.pm * BM + ai * HALF + wr * 64 + m * 16 + tr;
                if (pn < 3) {
#pragma unroll
                    for (int bj = 0; bj < 2; ++bj) { const u32x4 w_ = xpose16(pack8(acc[ai][bj][m][0], acc[ai][bj][m][1]), sa); if (NOST) asm volatile("" :: "v"(w_)); else *(u32x4*)(CB + (size_t)row * CONV_CH + pn * 256 + bj * HALF + tc0) = w_; }
                } else if (pn < 9) {
                    { const u32x4 w_ = xpose16(pack8(acc[ai][0][m][0] * acc[ai][1][m][0], acc[ai][0][m][1] * acc[ai][1][m][1]), sa); if (NOST) asm volatile("" :: "v"(w_)); else *(u32x4*)(V + (size_t)row * CONV_CH + (pn - 3) * HALF + tc0) = w_; }
                } else if (pn == 9) {
#pragma unroll
                    for (int bj = 0; bj < 2; ++bj) { const int c = bj * HALF + tc0, gq = c >> 4, h0 = c & 15;
                        const u32x4 w_ = xpose16(pack8(acc[ai][bj][m][0], acc[ai][bj][m][1]), sa); if (NOST) asm volatile("" :: "v"(w_)); else *(u32x4*)(SU + ((size_t)(gq * NCHUNK + (row >> LOGCL))) * SUK + (row & (CL - 1)) * 16 + h0) = w_; }
                } else {
#pragma unroll
                    for (int bj = 0; bj < 2; ++bj) { const int col = (pn - 10) * 256 + bj * HALF + c0;
                        const f32x4 b0 = *(const LAS f32x4*)(bgate + col), b1 = *(const LAS f32x4*)(bgate + col + 4);
                        const f32x4 v0 = acc[ai][bj][m][0] + b0, v1 = acc[ai][bj][m][1] + b1; unsigned lo = 0u, hi = 0u;
#pragma unroll
                        for (int e = 0; e < 4; ++e) { lo = __builtin_amdgcn_cvt_pk_u8_f32(sigm255(v0[e]), e, lo); hi = __builtin_amdgcn_cvt_pk_u8_f32(sigm255(v1[e]), e, hi); }
                        const int rowd = u.pm * BM + ai * HALF + wr * 64 + m * 16 + fr; const u32x2 w_ = {lo, hi};
                        if (NOST) asm volatile("" :: "v"(w_)); else *(u32x2*)(G8 + (size_t)rowd * 2048 + col) = w_; }
                }
            }
    }
};
typedef EpiG1T<false> EpiG1;
struct EpiNull {
    static constexpr bool PERM = true;
    __device__ __forceinline__ void operator()(AccRef acc, const Unit& u, int wr, int wc, int fr, int fq) const {
#pragma unroll
        for (int ai = 0; ai < 2; ++ai)
#pragma unroll
            for (int bj = 0; bj < 2; ++bj)
#pragma unroll
                for (int m = 0; m < 4; ++m)
#pragma unroll
                    for (int n = 0; n < 2; ++n) asm volatile("" :: "v"(acc[ai][bj][m][n]));
    }
};
#define EPI_WAIT() asm volatile("s_waitcnt vmcnt(0)" ::: "memory")
struct EpiP {
    static constexpr bool PERM = true;
    const unsigned char* G8; bf16_t* P;
    __device__ __forceinline__ void operator()(AccRef acc, const Unit& u, int wr, int wc, int fr, int fq) const {
        const int col0 = u.pn * BM + wc * 32 + 8 * fq;
#pragma unroll
        for (int ai = 0; ai < 2; ++ai) {
            u32x2 gg[4][2];
#pragma unroll
            for (int m = 0; m < 4; ++m) { const int row = u.pm * BM + ai * HALF + wr * 64 + m * 16 + fr;
#pragma unroll
                for (int bj = 0; bj < 2; ++bj) gg[m][bj] = *(const u32x2*)(G8 + (size_t)row * 2048 + col0 + bj * HALF); }
            EPI_WAIT();
#pragma unroll
            for (int m = 0; m < 4; ++m) { const int row = u.pm * BM + ai * HALF + wr * 64 + m * 16 + fr;
#pragma unroll
                for (int bj = 0; bj < 2; ++bj) { const u32x2 g2 = gg[m][bj];
                    f32x4 v0 = acc[ai][bj][m][0], v1 = acc[ai][bj][m][1];
                    v0[0] *= ub0(g2.x); v0[1] *= ub1(g2.x); v0[2] *= ub2(g2.x); v0[3] *= ub3(g2.x); v1[0] *= ub0(g2.y); v1[1] *= ub1(g2.y); v1[2] *= ub2(g2.y); v1[3] *= ub3(g2.y);
                    *(u32x4*)(P + (size_t)row * D + col0 + bj * HALF) = pack8(v0, v1); } }
        }
    }
};
struct EpiE {
    static constexpr bool PERM = false;
    float* E;
    __device__ __forceinline__ void operator()(AccRef acc, const Unit& u, int wr, int wc, int fr, int fq) const {
#pragma unroll
        for (int ai = 0; ai < 2; ++ai)
#pragma unroll
            for (int m = 0; m < 4; ++m) { const int row = u.pm * BM + ai * HALF + wr * 64 + m * 16 + fr;
#pragma unroll
                for (int n = 0; n < 2; ++n) *(f32x4*)(E + ((size_t)u.z * NCHUNK + row) * 128 + wc * 32 + n * 16 + 4 * fq) = acc[ai][0][m][n]; }
    }
};
struct EpiY {
    static constexpr bool PERM = true;
    const bf16_t* SU; const float* dskip; bf16_t* Z;
    __device__ __forceinline__ void operator()(AccRef acc, const Unit& u, int wr, int wc, int fr, int fq) const {
        f32x4 d0[2], d1[2];
#pragma unroll
        for (int bj = 0; bj < 2; ++bj) { const int col = u.pn * BM + bj * HALF + wc * 32 + 8 * fq, h0 = col & 15; d0[bj] = *(const f32x4*)(dskip + u.z * 16 + h0); d1[bj] = *(const f32x4*)(dskip + u.z * 16 + h0 + 4); }
#pragma unroll
        for (int ai = 0; ai < 2; ++ai) {
            u32x4 uu[4][2];
#pragma unroll
            for (int m = 0; m < 4; ++m) { const int chunk = u.pm * BM + ai * HALF + wr * 64 + m * 16 + fr;
#pragma unroll
                for (int bj = 0; bj < 2; ++bj) { const int col = u.pn * BM + bj * HALF + wc * 32 + 8 * fq;
                    uu[m][bj] = *(const u32x4*)(SU + ((size_t)u.z * NCHUNK + chunk) * SUK + col); } }
            EPI_WAIT();
#pragma unroll
            for (int m = 0; m < 4; ++m) { const int chunk = u.pm * BM + ai * HALF + wr * 64 + m * 16 + fr;
#pragma unroll
                for (int bj = 0; bj < 2; ++bj) { const int col = u.pn * BM + bj * HALF + wc * 32 + 8 * fq, j = col >> 4, h0 = col & 15; const u32x4 u4 = uu[m][bj];
                    f32x4 v0 = acc[ai][bj][m][0], v1 = acc[ai][bj][m][1];
                    v0[0] += d0[bj][0] * bflo(u4.x); v0[1] += d0[bj][1] * bfhi(u4.x); v0[2] += d0[bj][2] * bflo(u4.y); v0[3] += d0[bj][3] * bfhi(u4.y);
                    v1[0] += d1[bj][0] * bflo(u4.z); v1[1] += d1[bj][1] * bfhi(u4.z); v1[2] += d1[bj][2] * bflo(u4.w); v1[3] += d1[bj][3] * bfhi(u4.w);
#pragma unroll
                    for (int e = 0; e < 4; ++e) { v0[e] = gelu_exact(v0[e]); v1[e] = gelu_exact(v1[e]); }
                    *(u32x4*)(Z + ((size_t)chunk * CL + j) * 256 + u.z * 16 + h0) = pack8(v0, v1); } }
        }
    }
};
struct EpiGlu {
    static constexpr bool PERM = true;
    const bf16_t* Z; const float* bglu; bf16_t* S5;
    __device__ __forceinline__ void operator()(AccRef acc, const Unit& u, int wr, int wc, int fr, int fq) const {
        f32x4 b0[2], b1[2];
#pragma unroll
        for (int bj = 0; bj < 2; ++bj) { const int col = bj * HALF + wc * 32 + 8 * fq; b0[bj] = *(const f32x4*)(bglu + col); b1[bj] = *(const f32x4*)(bglu + col + 4); }
#pragma unroll
        for (int ai = 0; ai < 2; ++ai) {
            u32x4 zz[4][2];
#pragma unroll
            for (int m = 0; m < 4; ++m) { const int row = u.pm * BM + ai * HALF + wr * 64 + m * 16 + fr;
#pragma unroll
                for (int bj = 0; bj < 2; ++bj) zz[m][bj] = *(const u32x4*)(Z + (size_t)row * 256 + bj * HALF + wc * 32 + 8 * fq); }
            EPI_WAIT();
#pragma unroll
            for (int m = 0; m < 4; ++m) { const int row = u.pm * BM + ai * HALF + wr * 64 + m * 16 + fr;
#pragma unroll
                for (int bj = 0; bj < 2; ++bj) { const int col = bj * HALF + wc * 32 + 8 * fq; const u32x4 z4 = zz[m][bj];
                    f32x4 v0 = acc[ai][bj][m][0] + b0[bj], v1 = acc[ai][bj][m][1] + b1[bj];
                    v0[0] = bflo(z4.x) * sigm(v0[0]); v0[1] = bfhi(z4.x) * sigm(v0[1]); v0[2] = bflo(z4.y) * sigm(v0[2]); v0[3] = bfhi(z4.y) * sigm(v0[3]);
                    v1[0] = bflo(z4.z) * sigm(v1[0]); v1[1] = bfhi(z4.z) * sigm(v1[1]); v1[2] = bflo(z4.w) * sigm(v1[2]); v1[3] = bfhi(z4.w) * sigm(v1[3]);
                    *(u32x4*)(S5 + (size_t)row * 256 + col) = pack8(v0, v1); } }
        }
    }
};
struct EpiMerge {
    static constexpr bool PERM = true;
    const unsigned char* G8; const bf16_t* P; bf16_t* MG;
    __device__ __forceinline__ void operator()(AccRef acc, const Unit& u, int wr, int wc, int fr, int fq) const {
        const int col0 = u.pn * BM + wc * 32 + 8 * fq;
#pragma unroll
        for (int ai = 0; ai < 2; ++ai) {
            u32x2 gg[4][2]; u32x4 pp[4][2];
#pragma unroll
            for (int m = 0; m < 4; ++m) { const int row = u.pm * BM + ai * HALF + wr * 64 + m * 16 + fr;
#pragma unroll
                for (int bj = 0; bj < 2; ++bj) { gg[m][bj] = *(const u32x2*)(G8 + (size_t)row * 2048 + D + col0 + bj * HALF); pp[m][bj] = *(const u32x4*)(P + (size_t)row * D + col0 + bj * HALF); } }
            EPI_WAIT();
#pragma unroll
            for (int m = 0; m < 4; ++m) { const int row = u.pm * BM + ai * HALF + wr * 64 + m * 16 + fr;
#pragma unroll
                for (int bj = 0; bj < 2; ++bj) { const u32x2 g2 = gg[m][bj]; const u32x4 p4 = pp[m][bj];
                    f32x4 v0 = acc[ai][bj][m][0], v1 = acc[ai][bj][m][1];
                    v0[0] = bflo(p4.x) + ub0(g2.x) * v0[0]; v0[1] = bfhi(p4.x) + ub1(g2.x) * v0[1]; v0[2] = bflo(p4.y) + ub2(g2.x) * v0[2]; v0[3] = bfhi(p4.y) + ub3(g2.x) * v0[3];
                    v1[0] = bflo(p4.z) + ub0(g2.y) * v1[0]; v1[1] = bfhi(p4.z) + ub1(g2.y) * v1[1]; v1[2] = bflo(p4.w) + ub2(g2.y) * v1[2]; v1[3] = bfhi(p4.w) + ub3(g2.y) * v1[3];
                    *(u32x4*)(MG + (size_t)row * D + col0 + bj * HALF) = pack8(v0, v1); } }
        }
    }
};
struct EpiX1 {
    static constexpr bool PERM = true;
    const float* RINV; bf16_t* X1B; float* RS2P;
    __device__ __forceinline__ void operator()(AccRef acc, const Unit& u, int wr, int wc, int fr, int fq) const {
        const int col0 = u.pn * BM + wc * 32 + 8 * fq;
#pragma unroll
        for (int ai = 0; ai < 2; ++ai) {
            u32x4 xb[4][2]; float ri[4];
#pragma unroll
            for (int m = 0; m < 4; ++m) { const int row = u.pm * BM + ai * HALF + wr * 64 + m * 16 + fr; ri[m] = RINV[row];
#pragma unroll
                for (int bj = 0; bj < 2; ++bj) xb[m][bj] = *(const u32x4*)(X1B + (size_t)row * D + col0 + bj * HALF); }
            EPI_WAIT();
#pragma unroll
            for (int m = 0; m < 4; ++m) { const int row = u.pm * BM + ai * HALF + wr * 64 + m * 16 + fr; float ss = 0.f; const float r_ = ri[m];
#pragma unroll
                for (int bj = 0; bj < 2; ++bj) { const size_t o = (size_t)row * D + col0 + bj * HALF; const u32x4 w = xb[m][bj];
                    const f32x4 v0 = acc[ai][bj][m][0] + (f32x4){bflo(w.x), bfhi(w.x), bflo(w.y), bfhi(w.y)} * r_, v1 = acc[ai][bj][m][1] + (f32x4){bflo(w.z), bfhi(w.z), bflo(w.w), bfhi(w.w)} * r_;
                    *(u32x4*)(X1B + o) = pack8(v0, v1);
                    ss += (v0[0] * v0[0] + v0[1] * v0[1]) + (v0[2] * v0[2] + v0[3] * v0[3]) + (v1[0] * v1[0] + v1[1] * v1[1]) + (v1[2] * v1[2] + v1[3] * v1[3]); }
                ss += __shfl_xor(ss, 16); ss += __shfl_xor(ss, 32);
                if (fq == 0) RS2P[(size_t)row * 16 + u.pn * 4 + wc] = ss; }
        }
    }
};
struct EpiSC {
    static constexpr bool PERM = true;
    unsigned short* SC;
    __device__ __forceinline__ void operator()(AccRef acc, const Unit& u, int wr, int wc, int fr, int fq) const {
        const int col0 = u.pn * BM + wc * 32 + 8 * fq;
#pragma unroll
        for (int ai = 0; ai < 2; ++ai)
#pragma unroll
            for (int m = 0; m < 4; ++m) { const int row = u.pm * BM + ai * HALF + wr * 64 + m * 16 + fr;
#pragma unroll
                for (int bj = 0; bj < 2; ++bj) { const f32x4 v0 = acc[ai][bj][m][0], v1 = acc[ai][bj][m][1]; u32x4 o;
                    o.x = pk2h(v0[0], v0[1]); o.y = pk2h(v0[2], v0[3]); o.z = pk2h(v1[0], v1[1]); o.w = pk2h(v1[2], v1[3]);
                    *(u32x4*)(SC + (size_t)row * 2048 + col0 + bj * HALF) = o; } }
    }
};

__device__ __forceinline__ void transpose_item(const float* W, int ldw, int src_col0, bf16_t* WT, int ldt, int dst_row0, int k0, const float* scale, LAS float* scr, int lane, float cs = 1.0f) {
#pragma unroll
    for (int i = 0; i < 32; ++i) { const int kk = 2 * i + (lane >> 5); float v = W[(size_t)(k0 + kk) * ldw + src_col0 + (lane & 31)] * cs; if (scale) v *= scale[k0 + kk]; scr[kk * 33 + (lane & 31)] = v; }
    asm volatile("s_waitcnt lgkmcnt(0)" ::: "memory");
    const int c = lane & 7;
#pragma unroll
    for (int j = 0; j < 4; ++j) { const int n = (lane >> 3) + 8 * j; const LAS float* s = scr + (8 * c) * 33 + n;
        u32x4 o; o.x = pk2bf(s[0 * 33], s[1 * 33]); o.y = pk2bf(s[2 * 33], s[3 * 33]); o.z = pk2bf(s[4 * 33], s[5 * 33]); o.w = pk2bf(s[6 * 33], s[7 * 33]);
        *(u32x4*)(WT + (size_t)(dst_row0 + n) * ldt + k0 + 8 * c) = o; }
    asm volatile("s_waitcnt lgkmcnt(0)" ::: "memory");
}
struct TrIt { const float* src; bf16_t* dst; const float* scale; int ldw, ldt; float cs; };
__device__ __forceinline__ void tr_load(const TrIt& t, int lane, float (&v)[32]) {
#pragma unroll
    for (int i = 0; i < 32; ++i) v[i] = t.src[(size_t)(2 * i + (lane >> 5)) * t.ldw + (lane & 31)];
}
__device__ __forceinline__ void tr_flush(const TrIt& t, const float (&v)[32], LAS float* scr, int lane) {
#pragma unroll
    for (int i = 0; i < 32; ++i) scr[(2 * i + (lane >> 5)) * 33 + (lane & 31)] = v[i];
    asm volatile("s_waitcnt lgkmcnt(0)" ::: "memory");
    const int c = lane & 7;
    f32x4 s0 = (f32x4){t.cs, t.cs, t.cs, t.cs}, s1 = s0;
    if (t.scale) { s0 = *(const f32x4*)(t.scale + 8 * c) * t.cs; s1 = *(const f32x4*)(t.scale + 8 * c + 4) * t.cs; }
#pragma unroll
    for (int j = 0; j < 4; ++j) { const int n = (lane >> 3) + 8 * j; const LAS float* s = scr + (8 * c) * 33 + n;
        u32x4 o; o.x = pk2bf(s[0 * 33] * s0[0], s[1 * 33] * s0[1]); o.y = pk2bf(s[2 * 33] * s0[2], s[3 * 33] * s0[3]); o.z = pk2bf(s[4 * 33] * s1[0], s[5 * 33] * s1[1]); o.w = pk2bf(s[6 * 33] * s1[2], s[7 * 33] * s1[3]);
        *(u32x4*)(t.dst + (size_t)n * t.ldt + 8 * c) = o; }
    asm volatile("s_waitcnt lgkmcnt(0)" ::: "memory");
}
__device__ __forceinline__ int win_src_col(int n) {
    if (n < 768 || n >= 2304) return n;
    const int q = n - 768, j = q >> 8, r = q & 255;
    return r < 128 ? 768 + j * 128 + r : 1536 + j * 128 + (r - 128);
}
__device__ __forceinline__ void phase_prologue(const Params& p, LAS unsigned char* lds, int skip) {
    int tid = threadIdx.x; asm volatile("" : "+v"(tid));
    const int lane = tid & 63, wave = __builtin_amdgcn_readfirstlane(tid >> 6), gw = blockIdx.x * NWAVE + wave;
    unsigned char* ws = p.ws;
    const float* x = p.in[0]; const float* g_mix = p.in[1]; const float* w_in = p.in[2];
    const float* lam_re = p.in[6]; const float* lam_im = p.in[7]; const float* log_dt = p.in[8]; const float* b_re = p.in[9]; const float* b_im = p.in[10];
    const float* w_glu = p.in[14]; const float* w_a = p.in[16]; const float* w_b = p.in[17]; const float* w_out = p.in[18]; const float* g_ffn = p.in[19]; const float* w_q = p.in[20];
    const float* k1 = p.in[21]; const float* k2 = p.in[22]; const float* eu = p.in[23]; const float* ev = p.in[24];
    const int hw = wave & 3, ghw = blockIdx.x * 4 + hw;
    { const int hs_b = (blockIdx.x * 4) >> 6; const float* keys = (hs_b & 1) ? k2 : k1;
      if (!(skip & 1)) { for (int i = tid; i < 128 * 32; i += NTHR) *(LAS f32x4*)(lds + (size_t)i * 16) = *(const f32x4*)(keys + i * 4); }
      __syncthreads(); }
    if (wave >= 4) {
    if (!(skip & 1)) {
        const int hs = ghw >> 6, dblk = (ghw >> 2) & 15, jq = ghw & 3, d = dblk * 64 + lane;
        f32x4 wq[32];
#pragma unroll
        for (int i = 0; i < 32; ++i) wq[i] = *(const f32x4*)(w_q + (size_t)d * 2048 + hs * 128 + i * 4);
        const float gd = g_ffn[d];
        bf16_t* WS = (bf16_t*)(ws + WS_WS);
        for (int j = jq * 32; j < jq * 32 + 32; ++j) {
            const LAS f32x4* kp = (const LAS f32x4*)(lds + (size_t)j * 512); float s0 = 0.f, s1 = 0.f;
#pragma unroll
            for (int i = 0; i < 32; i += 2) { const f32x4 ka = kp[i], kb = kp[i + 1];
                s0 = fmaf(wq[i][0], ka[0], s0); s0 = fmaf(wq[i][1], ka[1], s0); s0 = fmaf(wq[i][2], ka[2], s0); s0 = fmaf(wq[i][3], ka[3], s0);
                s1 = fmaf(wq[i + 1][0], kb[0], s1); s1 = fmaf(wq[i + 1][1], kb[1], s1); s1 = fmaf(wq[i + 1][2], kb[2], s1); s1 = fmaf(wq[i + 1][3], kb[3], s1); }
            WS[(size_t)(hs * 128 + j) * D + d] = (bf16_t)(pk2bf((s0 + s1) * gd, 0.f) & 0xffffu);
        }
    }
    if (!(skip & 2)) {
        LAS float* scr = (LAS float*)(lds + 65536 + hw * 16384);
        constexpr int I_IN = 16 * 144, I_A = 12 * 32, I_B = 4 * 32, I_O = 16 * 32, I_G = 4 * 8, NIT = I_IN + I_A + I_B + I_O + I_G;
        auto decode = [=](int r) -> TrIt {
            if (r < I_IN) { const int kb = r / 144, nb = r % 144; return TrIt{w_in + (size_t)(kb * 64) * IN_COLS + win_src_col(nb * 32), (bf16_t*)(ws + WS_WIN) + (size_t)(nb * 32) * 1024 + kb * 64, g_mix + kb * 64, IN_COLS, 1024, 1.0f}; } r -= I_IN;
            if (r < I_A) { const int kb = r / 32, nb = r % 32; return TrIt{w_a + (size_t)(kb * 64) * 1024 + nb * 32, (bf16_t*)(ws + WS_WA) + (size_t)(nb * 32) * 768 + kb * 64, nullptr, 1024, 768, 1.0f / 255.0f}; }     r -= I_A;
            if (r < I_B) { const int kb = r / 32, nb = r % 32; return TrIt{w_b + (size_t)(kb * 64) * 1024 + nb * 32, (bf16_t*)(ws + WS_WB) + (size_t)(nb * 32) * 256 + kb * 64, nullptr, 1024, 256, 1.0f / 255.0f}; } r -= I_B;
            if (r < I_O) { const int kb = r / 32, nb = r % 32; return TrIt{w_out + (size_t)(kb * 64) * 1024 + nb * 32, (bf16_t*)(ws + WS_WOUT) + (size_t)(nb * 32) * 1024 + kb * 64, nullptr, 1024, 1024, 1.0f}; } r -= I_O;
            { const int kb = r / 8, nb = r % 8; return TrIt{w_glu + (size_t)(kb * 64) * 256 + nb * 32, (bf16_t*)(ws + WS_WGLU) + (size_t)(nb * 32) * 256 + kb * 64, nullptr, 256, 256, 1.0f}; }
        };
        static_assert(NIT >= 3 * (NGW / 2) && NIT <= 4 * (NGW / 2), "three or four transpose items per wave");
        const bool has3 = ghw + 3 * (NGW / 2) < NIT;
        const TrIt t0 = decode(ghw), t1 = decode(ghw + NGW / 2), t2 = decode(ghw + 2 * (NGW / 2)), t3 = decode(has3 ? ghw + 3 * (NGW / 2) : ghw);
        float v0[32], v1[32], v2[32], v3[32];
        tr_load(t0, lane, v0); tr_load(t1, lane, v1); tr_load(t2, lane, v2); if (has3) tr_load(t3, lane, v3);
        tr_flush(t0, v0, scr, lane); tr_flush(t1, v1, scr, lane); tr_flush(t2, v2, scr, lane); if (has3) tr_flush(t3, v3, scr, lane);
    }
    if (!(skip & 16)) {
        const int g = blockIdx.x >> 4, h = blockIdx.x & 15;
        const float dt = expf(log_dt[g]);
        bf16_t* MEND = (bf16_t*)(ws + WS_MEND); bf16_t* MY = (bf16_t*)(ws + WS_MY);
        {
            const int gp = g * 64 + lane; const float lr = lam_re[gp], li = lam_im[gp];
            float sn1, cs1; sincosf(li * dt, &sn1, &cs1); const float mag1 = expf(lr * dt), ar = mag1 * cs1, ai = mag1 * sn1;
            const float den = lr * lr + li * li, nr = ar - 1.0f, ni = ai, kr = (nr * lr + ni * li) / den, ki = (ni * lr - nr * li) / den;
            float bbr[16], bbi[16];
#pragma unroll
            for (int q = 0; q < 4; ++q) { const f32x4 br = *(const f32x4*)(b_re + (size_t)gp * 16 + q * 4), bi = *(const f32x4*)(b_im + (size_t)gp * 16 + q * 4);
#pragma unroll
                for (int c = 0; c < 4; ++c) { bbr[q * 4 + c] = kr * br[c] - ki * bi[c]; bbi[q * 4 + c] = kr * bi[c] + ki * br[c]; } }
            const float cr = p.in[11][(g * 16 + h) * 64 + lane], ci = p.in[12][(g * 16 + h) * 64 + lane];
            const bool b32 = lane & 32, b16 = lane & 16, b8 = lane & 8, b4 = lane & 4;
            const int jl = ((lane >> 5) & 1) * 8 + ((lane >> 4) & 1) * 4 + ((lane >> 3) & 1) * 2 + ((lane >> 2) & 1);
            LAS float* KCL = (LAS float*)(lds + 77824);
            float pr, pi; { const float d0 = (float)(hw * (CL / 4)); float sn, cs; sincosf(li * dt * d0, &sn, &cs); const float mg = expf(lr * dt * d0); pr = mg * cs; pi = mg * sn; }
#pragma unroll 1
            for (int d = hw * (CL / 4); d < (hw + 1) * (CL / 4); ++d) {
                const float wr_ = cr * pr - ci * pi, wi_ = cr * pi + ci * pr;
                float pd[16];
#pragma unroll
                for (int e = 0; e < 16; ++e) pd[e] = wr_ * bbr[e] - wi_ * bbi[e];
                float q8[8], q4[4], q2[2];
#pragma unroll
                for (int j = 0; j < 8; ++j) { const float keep = b32 ? pd[8 + j] : pd[j], send = b32 ? pd[j] : pd[8 + j]; q8[j] = keep + __shfl_xor(send, 32); }
#pragma unroll
                for (int j = 0; j < 4; ++j) { const float keep = b16 ? q8[4 + j] : q8[j], send = b16 ? q8[j] : q8[4 + j]; q4[j] = keep + __shfl_xor(send, 16); }
#pragma unroll
                for (int j = 0; j < 2; ++j) { const float keep = b8 ? q4[2 + j] : q4[j], send = b8 ? q4[j] : q4[2 + j]; q2[j] = keep + __shfl_xor(send, 8); }
                float hsum; { const float keep = b4 ? q2[1] : q2[0], send = b4 ? q2[0] : q2[1]; hsum = keep + __shfl_xor(send, 4); }
                hsum += __shfl_xor(hsum, 2); hsum += __shfl_xor(hsum, 1);
                if ((lane & 3) == 0) KCL[d * 16 + jl] = hsum;
                const float npr = pr * ar - pi * ai, npi = pr * ai + pi * ar; pr = npr; pi = npi;
            }
        }
        {
            constexpr int JP = CL / 16;
            const int it = tid - 256, n = 16 * h + (it >> 4), jseg = it & 15;
            bf16_t* rowp = MEND + (size_t)(g * 256 + n) * CK;
            if (n < 128) {
                const int gp = g * 64 + (n & 63); const float lr = lam_re[gp], li = lam_im[gp];
                float sn1, cs1; sincosf(li * dt, &sn1, &cs1); const float mag1 = expf(lr * dt), ar = mag1 * cs1, ai = mag1 * sn1;
                const float den = lr * lr + li * li, nr = ar - 1.0f, ni = ai, kr = (nr * lr + ni * li) / den, ki = (ni * lr - nr * li) / den;
                float bbr[16], bbi[16];
#pragma unroll
                for (int q = 0; q < 4; ++q) { const f32x4 br = *(const f32x4*)(b_re + (size_t)gp * 16 + q * 4), bi = *(const f32x4*)(b_im + (size_t)gp * 16 + q * 4);
#pragma unroll
                    for (int c = 0; c < 4; ++c) { bbr[q * 4 + c] = kr * br[c] - ki * bi[c]; bbi[q * 4 + c] = kr * bi[c] + ki * br[c]; } }
                float pr, pi; { const float d0 = (float)(CL - 1 - (jseg * JP + JP - 1)); float sn, cs; sincosf(li * dt * d0, &sn, &cs); const float mg = expf(lr * dt * d0); pr = mg * cs; pi = mg * sn; }
#pragma unroll
                for (int jj = JP - 1; jj >= 0; --jj) { const int jp = jseg * JP + jj;
                    float v[16];
#pragma unroll
                    for (int e = 0; e < 16; ++e) v[e] = n < 64 ? pr * bbr[e] - pi * bbi[e] : pr * bbi[e] + pi * bbr[e];
                    u32x4 o; o.x = pk2bf(v[0], v[1]); o.y = pk2bf(v[2], v[3]); o.z = pk2bf(v[4], v[5]); o.w = pk2bf(v[6], v[7]); *(u32x4*)(rowp + jp * 16) = o;
                    o.x = pk2bf(v[8], v[9]); o.y = pk2bf(v[10], v[11]); o.z = pk2bf(v[12], v[13]); o.w = pk2bf(v[14], v[15]); *(u32x4*)(rowp + jp * 16 + 8) = o;
                    const float npr = pr * ar - pi * ai, npi = pr * ai + pi * ar; pr = npr; pi = npi; }
            } else {
#pragma unroll
                for (int jj = 0; jj < JP; ++jj) { *(u32x4*)(rowp + (jseg * JP + jj) * 16) = (u32x4){0u, 0u, 0u, 0u}; *(u32x4*)(rowp + (jseg * JP + jj) * 16 + 8) = (u32x4){0u, 0u, 0u, 0u}; }
            }
        }
        {
            const int it = tid - 256, pp = it & 63, jseg = it >> 6, gp = g * 64 + pp; const float lr = lam_re[gp], li = lam_im[gp];
            float sn1, cs1; sincosf(li * dt, &sn1, &cs1); const float mag1 = expf(lr * dt), ar = mag1 * cs1, ai = mag1 * sn1;
            const float cr = p.in[11][(g * 16 + h) * 64 + pp], ci = p.in[12][(g * 16 + h) * 64 + pp];
            float pr, pi; { const float d0 = (float)(jseg * (CL / 4) + 1); float sn, cs; sincosf(li * dt * d0, &sn, &cs); const float mg = expf(lr * dt * d0); pr = mg * cs; pi = mg * sn; }
#pragma unroll 1
            for (int j = jseg * (CL / 4); j < (jseg + 1) * (CL / 4); ++j) {
                bf16_t* rowp = MY + ((size_t)(g * CK + j * 16 + h)) * SUK;
                rowp[CK + pp] = (bf16_t)(pk2bf(cr * pr - ci * pi, 0.f) & 0xffffu); rowp[CK + 64 + pp] = (bf16_t)(pk2bf(-(cr * pi + ci * pr), 0.f) & 0xffffu);
                const float npr = pr * ar - pi * ai, npi = pr * ai + pi * ar; pr = npr; pi = npi;
            }
        }
    }
    }
    if (wave < 4) {
    if (!(skip & 4)) {
        bf16_t* XB = (bf16_t*)(ws + WS_XB); float* RINV = (float*)(ws + WS_RINV);
        for (int t0 = ghw; t0 < T; t0 += 2 * NGW) {
            f32x4 a[4][4];
#pragma unroll
            for (int u = 0; u < 4; ++u) { const float* xr = x + (size_t)(t0 + u * (NGW / 2)) * D;
                a[u][0] = *(const f32x4*)(xr + lane * 8); a[u][1] = *(const f32x4*)(xr + lane * 8 + 4); a[u][2] = *(const f32x4*)(xr + 512 + lane * 8); a[u][3] = *(const f32x4*)(xr + 512 + lane * 8 + 4); }
#pragma unroll
            for (int u = 0; u < 4; ++u) { const int t = t0 + u * (NGW / 2); float sq = 0.f;
#pragma unroll
                for (int q = 0; q < 4; ++q) sq += (a[u][q][0] * a[u][q][0] + a[u][q][1] * a[u][q][1]) + (a[u][q][2] * a[u][q][2] + a[u][q][3] * a[u][q][3]);
                sq = wave_sum(sq);
                const float rsd = rsqrtf(sq * (1.0f / D) + RMS_EPS);
                if (lane == 0) RINV[t] = sqrtf(sq * (1.0f / D) + RMS_EPS);
                *(u32x4*)(XB + (size_t)t * D + lane * 8) = pack8(a[u][0] * rsd, a[u][1] * rsd); *(u32x4*)(XB + (size_t)t * D + 512 + lane * 8) = pack8(a[u][2] * rsd, a[u][3] * rsd); }
        }
    }
    if (!(skip & 8)) {
        unsigned char* UQ = ws + WS_UH; unsigned char* VQ = ws + WS_VH; float* USC = (float*)(ws + WS_USC); float* VSC = (float*)(ws + WS_VSC);
        f32x4 gf[4];
#pragma unroll
        for (int q = 0; q < 4; ++q) gf[q] = *(const f32x4*)(g_ffn + lane * 16 + q * 4);
        for (int r0 = ghw; r0 < 2 * 16384; r0 += 2 * NGW) {
            f32x4 v[4][4];
#pragma unroll
            for (int u = 0; u < 4; ++u) { const int r = r0 + u * (NGW / 2); const bool isv = r >= 16384; const int e = isv ? r - 16384 : r; const float* src = (isv ? ev : eu) + (size_t)e * D + lane * 16;
#pragma unroll
                for (int q = 0; q < 4; ++q) v[u][q] = *(const f32x4*)(src + q * 4); }
#pragma unroll
            for (int u = 0; u < 4; ++u) { const int r = r0 + u * (NGW / 2); const bool isv = r >= 16384; const int e = isv ? r - 16384 : r;
                float mx = 0.f;
#pragma unroll
                for (int q = 0; q < 4; ++q) { if (!isv) v[u][q] = v[u][q] * gf[q];
#pragma unroll
                    for (int c = 0; c < 4; ++c) mx = fmaxf(mx, fabsf(v[u][q][c])); }
#pragma unroll
                for (int o = 1; o < 64; o <<= 1) mx = fmaxf(mx, __shfl_xor(mx, o));
                const float sc = mx > 0.f ? mx * (1.0f / 127.0f) : 1.0f, inv = 1.0f / sc;
                u32x4 w;
#pragma unroll
                for (int q = 0; q < 4; ++q) { unsigned d = 0;
#pragma unroll
                    for (int c = 0; c < 4; ++c) { int qi = (int)rintf(v[u][q][c] * inv); qi = qi > 127 ? 127 : (qi < -127 ? -127 : qi); d |= ((unsigned)qi & 0xffu) << (8 * c); }
                    w[q] = d; }
                *(u32x4*)((isv ? VQ : UQ) + ((size_t)(lane >> 3) * 16384 + e) * 128 + (lane & 7) * 16) = w;
                if (lane == 0) (isv ? VSC : USC)[e] = sc; }
        }
    }
    }
    asm volatile("s_waitcnt lgkmcnt(0)" ::: "memory");
    __syncthreads();
    if (!(skip & 16)) {
        const int g = blockIdx.x >> 4, h = blockIdx.x & 15; bf16_t* MY = (bf16_t*)(ws + WS_MY); const LAS float* KCL = (const LAS float*)(lds + 77824);
        for (int it = tid; it < CL * (CK / 8); it += NTHR) {
            const int j = it / (CK / 8), kc = it % (CK / 8), jp = kc >> 1, h0 = (kc & 1) * 8;
            u32x4 w = (u32x4){0u, 0u, 0u, 0u};
            if (j >= jp) { const LAS f32x4* src = (const LAS f32x4*)(KCL + (j - jp) * 16 + h0); const f32x4 a = src[0], b = src[1]; w = pack8(a, b); }
            *(u32x4*)(MY + ((size_t)(g * CK + j * 16 + h)) * SUK + kc * 8) = w;
        }
    }
}

__device__ __forceinline__ void phase_ssm_tables(const Params& p) {
    unsigned char* ws = p.ws; const float* c_re = p.in[11]; const float* c_im = p.in[12];
    const float* POW = (const float*)(ws + WS_POW); const float* BBAR = (const float*)(ws + WS_BBAR);
    float* KC = (float*)(ws + WS_KC); bf16_t* MEND = (bf16_t*)(ws + WS_MEND);
    int tid = threadIdx.x; asm volatile("" : "+v"(tid));
    const int gt = blockIdx.x * NTHR + tid, NT = NBLK * NTHR;
    {
        const int lane = tid & 63, wave = __builtin_amdgcn_readfirstlane(tid >> 6), gw = blockIdx.x * NWAVE + wave;
        const bool b32 = lane & 32, b16 = lane & 16, b8 = lane & 8, b4 = lane & 4;
        const int jl = ((lane >> 5) & 1) * 8 + ((lane >> 4) & 1) * 4 + ((lane >> 3) & 1) * 2 + ((lane >> 2) & 1);
        for (int it = gw; it < 16 * 64 * 16; it += NGW) {
            const int g = it >> 10, d = (it >> 4) & 63, h = it & 15;
            const float cr = c_re[(g * 16 + h) * 64 + lane], ci = c_im[(g * 16 + h) * 64 + lane];
            const float pr = POW[((size_t)(g * 65 + d) * 64 + lane) * 2], pi = POW[((size_t)(g * 65 + d) * 64 + lane) * 2 + 1];
            const float wr_ = cr * pr - ci * pi, wi_ = cr * pi + ci * pr;
            const f32x4* bb = (const f32x4*)(BBAR + (size_t)(g * 64 + lane) * 32);
            float pd[16];
#pragma unroll
            for (int q = 0; q < 8; ++q) { const f32x4 v = bb[q]; pd[2 * q] = wr_ * v[0] - wi_ * v[1]; pd[2 * q + 1] = wr_ * v[2] - wi_ * v[3]; }
            float q8[8], q4[4], q2[2];
#pragma unroll
            for (int j = 0; j < 8; ++j) { const float keep = b32 ? pd[8 + j] : pd[j], send = b32 ? pd[j] : pd[8 + j]; q8[j] = keep + __shfl_xor(send, 32); }
#pragma unroll
            for (int j = 0; j < 4; ++j) { const float keep = b16 ? q8[4 + j] : q8[j], send = b16 ? q8[j] : q8[4 + j]; q4[j] = keep + __shfl_xor(send, 16); }
#pragma unroll
            for (int j = 0; j < 2; ++j) { const float keep = b8 ? q4[2 + j] : q4[j], send = b8 ? q4[j] : q4[2 + j]; q2[j] = keep + __shfl_xor(send, 8); }
            float hsum; { const float keep = b4 ? q2[1] : q2[0], send = b4 ? q2[0] : q2[1]; hsum = keep + __shfl_xor(send, 4); }
            hsum += __shfl_xor(hsum, 2); hsum += __shfl_xor(hsum, 1);
            if ((lane & 3) == 0) KC[(size_t)it * 16 + jl] = hsum;
        }
    }
    for (int i = gt; i < 16 * 256 * 128; i += NT) {
        const int g = i >> 15, n = (i >> 7) & 255, k8 = (i & 127) * 8, jp = k8 >> 4, h0 = k8 & 15;
        u32x4 o = (u32x4){0u, 0u, 0u, 0u};
        if (n < 128) {
            const int pp = n & 63; const float pr = POW[((size_t)(g * 65 + 63 - jp) * 64 + pp) * 2], pi = POW[((size_t)(g * 65 + 63 - jp) * 64 + pp) * 2 + 1];
            float v[8];
#pragma unroll
            for (int e = 0; e < 8; ++e) { const float br = BBAR[((size_t)(g * 64 + pp) * 16 + h0 + e) * 2], bi = BBAR[((size_t)(g * 64 + pp) * 16 + h0 + e) * 2 + 1];
                v[e] = n < 64 ? pr * br - pi * bi : pr * bi + pi * br; }
            o.x = pk2bf(v[0], v[1]); o.y = pk2bf(v[2], v[3]); o.z = pk2bf(v[4], v[5]); o.w = pk2bf(v[6], v[7]);
        }
        *(u32x4*)(MEND + (size_t)i * 8) = o;
    }
}

__device__ __forceinline__ void phase_conv_my(const Params& p, int first_block) {
    if ((int)blockIdx.x < first_block) return;
    unsigned char* ws = p.ws; const float* conv_w = p.in[4]; const float* conv_b = p.in[5]; const float* c_re = p.in[11]; const float* c_im = p.in[12];
    const bf16_t* CB = (const bf16_t*)(ws + WS_CB); const bf16_t* V = (const bf16_t*)(ws + WS_V); bf16_t* A2 = (bf16_t*)(ws + WS_A2);
    const float* KC = (const float*)(ws + WS_KC); const float* POW = (const float*)(ws + WS_POW); bf16_t* MY = (bf16_t*)(ws + WS_MY);
    int tid = threadIdx.x; asm volatile("" : "+v"(tid));
    const int nb = NBLK - first_block, gt = ((int)blockIdx.x - first_block) * NTHR + tid, NT = nb * NTHR;
    const int lane = tid & 63, wave = __builtin_amdgcn_readfirstlane(tid >> 6), gw = ((int)blockIdx.x - first_block) * NWAVE + wave, NW = nb * NWAVE;
    for (int i = gt; i < 96 * (T / 32); i += NT) {
        const int j8 = (i % 96) * 8, t0 = (i / 96) * 32;
        float w0[8], w1[8], w2[8], bb[8];
#pragma unroll
        for (int e = 0; e < 8; ++e) { w0[e] = conv_w[j8 + e]; w1[e] = conv_w[CONV_CH + j8 + e]; w2[e] = conv_w[2 * CONV_CH + j8 + e]; bb[e] = conv_b[j8 + e]; }
        u32x4 vm2 = (u32x4){0u, 0u, 0u, 0u}, vm1 = (u32x4){0u, 0u, 0u, 0u};
        if ((t0 & (SEQ - 1)) != 0) { vm2 = *(const u32x4*)(V + (size_t)(t0 - 2) * CONV_CH + j8); vm1 = *(const u32x4*)(V + (size_t)(t0 - 1) * CONV_CH + j8); }
#pragma unroll 4
        for (int tt = 0; tt < 32; ++tt) {
            const size_t o = (size_t)(t0 + tt) * CONV_CH + j8;
            const u32x4 cb = *(const u32x4*)(CB + o), v0 = *(const u32x4*)(V + o);
            float r[8];
#pragma unroll
            for (int e = 0; e < 8; ++e) {
                const unsigned dc = cb[e >> 1], d0 = v0[e >> 1], d1 = vm1[e >> 1], d2 = vm2[e >> 1];
                const float fc = (e & 1) ? bfhi(dc) : bflo(dc), f0 = (e & 1) ? bfhi(d0) : bflo(d0), f1 = (e & 1) ? bfhi(d1) : bflo(d1), f2 = (e & 1) ? bfhi(d2) : bflo(d2);
                r[e] = fc * (bb[e] + w0[e] * f2 + w1[e] * f1 + w2[e] * f0);
            }
            u32x4 w; w.x = pk2bf(r[0], r[1]); w.y = pk2bf(r[2], r[3]); w.z = pk2bf(r[4], r[5]); w.w = pk2bf(r[6], r[7]);
            *(u32x4*)(A2 + o) = w;
            vm2 = vm1; vm1 = v0;
        }
    }
}

__device__ __forceinline__ void phase_carry(const Params& p) {
    constexpr int NPL = CPS / 64;
    int tid = threadIdx.x; asm volatile("" : "+v"(tid));
    const int lane = tid & 63, wave = __builtin_amdgcn_readfirstlane(tid >> 6), gw = blockIdx.x * NWAVE + wave;
    unsigned char* ws = p.ws; const float* E = (const float*)(ws + WS_E); bf16_t* SU = (bf16_t*)(ws + WS_SU);
    for (int it = gw; it < (T / SEQ) * 1024; it += NGW) {
        const int b = it >> 10, g = (it >> 6) & 15, pp = it & 63;
        float ar, ai; { const float lr = p.in[6][g * 64 + pp], li = p.in[7][g * 64 + pp], dt = expf(p.in[8][g]); float sn, cs; sincosf(li * dt * (float)CL, &sn, &cs); const float mg = expf(lr * dt * (float)CL); ar = mg * cs; ai = mg * sn; }
        const size_t ch0 = (size_t)g * NCHUNK + b * CPS + NPL * lane;
        float er[NPL], ei[NPL];
#pragma unroll
        for (int k = 0; k < NPL; ++k) { er[k] = E[(ch0 + k) * 128 + pp]; ei[k] = E[(ch0 + k) * 128 + 64 + pp]; }
        float sr = 0.f, si = 0.f, mr = 1.f, mi = 0.f;
#pragma unroll
        for (int k = 0; k < NPL; ++k) { const float nr = ar * sr - ai * si + er[k], ni = ar * si + ai * sr + ei[k]; sr = nr; si = ni; const float tr = mr * ar - mi * ai, ti = mr * ai + mi * ar; mr = tr; mi = ti; }
#pragma unroll
        for (int d = 0; d < 6; ++d) { const int off = 1 << d; const float orr = __shfl_up(sr, off), oii = __shfl_up(si, off);
            if (lane >= off) { sr += mr * orr - mi * oii; si += mr * oii + mi * orr; }
            const float nmr = mr * mr - mi * mi, nmi = 2.0f * mr * mi; mr = nmr; mi = nmi; }
        float xr = __shfl_up(sr, 1), xi = __shfl_up(si, 1); if (lane == 0) { xr = 0.f; xi = 0.f; }
#pragma unroll
        for (int k = 0; k < NPL; ++k) {
            SU[(ch0 + k) * SUK + CK + pp] = (bf16_t)(pk2bf(xr, 0.f) & 0xffffu); SU[(ch0 + k) * SUK + CK + 64 + pp] = (bf16_t)(pk2bf(xi, 0.f) & 0xffffu);
            const float nr = ar * xr - ai * xi + er[k], ni = ar * xi + ai * xr + ei[k]; xr = nr; xi = ni; }
    }
}

__device__ __forceinline__ void ins16(float (&a)[16], float x, float big) {
#pragma unroll
    for (int k = 15; k >= 1; --k) a[k] = __builtin_amdgcn_fmed3f(a[k - 1], a[k], x);
    a[0] = __builtin_amdgcn_fmed3f(a[0], x, big);
}
__device__ __forceinline__ void ins16r(float (&a)[16], float x, float big, int R) {
#pragma unroll
    for (int k = 15; k >= 1; --k) if (k >= R) a[k] = __builtin_amdgcn_fmed3f(a[k - 1], a[k], x);
    if (R == 0) a[0] = __builtin_amdgcn_fmed3f(a[0], x, big);
}
__device__ __forceinline__ void phase_topk(const Params& p, LAS unsigned char* lds) {
    unsigned char* ws = p.ws; const unsigned short* SC = (const unsigned short*)(ws + WS_SC); const float* RS2P = (const float*)(ws + WS_RS2P);
    unsigned short* EIDX = (unsigned short*)(ws + WS_EIDX); unsigned short* GATE = (unsigned short*)(ws + WS_GATE);
    int tid = threadIdx.x; asm volatile("" : "+v"(tid));
    const int lane = tid & 63, wave = __builtin_amdgcn_readfirstlane(tid >> 6);
    LAS unsigned char* wst = lds + wave * 17408;
    LAS unsigned* myl = (LAS unsigned*)(wst + lane * 32);
    const float NINF = -__builtin_inff(); float BIG = 3.0e38f; asm volatile("" : "+s"(BIG));
    const int tw0 = blockIdx.x * (T / NBLK) + wave * (T / NGW);
#define TK_LOAD(it_) do { _Pragma("unroll") for (int i = 0; i < 16; ++i)     \
        r[i] = *(const u32x4*)(SC + (size_t)(tw0 + (it_) * 4 + (i >> 2)) * 2048 + (4 * (i & 3) + (lane >> 4)) * 128 + (lane & 15) * 8); } while (0)
    u32x4 r[16];
    TK_LOAD(0);
#pragma unroll 1
    for (int item = 0; item < (T / NGW) / 4; ++item) {
        const int t = tw0 + item * 4 + (lane >> 4), hs = lane & 15, h = hs >> 1, odd = lane & 1;
        f32x4 pv4[4];
#pragma unroll
        for (int q = 0; q < 4; ++q) pv4[q] = *(const f32x4*)(RS2P + (size_t)t * 16 + q * 4);
        float a[16];
#pragma unroll
        for (int k = 0; k < 16; ++k) a[k] = NINF;
        {
#pragma unroll
            for (int i = 0; i < 16; ++i) *(LAS u32x4*)(wst + (lane >> 4) * 272 + (lane & 15) * 16 + i * 1088) = r[i];
            if (item + 1 < (T / NGW) / 4) TK_LOAD(item + 1);
#pragma unroll
            for (int c = 0; c < 16; ++c) { const u32x4 v = *(const LAS u32x4*)(wst + lane * 272 + c * 16);
                float w[4];
#pragma unroll
                for (int e = 0; e < 4; ++e) { const h2 hv = as_h2(v[e]);
                    const float k0 = __uint_as_float(__float_as_uint((float)hv[0]) | (unsigned)(c * 8 + 2 * e)), k1 = __uint_as_float(__float_as_uint((float)hv[1]) | (unsigned)(c * 8 + 2 * e + 1));
                    w[e] = __builtin_amdgcn_fmed3f(k0, k1, BIG); }
                ins16(a, __builtin_amdgcn_fmed3f(w[0], w[1], BIG), BIG); ins16(a, __builtin_amdgcn_fmed3f(w[2], w[3], BIG), BIG);
                __builtin_amdgcn_sched_barrier(0); }
            { unsigned pi[15]; float l2[15];
#pragma unroll
              for (int k = 0; k < 15; ++k) pi[k] = ((__float_as_uint(a[k]) & 127u) >> 1) ^ 1u;
#pragma unroll
              for (int k = 0; k < 15; ++k) { const h2 hv = as_h2(*(const LAS unsigned*)(wst + lane * 272 + pi[k] * 4));
                  const float k0 = __uint_as_float(__float_as_uint((float)hv[0]) | (pi[k] * 2u)), k1 = __uint_as_float(__float_as_uint((float)hv[1]) | (pi[k] * 2u + 1u));
                  l2[k] = __builtin_amdgcn_fmed3f(k0, k1, BIG); }
#pragma unroll
              for (int k = 0; k < 15; ++k) ins16r(a, l2[k], BIG, k + 1); }
            unsigned li[15]; float lk[15];
#pragma unroll
            for (int k = 0; k < 15; ++k) li[k] = (__float_as_uint(a[k]) & 127u) ^ 1u;
#pragma unroll
            for (int k = 0; k < 15; ++k) { const unsigned short hb = *(const LAS unsigned short*)(wst + lane * 272 + li[k] * 2); lk[k] = __uint_as_float(__float_as_uint((float)__builtin_bit_cast(_Float16, hb)) | li[k]); }
#pragma unroll
            for (int k = 0; k < 15; ++k) ins16r(a, lk[k], BIG, k + 1);
        }
        float A[16], B[16];
#pragma unroll
        for (int k = 0; k < 16; ++k) { const float o = __shfl_xor(a[k], 1); A[k] = odd ? o : a[k]; B[k] = odd ? a[k] : o; }
        float f[16];
#pragma unroll
        for (int k = 0; k < 16; ++k) f[k] = NINF;
#pragma unroll
        for (int ia = 0; ia < 16; ++ia)
#pragma unroll
            for (int ib = 0; ib < 16; ++ib)
                if ((ia + 1) * (ib + 1) <= 16) {
                    const unsigned sb = __float_as_uint(A[ia] + B[ib]), sg = (unsigned)((int)sb >> 31);
                    ins16r(f, __uint_as_float((sb & ~255u) | ((sg ^ (255u - (unsigned)(ia * 16 + ib))) & 255u)), BIG, (ia + 1) * (ib + 1) - 1); }
        u32x4 wa, wb;
        wa.x = (__float_as_uint(A[0]) & 127u) | ((__float_as_uint(A[1]) & 127u) << 8) | ((__float_as_uint(A[2]) & 127u) << 16) | ((__float_as_uint(A[3]) & 127u) << 24);
        wa.y = (__float_as_uint(A[4]) & 127u) | ((__float_as_uint(A[5]) & 127u) << 8) | ((__float_as_uint(A[6]) & 127u) << 16) | ((__float_as_uint(A[7]) & 127u) << 24);
        wa.z = (__float_as_uint(A[8]) & 127u) | ((__float_as_uint(A[9]) & 127u) << 8) | ((__float_as_uint(A[10]) & 127u) << 16) | ((__float_as_uint(A[11]) & 127u) << 24);
        wa.w = (__float_as_uint(A[12]) & 127u) | ((__float_as_uint(A[13]) & 127u) << 8) | ((__float_as_uint(A[14]) & 127u) << 16) | ((__float_as_uint(A[15]) & 127u) << 24);
        wb.x = (__float_as_uint(B[0]) & 127u) | ((__float_as_uint(B[1]) & 127u) << 8) | ((__float_as_uint(B[2]) & 127u) << 16) | ((__float_as_uint(B[3]) & 127u) << 24);
        wb.y = (__float_as_uint(B[4]) & 127u) | ((__float_as_uint(B[5]) & 127u) << 8) | ((__float_as_uint(B[6]) & 127u) << 16) | ((__float_as_uint(B[7]) & 127u) << 24);
        wb.z = (__float_as_uint(B[8]) & 127u) | ((__float_as_uint(B[9]) & 127u) << 8) | ((__float_as_uint(B[10]) & 127u) << 16) | ((__float_as_uint(B[11]) & 127u) << 24);
        wb.w = (__float_as_uint(B[12]) & 127u) | ((__float_as_uint(B[13]) & 127u) << 8) | ((__float_as_uint(B[14]) & 127u) << 16) | ((__float_as_uint(B[15]) & 127u) << 24);
        *(LAS u32x4*)myl = wa; *(LAS u32x4*)(myl + 4) = wb;
        float ssq = 0.f;
#pragma unroll
        for (int q = 0; q < 4; ++q) { const f32x4 pv = pv4[q]; ssq += (pv[0] + pv[1]) + (pv[2] + pv[3]); }
        const float rs = rsqrtf(ssq * (1.0f / D) + RMS_EPS);
        float ex[16], sum = 0.f;
#pragma unroll
        for (int k = 0; k < 16; ++k) { ex[k] = __expf(rs * (f[k] - f[0])); sum += ex[k]; }
        const float inv = 1.0f / sum;
        int eo[8]; float go[8]; const unsigned omask = odd ? 0xffffffffu : 0u;
        const LAS unsigned char* mb = (const LAS unsigned char*)myl;
#pragma unroll
        for (int r = 0; r < 8; ++r) {
            const unsigned fsel = (__float_as_uint(f[8 + r]) & omask) | (__float_as_uint(f[r]) & ~omask);
            const unsigned code = ~(fsel ^ (unsigned)((int)fsel >> 31)) & 255u;
            const unsigned i1 = mb[code >> 4], i2 = mb[16 + (code & 15u)];
            eo[r] = (int)(i1 * 128u + i2); go[r] = __uint_as_float((__float_as_uint(ex[8 + r]) & omask) | (__float_as_uint(ex[r]) & ~omask)) * inv;
        }
        const size_t ob = ((size_t)t * 8 + h) * 16 + odd * 8;
        *(u32x4*)(EIDX + ob) = (u32x4){(unsigned)eo[0] | ((unsigned)eo[1] << 16), (unsigned)eo[2] | ((unsigned)eo[3] << 16), (unsigned)eo[4] | ((unsigned)eo[5] << 16), (unsigned)eo[6] | ((unsigned)eo[7] << 16)};
        *(u32x4*)(GATE + ob) = (u32x4){pk2h(go[0], go[1]), pk2h(go[2], go[3]), pk2h(go[4], go[5]), pk2h(go[6], go[7])};
    }
}

#undef TK_LOAD
#define LANE_OF(j) ((((j) >> 3) & 1) * 32 + (((j) >> 2) & 1) * 16 + (((j) >> 1) & 1) * 8 + ((j) & 1) * 4)
__device__ __forceinline__ void axpy4u(float* acc, unsigned d, float w) {
    acc[0] = fmaf((float)(d & 0xffu), w, acc[0]); acc[1] = fmaf((float)((d >> 8) & 0xffu), w, acc[1]);
    acc[2] = fmaf((float)((d >> 16) & 0xffu), w, acc[2]); acc[3] = fmaf((float)(d >> 24), w, acc[3]);
}
constexpr int TPB = T / NBLK, TPW = TPB / NWAVE;
constexpr int EX_EL = 0, EX_HA = TPB * 128 * 2, EX_HS = EX_HA + TPB * 128 * 4, EX_WS = EX_HS + TPB * 4, EX_SS = EX_WS + TPB * 4;
static_assert(EX_SS + TPB * 4 <= LDS_STAGE && NWAVE * 17408 <= LDS_BYTES, "expert phase / routing LDS");
__device__ __forceinline__ void phase_expert(const Params& p, LAS unsigned char* lds) {
    unsigned char* ws = p.ws;
    const bf16_t* X1B = (const bf16_t*)(ws + WS_X1B); const float* RS2P = (const float*)(ws + WS_RS2P);
    const unsigned short* EIDX = (const unsigned short*)(ws + WS_EIDX); const unsigned short* GATE = (const unsigned short*)(ws + WS_GATE);
    const unsigned char* UQ = ws + WS_UH; const unsigned char* VQ = ws + WS_VH; const float* USC = (const float*)(ws + WS_USC); const float* VSC = (const float*)(ws + WS_VSC);
    unsigned char* XQ = ws + WS_XQ;
    const float* gfin = p.in[25]; float* out = p.out;
    unsigned char* const SCb = ws + WS_SC;
    auto x2tmp = [=](size_t t) -> bf16_t* { return (bf16_t*)(SCb + t * 4096); };
    int tid = threadIdx.x; asm volatile("" : "+v"(tid));
    const int lane = tid & 63, wave = __builtin_amdgcn_readfirstlane(tid >> 6);
    const int g = lane >> 3, ch = lane & 7;
    const bool b1 = lane & 1, b2 = lane & 2, b4 = lane & 4, b8 = lane & 8, b16 = lane & 16, b32 = lane & 32;
    LAS unsigned short* EL = (LAS unsigned short*)(lds + EX_EL); LAS int* HA = (LAS int*)(lds + EX_HA);
    LAS float* HS = (LAS float*)(lds + EX_HS); LAS float* WSUM = (LAS float*)(lds + EX_WS); LAS float* SSQ = (LAS float*)(lds + EX_SS);
    const int tl0 = wave * TPW, tg0 = blockIdx.x * TPB;
#pragma unroll 1
    for (int q0 = 0; q0 < TPW; q0 += 4) {
        u32x4 xa4[4], xb4[4]; float sq4[4]; unsigned ew4[4];
#pragma unroll
        for (int u = 0; u < 4; ++u) { const size_t t = (size_t)(tg0 + tl0 + q0 + u);
            xa4[u] = *(const u32x4*)(X1B + t * D + lane * 16); xb4[u] = *(const u32x4*)(X1B + t * D + lane * 16 + 8);
            sq4[u] = (lane < 16) ? RS2P[t * 16 + lane] : 0.f; ew4[u] = *(const unsigned*)(EIDX + t * 128 + 2 * lane); }
#pragma unroll
        for (int u = 0; u < 4; ++u) { const int tl = tl0 + q0 + u; const size_t t = (size_t)(tg0 + tl); const u32x4 xa = xa4[u], xb = xb4[u];
            float xf[16];
            xf[0] = bflo(xa.x); xf[1] = bfhi(xa.x); xf[2] = bflo(xa.y); xf[3] = bfhi(xa.y); xf[4] = bflo(xa.z); xf[5] = bfhi(xa.z); xf[6] = bflo(xa.w); xf[7] = bfhi(xa.w);
            xf[8] = bflo(xb.x); xf[9] = bfhi(xb.x); xf[10] = bflo(xb.y); xf[11] = bfhi(xb.y); xf[12] = bflo(xb.z); xf[13] = bfhi(xb.z); xf[14] = bflo(xb.w); xf[15] = bfhi(xb.w);
            float mx = 0.f;
#pragma unroll
            for (int i = 0; i < 16; ++i) mx = fmaxf(mx, fabsf(xf[i]));
#pragma unroll
            for (int o = 1; o < 64; o <<= 1) mx = fmaxf(mx, __shfl_xor(mx, o));
            const float xsc = mx > 0.f ? mx * (1.0f / 127.0f) : 1.0f, xinv = 1.0f / xsc;
            u32x4 xq;
#pragma unroll
            for (int k = 0; k < 4; ++k) { unsigned d = 0;
#pragma unroll
                for (int c = 0; c < 4; ++c) d |= ((unsigned)(int)rintf(xf[k * 4 + c] * xinv) & 0xffu) << (8 * c);
                xq[k] = d; }
            *(u32x4*)(XQ + t * D + lane * 16) = xq;
            const float ssq = wave_sum(sq4[u]);
            if (lane == 0) { HS[tl] = rsqrtf(ssq * (1.0f / D) + RMS_EPS) * xsc; SSQ[tl] = 0.f; }
            *(LAS unsigned*)(EL + tl * 128 + 2 * lane) = ew4[u];
            HA[tl * 128 + lane] = 0; HA[tl * 128 + 64 + lane] = 0; }
    }
    asm volatile("s_waitcnt vmcnt(0) lgkmcnt(0)" ::: "memory");
    __syncthreads();
#define EXU_LOAD(R, XS, q_) do { const int tl_ = tl0 + (q_); XS = *(const u32x4*)(XQ + (size_t)(tg0 + tl_) * D + s * 128 + ch * 16); \
        _Pragma("unroll") for (int i = 0; i < 16; ++i) { const int e_ = EL[tl_ * 128 + 8 * i + g]; R[i] = *(const u32x4*)(usl + (unsigned)(e_ * 128 + ch * 16)); } } while (0)
#define EXU_COMP(R, XS, q_) do { const int tl_ = tl0 + (q_); int pd[16]; \
        _Pragma("unroll") for (int i = 0; i < 16; ++i) { int sd = dot4z(R[i].x, (int)XS.x); sd = __builtin_amdgcn_sdot4((int)R[i].y, (int)XS.y, sd, false); \
            sd = __builtin_amdgcn_sdot4((int)R[i].z, (int)XS.z, sd, false); sd = __builtin_amdgcn_sdot4((int)R[i].w, (int)XS.w, sd, false); pd[i] = sd; } \
        int q8[8], q4[4], q2[2]; \
        _Pragma("unroll") for (int j = 0; j < 8; ++j) { const int keep = b4 ? pd[8 + j] : pd[j], send = b4 ? pd[j] : pd[8 + j]; q8[j] = keep + __shfl_xor(send, 4); } \
        _Pragma("unroll") for (int j = 0; j < 4; ++j) { const int keep = b2 ? q8[4 + j] : q8[j], send = b2 ? q8[j] : q8[4 + j]; q4[j] = keep + __shfl_xor(send, 2); } \
        _Pragma("unroll") for (int j = 0; j < 2; ++j) { const int keep = b1 ? q4[2 + j] : q4[j], send = b1 ? q4[j] : q4[2 + j]; q2[j] = keep + __shfl_xor(send, 1); } \
        HA[tl_ * 128 + 16 * ch + g] += q2[0]; HA[tl_ * 128 + 16 * ch + 8 + g] += q2[1]; } while (0)
#pragma unroll 1
    for (int s = 0; s < 8; ++s) {
        u32x4 ra[16], rb[16], xsa, xsb; const unsigned char* usl = UQ + (size_t)s * (16384 * 128);
        EXU_LOAD(ra, xsa, 0);
#pragma unroll 1
        for (int q = 0; q < TPW; q += 2) {
            EXU_LOAD(rb, xsb, q + 1);
            EXU_COMP(ra, xsa, q);
            if (q + 2 < TPW) EXU_LOAD(ra, xsa, q + 2);
            EXU_COMP(rb, xsb, q + 1);
        }
    }
#undef EXU_LOAD
#undef EXU_COMP
#pragma unroll 1
    for (int q0 = 0; q0 < TPW; q0 += 4) {
        float hv[4][2], us[4][2], vs[4][2], gt[4][2];
#pragma unroll
        for (int u = 0; u < 4; ++u) { const int tl = tl0 + q0 + u; const size_t t = (size_t)(tg0 + tl);
#pragma unroll
            for (int hlf = 0; hlf < 2; ++hlf) { const int k = hlf * 64 + lane; const int e = EL[tl * 128 + k];
                hv[u][hlf] = (float)HA[tl * 128 + k]; us[u][hlf] = USC[e]; vs[u][hlf] = VSC[e]; gt[u][hlf] = (float)__builtin_bit_cast(_Float16, GATE[t * 128 + k]); } }
#pragma unroll
        for (int u = 0; u < 4; ++u) { const int tl = tl0 + q0 + u; const float hs = HS[tl];
            float w2[2];
#pragma unroll
            for (int hlf = 0; hlf < 2; ++hlf) w2[hlf] = gt[u][hlf] * gelu_exact(hv[u][hlf] * (hs * us[u][hlf])) * vs[u][hlf];
            float wm = fmaxf(fabsf(w2[0]), fabsf(w2[1]));
#pragma unroll
            for (int o = 1; o < 64; o <<= 1) wm = fmaxf(wm, __shfl_xor(wm, o));
            const float wsc = wm > 0.f ? wm * (1.0f / 127.0f) : 1.0f, winv = 1.0f / wsc;
            LAS signed char* WQ = (LAS signed char*)(HA + tl * 128);
#pragma unroll
            for (int hlf = 0; hlf < 2; ++hlf) { const int i = hlf * 8 + (lane >> 3), gg = lane & 7;
                WQ[((i >> 2) * 8 + gg) * 4 + (i & 3)] = (signed char)(int)rintf(w2[hlf] * winv); }
            if (lane == 0) WSUM[tl] = wsc; }
    }
#define EXV_LOAD(R, XR, q_) do { const int tl_ = tl0 + (q_); XR = *(const unsigned*)(X1B + (size_t)(tg0 + tl_) * D + s * 128 + ch * 16 + 2 * g); \
        _Pragma("unroll") for (int i = 0; i < 16; ++i) { const int e_ = EL[tl_ * 128 + 8 * i + g]; R[i] = *(const u32x4*)(vsl + (unsigned)(e_ * 128 + ch * 16)); } } while (0)
#define EXV_COMP(R, XR, q_) do { const int tl_ = tl0 + (q_); const size_t t_ = (size_t)(tg0 + tl_); int acc[16]; \
        _Pragma("unroll") for (int a = 0; a < 4; ++a) { const int wd = HA[tl_ * 128 + a * 8 + g]; \
            _Pragma("unroll") for (int c4 = 0; c4 < 4; ++c4) { const unsigned x0 = R[4 * a][c4], x1 = R[4 * a + 1][c4], x2 = R[4 * a + 2][c4], x3 = R[4 * a + 3][c4]; \
                const unsigned p01l = __builtin_amdgcn_perm(x1, x0, 0x05010400u), p01h = __builtin_amdgcn_perm(x1, x0, 0x07030602u), p23l = __builtin_amdgcn_perm(x3, x2, 0x05010400u), p23h = __builtin_amdgcn_perm(x3, x2, 0x07030602u); \
                { const unsigned tb_ = __builtin_amdgcn_perm(p23l, p01l, 0x05040100u); acc[4 * c4 + 0] = (a == 0) ? dot4z(tb_, wd) : __builtin_amdgcn_sdot4((int)tb_, wd, acc[4 * c4 + 0], false); } \
                { const unsigned tb_ = __builtin_amdgcn_perm(p23l, p01l, 0x07060302u); acc[4 * c4 + 1] = (a == 0) ? dot4z(tb_, wd) : __builtin_amdgcn_sdot4((int)tb_, wd, acc[4 * c4 + 1], false); } \
                { const unsigned tb_ = __builtin_amdgcn_perm(p23h, p01h, 0x05040100u); acc[4 * c4 + 2] = (a == 0) ? dot4z(tb_, wd) : __builtin_amdgcn_sdot4((int)tb_, wd, acc[4 * c4 + 2], false); } \
                { const unsigned tb_ = __builtin_amdgcn_perm(p23h, p01h, 0x07060302u); acc[4 * c4 + 3] = (a == 0) ? dot4z(tb_, wd) : __builtin_amdgcn_sdot4((int)tb_, wd, acc[4 * c4 + 3], false); } } } \
        int r8[8], r4[4], r2[2]; \
        _Pragma("unroll") for (int j = 0; j < 8; ++j) { const int keep = b32 ? acc[8 + j] : acc[j], send = b32 ? acc[j] : acc[8 + j]; r8[j] = keep + __shfl_xor(send, 32); } \
        _Pragma("unroll") for (int j = 0; j < 4; ++j) { const int keep = b16 ? r8[4 + j] : r8[j], send = b16 ? r8[j] : r8[4 + j]; r4[j] = keep + __shfl_xor(send, 16); } \
        _Pragma("unroll") for (int j = 0; j < 2; ++j) { const int keep = b8 ? r4[2 + j] : r4[j], send = b8 ? r4[j] : r4[2 + j]; r2[j] = keep + __shfl_xor(send, 8); } \
        const size_t o_ = t_ * D + s * 128 + ch * 16 + 2 * g; const float wsc_ = WSUM[tl_];     \
        const unsigned xr_ = XR; \
        const float v0_ = bflo(xr_) + wsc_ * (float)r2[0], v1_ = bfhi(xr_) + wsc_ * (float)r2[1]; \
        *(unsigned*)(x2tmp(t_) + s * 128 + ch * 16 + 2 * g) = pk2bf(v0_, v1_);     \
        float ss_ = v0_ * v0_ + v1_ * v1_; ss_ = wave_sum(ss_); \
        if (lane == 0) SSQ[tl_] += ss_; } while (0)
#pragma unroll 1
    for (int s = 0; s < 8; ++s) {
        u32x4 ra[16], rb[16]; unsigned xra, xrb; const unsigned char* vsl = VQ + (size_t)s * (16384 * 128);
        EXV_LOAD(ra, xra, 0);
#pragma unroll 1
        for (int q = 0; q < TPW; q += 2) {
            EXV_LOAD(rb, xrb, q + 1);
            EXV_COMP(ra, xra, q);
            if (q + 2 < TPW) EXV_LOAD(ra, xra, q + 2);
            EXV_COMP(rb, xrb, q + 1);
        }
    }
#undef EXV_LOAD
#undef EXV_COMP
    asm volatile("s_waitcnt vmcnt(0) lgkmcnt(0)" ::: "memory");
    const f32x4 gn0 = *(const f32x4*)(gfin + lane * 16), gn1 = *(const f32x4*)(gfin + lane * 16 + 4), gn2 = *(const f32x4*)(gfin + lane * 16 + 8), gn3 = *(const f32x4*)(gfin + lane * 16 + 12);
#pragma unroll 1
    for (int q0 = 0; q0 < TPW; q0 += 4) {
        u32x4 xa4[4], xb4[4];
#pragma unroll
        for (int u = 0; u < 4; ++u) { const bf16_t* xrow = x2tmp((size_t)(tg0 + tl0 + q0 + u)) + lane * 16; xa4[u] = *(const u32x4*)xrow; xb4[u] = *(const u32x4*)(xrow + 8); }
#pragma unroll
        for (int u = 0; u < 4; ++u) { const int tl = tl0 + q0 + u; const size_t t = (size_t)(tg0 + tl); const u32x4 xa = xa4[u], xb = xb4[u];
            const float rn = rsqrtf(SSQ[tl] * (1.0f / D) + RMS_EPS);
            float* orow = out + t * D + lane * 16;
            *(f32x4*)(orow) = (f32x4){bflo(xa.x), bfhi(xa.x), bflo(xa.y), bfhi(xa.y)} * rn * gn0;
            *(f32x4*)(orow + 4) = (f32x4){bflo(xa.z), bfhi(xa.z), bflo(xa.w), bfhi(xa.w)} * rn * gn1;
            *(f32x4*)(orow + 8) = (f32x4){bflo(xb.x), bfhi(xb.x), bflo(xb.y), bfhi(xb.y)} * rn * gn2;
            *(f32x4*)(orow + 12) = (f32x4){bflo(xb.z), bfhi(xb.z), bflo(xb.w), bfhi(xb.w)} * rn * gn3; }
    }
}

#if DBG
constexpr int SSM_CH = 256, SSM_GROUPS = 16, SSM_STATE = 64, SSM_GROUP = 16;
constexpr int PEER_HEADS = 8, PEER_KEYS = 128, PEER_HALF = 128, PEER_TOPK = 16, PEER_QD = 2048;
__device__ __forceinline__ float sigm_n(float v) { return 1.0f / (1.0f + expf(-v)); }
__global__ void __launch_bounds__(256) ngemm(const float* __restrict__ A, int lda, const float* __restrict__ B, int ldb,
                                             float* __restrict__ C, int ldc, int M, int N, int K) {
    __shared__ float As[16][64 + 4];
    __shared__ float Bs[16][64 + 4];
    const int tx = threadIdx.x & 15, ty = threadIdx.x >> 4;
    const int bm = blockIdx.y * 64, bn = blockIdx.x * 64;
    float acc[4][4] = {};
    for (int k0 = 0; k0 < K; k0 += 16) {
        {
            const int r = threadIdx.x >> 2, c4 = (threadIdx.x & 3) * 4;
            const float4 v = *(const float4*)(A + (size_t)(bm + r) * lda + k0 + c4);
            As[c4 + 0][r] = v.x; As[c4 + 1][r] = v.y; As[c4 + 2][r] = v.z; As[c4 + 3][r] = v.w;
            const int rb = threadIdx.x >> 4, cb4 = (threadIdx.x & 15) * 4;
            const float4 w = *(const float4*)(B + (size_t)(k0 + rb) * ldb + bn + cb4);
            Bs[rb][cb4 + 0] = w.x; Bs[rb][cb4 + 1] = w.y; Bs[rb][cb4 + 2] = w.z; Bs[rb][cb4 + 3] = w.w;
        }
        __syncthreads();
#pragma unroll
        for (int k = 0; k < 16; ++k) {
            float a[4], b[4];
#pragma unroll
            for (int i = 0; i < 4; ++i) a[i] = As[k][ty * 4 + i];
#pragma unroll
            for (int j = 0; j < 4; ++j) b[j] = Bs[k][tx * 4 + j];
#pragma unroll
            for (int i = 0; i < 4; ++i)
#pragma unroll
                for (int j = 0; j < 4; ++j) acc[i][j] = fmaf(a[i], b[j], acc[i][j]);
        }
        __syncthreads();
    }
#pragma unroll
    for (int i = 0; i < 4; ++i) {
        float4 o = make_float4(acc[i][0], acc[i][1], acc[i][2], acc[i][3]);
        *(float4*)(C + (size_t)(bm + ty * 4 + i) * ldc + bn + tx * 4) = o;
    }
}

__global__ void __launch_bounds__(256) n_rmsnorm(const float* __restrict__ x, const float* __restrict__ g, float* __restrict__ y) {
    __shared__ float red[4];
    const size_t row = blockIdx.x;
    const float4 v = *(const float4*)(x + row * D + threadIdx.x * 4);
    float s = v.x * v.x + v.y * v.y + v.z * v.z + v.w * v.w;
    for (int o = 32; o > 0; o >>= 1) s += __shfl_xor(s, o);
    if ((threadIdx.x & 63) == 0) red[threadIdx.x >> 6] = s;
    __syncthreads();
    const float tot = red[0] + red[1] + red[2] + red[3];
    const float r = rsqrtf(tot * (1.0f / D) + RMS_EPS);
    const float4 gg = *(const float4*)(g + threadIdx.x * 4);
    float4 o = make_float4(v.x * r * gg.x, v.y * r * gg.y, v.z * r * gg.z, v.w * r * gg.w);
    *(float4*)(y + row * D + threadIdx.x * 4) = o;
}

__global__ void __launch_bounds__(256) n_conv(const float* __restrict__ proj, const float* __restrict__ cw, const float* __restrict__ cbias,
                                              float* __restrict__ am, int S) {
    const size_t i = (size_t)blockIdx.x * 256 + threadIdx.x;
    const int t = (int)(i / CONV_CH), j = (int)(i % CONV_CH);
    if (t >= S) return;
    const float* pr = proj + (size_t)t * IN_COLS;
    float y = cbias[j];
#pragma unroll
    for (int k = 0; k < 3; ++k) {
        const int tt = t - 2 + k;
        if (tt >= 0) { const float* q = proj + (size_t)tt * IN_COLS; y += cw[k * CONV_CH + j] * (q[CONV_CH + j] * q[2 * CONV_CH + j]); }
    }
    am[(size_t)t * CONV_CH + j] = pr[j] * y;
}

__global__ void n_ssm_const(const float* lam_re, const float* lam_im, const float* log_dt, float* cst) {
    const int i = blockIdx.x * blockDim.x + threadIdx.x;
    if (i >= 1024) return;
    const int g = i >> 6;
    const float lr = lam_re[i], li = lam_im[i], dt = expf(log_dt[g]);
    const float mag = expf(lr * dt), ang = li * dt;
    const float ar = mag * cosf(ang), ai = mag * sinf(ang);
    const float den = lr * lr + li * li, nr = ar - 1.0f, ni = ai;
    cst[i] = ar; cst[1024 + i] = ai; cst[2048 + i] = (nr * lr + ni * li) / den; cst[3072 + i] = (ni * lr - nr * li) / den;
}
__global__ void __launch_bounds__(256) n_ssm_x(const float* __restrict__ proj, const float* __restrict__ bre, const float* __restrict__ bim,
                                               const float* __restrict__ cst, float* __restrict__ xr, float* __restrict__ xi, int S) {
    const size_t i = (size_t)blockIdx.x * 256 + threadIdx.x;
    const int t = (int)(i >> 10), gp = (int)(i & 1023), g = gp >> 6;
    if (t >= S) return;
    const float* u = proj + (size_t)t * IN_COLS + 3 * CONV_CH + g * 16;
    float br = 0.f, bi = 0.f;
#pragma unroll
    for (int h = 0; h < 16; ++h) { br = fmaf(u[h], bre[gp * 16 + h], br); bi = fmaf(u[h], bim[gp * 16 + h], bi); }
    const float kr = cst[2048 + gp], ki = cst[3072 + gp];
    xr[i] = kr * br - ki * bi; xi[i] = kr * bi + ki * br;
}
__global__ void __launch_bounds__(256) n_ssm_scan(const float* __restrict__ cst, float* __restrict__ xr, float* __restrict__ xi, int S) {
    const int gp = blockIdx.x * 256 + threadIdx.x;
    const float ar = cst[gp], ai = cst[1024 + gp];
    float sr = 0.f, si = 0.f;
    for (int t = 0; t < S; ++t) {
        const size_t o = (size_t)t * 1024 + gp;
        const float a = xr[o], b = xi[o];
        const float nr = ar * sr - ai * si + a, ni = ar * si + ai * sr + b;
        sr = nr; si = ni; xr[o] = sr; xi[o] = si;
    }
}
__global__ void __launch_bounds__(256) n_ssm_y(const float* __restrict__ proj, const float* __restrict__ sr, const float* __restrict__ si,
                                               const float* __restrict__ cre, const float* __restrict__ cim, const float* __restrict__ dsk,
                                               float* __restrict__ z, int S) {
    const size_t i = (size_t)blockIdx.x * 256 + threadIdx.x;
    const int t = (int)(i >> 8), c = (int)(i & 255), g = c >> 4;
    if (t >= S) return;
    const float* a = sr + (size_t)t * 1024 + g * 64; const float* b = si + (size_t)t * 1024 + g * 64;
    float y = 0.f;
    for (int p = 0; p < 64; ++p) y += a[p] * cre[c * 64 + p] - b[p] * cim[c * 64 + p];
    y += dsk[c] * proj[(size_t)t * IN_COLS + 3 * CONV_CH + c];
    z[i] = gelu_exact(y);
}
__global__ void __launch_bounds__(256) n_glu(const float* __restrict__ z, const float* __restrict__ lin, const float* __restrict__ bglu, float* __restrict__ o, size_t n) {
    const size_t i = (size_t)blockIdx.x * 256 + threadIdx.x; if (i >= n) return;
    o[i] = z[i] * sigm_n(lin[i] + bglu[i & 255]);
}
__global__ void __launch_bounds__(256) n_merge(const float* __restrict__ proj, const float* __restrict__ bg, const float* __restrict__ ya,
                                               const float* __restrict__ yb, float* __restrict__ m, size_t n) {
    const size_t i = (size_t)blockIdx.x * 256 + threadIdx.x; if (i >= n) return;
    const size_t t = i >> 10; const int d = (int)(i & 1023);
    const float* gl = proj + t * IN_COLS + 3 * CONV_CH + SSM_CH;
    m[i] = sigm_n(gl[d] + bg[d]) * ya[i] + sigm_n(gl[D + d] + bg[D + d]) * yb[i];
}
__global__ void __launch_bounds__(256) n_add(const float* __restrict__ a, float* __restrict__ b, size_t n) {
    const size_t i = (size_t)blockIdx.x * 256 + threadIdx.x; if (i >= n) return; b[i] += a[i];
}

__device__ __forceinline__ void wave_argmax(float& v, int& idx) {
    for (int o = 32; o > 0; o >>= 1) {
        const float ov = __shfl_xor(v, o); const int oi = __shfl_xor(idx, o);
        if (ov > v || (ov == v && oi < idx)) { v = ov; idx = oi; }
    }
}
__global__ void __launch_bounds__(256) n_route(const float* __restrict__ q, const float* __restrict__ k1, const float* __restrict__ k2,
                                               int* __restrict__ eidx, float* __restrict__ gate) {
    __shared__ float qs[PEER_QD];
    __shared__ float sc[PEER_QD];
    __shared__ float tv[16][16]; __shared__ int ti[16][16];
    const size_t t = blockIdx.x; const int tid = threadIdx.x, lane = tid & 63, w = tid >> 6;
    for (int i = tid; i < PEER_QD; i += 256) qs[i] = q[t * PEER_QD + i];
    __syncthreads();
    for (int i = tid; i < PEER_QD; i += 256) {
        const int hs = i >> 7, n = i & 127, side = hs & 1;
        const float* kk = (side ? k2 : k1) + n * PEER_HALF; const float* qq = qs + hs * 128;
        float s = 0.f;
        for (int k = 0; k < 128; ++k) s = fmaf(qq[k], kk[k], s);
        sc[i] = s;
    }
    __syncthreads();
    for (int gi = 0; gi < 4; ++gi) {
        const int grp = w * 4 + gi;
        float a0 = sc[grp * 128 + lane], a1 = sc[grp * 128 + 64 + lane];
        for (int it = 0; it < 16; ++it) {
            float v; int idx;
            if (a0 >= a1) { v = a0; idx = lane; } else { v = a1; idx = lane + 64; }
            wave_argmax(v, idx);
            if (lane == 0) { tv[grp][it] = v; ti[grp][it] = idx; }
            if (idx == lane) a0 = -INFINITY; if (idx == lane + 64) a1 = -INFINITY;
        }
    }
    __syncthreads();
    for (int hh = 0; hh < 2; ++hh) {
        const int h = w * 2 + hh;
        float c[4]; int ci[4];
#pragma unroll
        for (int j = 0; j < 4; ++j) { const int pos = j * 64 + lane, a = pos >> 4, b = pos & 15; c[j] = tv[2 * h][a] + tv[2 * h + 1][b]; ci[j] = pos; }
        float bestv = 0.f; int beste = 0; float mx = 0.f;
        for (int it = 0; it < 16; ++it) {
            float v = c[0]; int idx = ci[0];
#pragma unroll
            for (int j = 1; j < 4; ++j) if (c[j] > v) { v = c[j]; idx = ci[j]; }
            wave_argmax(v, idx);
#pragma unroll
            for (int j = 0; j < 4; ++j) if (ci[j] == idx) c[j] = -INFINITY;
            if (it == 0) mx = v;
            if (lane == it) { bestv = v; beste = ti[2 * h][idx >> 4] * PEER_KEYS + ti[2 * h + 1][idx & 15]; }
        }
        float e = (lane < 16) ? expf(bestv - mx) : 0.f;
        float s = e; for (int o = 32; o > 0; o >>= 1) s += __shfl_xor(s, o);
        if (lane < 16) { eidx[t * 128 + h * 16 + lane] = beste; gate[t * 128 + h * 16 + lane] = e / s; }
    }
}

__global__ void __launch_bounds__(256) n_expert(const float* __restrict__ xn, const float* __restrict__ x1, const int* __restrict__ eidx,
                                                const float* __restrict__ gate, const float* __restrict__ eu, const float* __restrict__ ev,
                                                const float* __restrict__ gfin, float* __restrict__ out) {
    const size_t t = (size_t)blockIdx.x * 4 + (threadIdx.x >> 6); const int lane = threadIdx.x & 63;
    float4 xv[4], acc[4];
#pragma unroll
    for (int i = 0; i < 4; ++i) { xv[i] = *(const float4*)(xn + t * D + i * 256 + lane * 4); acc[i] = make_float4(0.f, 0.f, 0.f, 0.f); }
    for (int k = 0; k < 128; ++k) {
        const int e = eidx[t * 128 + k]; const float gt = gate[t * 128 + k];
        const float* ur = eu + (size_t)e * D; const float* vr = ev + (size_t)e * D;
        float s = 0.f;
#pragma unroll
        for (int i = 0; i < 4; ++i) { const float4 u = *(const float4*)(ur + i * 256 + lane * 4); s += u.x * xv[i].x + u.y * xv[i].y + u.z * xv[i].z + u.w * xv[i].w; }
        for (int o = 32; o > 0; o >>= 1) s += __shfl_xor(s, o);
        const float wgt = gt * gelu_exact(s);
#pragma unroll
        for (int i = 0; i < 4; ++i) { const float4 v = *(const float4*)(vr + i * 256 + lane * 4);
            acc[i].x = fmaf(wgt, v.x, acc[i].x); acc[i].y = fmaf(wgt, v.y, acc[i].y); acc[i].z = fmaf(wgt, v.z, acc[i].z); acc[i].w = fmaf(wgt, v.w, acc[i].w); }
    }
    float ss = 0.f;
#pragma unroll
    for (int i = 0; i < 4; ++i) { const float4 r = *(const float4*)(x1 + t * D + i * 256 + lane * 4);
        acc[i].x += r.x; acc[i].y += r.y; acc[i].z += r.z; acc[i].w += r.w;
        ss += acc[i].x * acc[i].x + acc[i].y * acc[i].y + acc[i].z * acc[i].z + acc[i].w * acc[i].w; }
    for (int o = 32; o > 0; o >>= 1) ss += __shfl_xor(ss, o);
    const float r = rsqrtf(ss * (1.0f / D) + RMS_EPS);
#pragma unroll
    for (int i = 0; i < 4; ++i) { const float4 g = *(const float4*)(gfin + i * 256 + lane * 4);
        *(float4*)(out + t * D + i * 256 + lane * 4) = make_float4(acc[i].x * r * g.x, acc[i].y * r * g.y, acc[i].z * r * g.z, acc[i].w * r * g.w); }
}


__device__ __forceinline__ float bf_at(const bf16_t* p, size_t i) { return __uint_as_float(((unsigned)p[i]) << 16); }
template <class F> __device__ __forceinline__ void dbg_cmp(unsigned char* ws, int id, int rows, int cols, F f) {
    float e2 = 0.f, r2 = 0.f;
    const size_t n = (size_t)rows * cols;
    int tid = threadIdx.x; asm volatile("" : "+v"(tid));
    for (size_t i = (size_t)blockIdx.x * NTHR + tid; i < n; i += (size_t)NBLK * NTHR) { float a, b; f((int)(i / cols), (int)(i % cols), a, b); e2 += (a - b) * (a - b); r2 += b * b; }
    e2 = wave_sum(e2); r2 = wave_sum(r2);
    if ((tid & 63) == 0) { atomicAdd((float*)(ws + DB_ACC) + id * 2, e2); atomicAdd((float*)(ws + DB_ACC) + id * 2 + 1, r2); }
}
__global__ void dbg_report(const float* acc, float* out, int n, int first_id) {
    float c = 0.f;
    for (int id = first_id; id < 32; ++id) { const float e2 = acc[id * 2], r2 = acc[id * 2 + 1]; if (r2 <= 0.f) continue; const float rel = sqrtf(e2 / r2);
        const float thr = id == 12 ? 0.22f : id == 13 ? 0.1f : DBG_THR;
        if (rel > thr || !(rel == rel)) { int d = (rel == rel) ? (int)(-4.0f * log10f(fminf(rel, 1.0f)) + 0.5f) : 9; if (d > 9) d = 9; c = sqrtf((float)(id * 10 + d) - 1.0f); break; } }
    for (int i = blockIdx.x * blockDim.x + threadIdx.x; i < n; i += gridDim.x * blockDim.x) out[i] = c;
}
#endif
__global__ void __launch_bounds__(512, 2) fwd_megakernel(Params p) {
    extern __shared__ __attribute__((aligned(16))) unsigned char smem[];
    LAS unsigned char* lds = (LAS unsigned char*)smem;
    unsigned char* ws = p.ws;
    volatile LAS unsigned* bst = (volatile LAS unsigned*)(lds + LDS_MISC);
    if (threadIdx.x < 4) bst[threadIdx.x] = 0u;
    *(LAS f32x4*)(lds + LDS_GBIAS + threadIdx.x * 16) = *(const f32x4*)(p.in[3] + threadIdx.x * 4);
    __syncthreads();
    XcdBarrier bar = xcd_barrier_post((unsigned*)(ws + WS_CTL), bst);
    Order S;
    TSTAMP(0);
    for (int rep_ah = 0; rep_ah < REP_AH; ++rep_ah) {
    for (int rp_ = 0; rp_ < (REP_PH == 1 ? 2 : 1); ++rp_) {
    phase_prologue(p, lds, rp_ ? SKIPA : 0);
    xcd_barrier(bar); TSTAMP(1);
    }
    for (int rp_ = 0; rp_ < (REP_PH == 2 ? 2 : 1); ++rp_) {
    { Gemm g{(const bf16_t*)(ws + WS_XB), (const bf16_t*)(ws + WS_WIN), 1024, 1024, 1024, 0, 0}; S.init(T, IN_COLS, 1, 0);
      EpiG1 e{(const LAS float*)(lds + LDS_GBIAS), (bf16_t*)(ws + WS_CB), (bf16_t*)(ws + WS_V), (bf16_t*)(ws + WS_SU), ws + WS_G};
      if (NULLG1 == 1 && rp_) { EpiNull en; gemm_phase(lds, g, S, en); } else if (NULLG1 == 2 && rp_) { EpiG1T<true> en{(const LAS float*)(lds + LDS_GBIAS), nullptr, nullptr, nullptr, nullptr}; gemm_phase(lds, g, S, en); } else
      gemm_phase(lds, g, S, e); }
    xcd_barrier(bar); TSTAMP(2);
    DBGC({ const float* pj = (const float*)(ws + DB_PROJ); const float* bg = p.in[3];
      const bf16_t* CBp = (const bf16_t*)(ws + WS_CB); const bf16_t* Vp = (const bf16_t*)(ws + WS_V); const bf16_t* SUp = (const bf16_t*)(ws + WS_SU); const bf16_t* Gp = (const bf16_t*)(ws + WS_G);
      dbg_cmp(ws, 1, NB, 768, [=](int t, int c, float& a, float& b) { a = bf_at(CBp, (size_t)t * 768 + c); b = pj[(size_t)t * IN_COLS + c]; });
      dbg_cmp(ws, 2, NB, 768, [=](int t, int c, float& a, float& b) { a = bf_at(Vp, (size_t)t * 768 + c); b = pj[(size_t)t * IN_COLS + 768 + c] * pj[(size_t)t * IN_COLS + 1536 + c]; });
      dbg_cmp(ws, 3, NB, 256, [=](int t, int c, float& a, float& b) { a = bf_at(SUp, ((size_t)(c >> 4) * NCHUNK + (t >> LOGCL)) * SUK + (t & (CL - 1)) * 16 + (c & 15)); b = pj[(size_t)t * IN_COLS + 2304 + c]; });
      dbg_cmp(ws, 4, NB, 2048, [=](int t, int c, float& a, float& b) { a = bf_at(Gp, (size_t)t * 2048 + c); b = sigm_n(pj[(size_t)t * IN_COLS + 2560 + c] + bg[c]); }); })
    }
    for (int rp_ = 0; rp_ < (REP_PH == 3 ? 2 : 1); ++rp_) {
    phase_conv_my(p, 16 * (NCHUNK / BM));
    { Gemm g{(const bf16_t*)(ws + WS_SU), (const bf16_t*)(ws + WS_MEND), SUK, CK, CK, (long)NCHUNK * SUK, (long)256 * CK}; S.init(NCHUNK, 256, 16, 0); S.window(0, S.u1, 0, 16 * (NCHUNK / BM));
      EpiE e{(float*)(ws + WS_E)}; gemm_phase(lds, g, S, e); }
    xcd_barrier(bar); TSTAMP(3);
    DBGC({ const bf16_t* A2p = (const bf16_t*)(ws + WS_A2); const float* am = (const float*)(ws + DB_AM);
      dbg_cmp(ws, 5, NB, 768, [=](int t, int c, float& a, float& b) { a = bf_at(A2p, (size_t)t * 768 + c); b = am[(size_t)t * 768 + c]; }); })
    }
    for (int rp_ = 0; rp_ < (REP_PH == 4 ? 2 : 1); ++rp_) {
    phase_carry(p);
    { Gemm g{(const bf16_t*)(ws + WS_A2), (const bf16_t*)(ws + WS_WA), 768, 768, 768, 0, 0}; S.init(T, 1024, 1, 0); S.window(0, S.u1 / 2, 0, NBLK);
      EpiP e{ws + WS_G, (bf16_t*)(ws + WS_P)}; gemm_phase(lds, g, S, e); }
    xcd_barrier(bar); TSTAMP(4);
    }
    for (int rp_ = 0; rp_ < (REP_PH == 5 ? 2 : 1); ++rp_) {
    { Gemm g{(const bf16_t*)(ws + WS_SU), (const bf16_t*)(ws + WS_MY), SUK, SUK, SUK, (long)NCHUNK * SUK, (long)CK * SUK}; S.init(NCHUNK, CK, 16, 0); S.window(0, S.u1, 0, NBLK / 2);
      EpiY e{(const bf16_t*)(ws + WS_SU), p.in[13], (bf16_t*)(ws + WS_Z)}; gemm_phase(lds, g, S, e); }
    { Gemm g{(const bf16_t*)(ws + WS_A2), (const bf16_t*)(ws + WS_WA), 768, 768, 768, 0, 0}; S.init(T, 1024, 1, 0); S.window(S.u1 / 2, S.u1, NBLK / 2, NBLK / 2);
      EpiP e{ws + WS_G, (bf16_t*)(ws + WS_P)}; gemm_phase(lds, g, S, e); }
    xcd_barrier(bar); TSTAMP(5);
    DBGC({ const bf16_t* Pp = (const bf16_t*)(ws + WS_P); const float* ya = (const float*)(ws + DB_YA); const float* pj = (const float*)(ws + DB_PROJ); const float* bg = p.in[3];
      dbg_cmp(ws, 6, NB, 1024, [=](int t, int c, float& a, float& b) { a = bf_at(Pp, (size_t)t * 1024 + c); b = ya[(size_t)t * 1024 + c] * sigm_n(pj[(size_t)t * IN_COLS + 2560 + c] + bg[c]); }); })
    DBGC({ const bf16_t* Zp = (const bf16_t*)(ws + WS_Z); const float* zn = (const float*)(ws + DB_Z);
      dbg_cmp(ws, 7, NB, 256, [=](int t, int c, float& a, float& b) { a = bf_at(Zp, (size_t)t * 256 + c); b = zn[(size_t)t * 256 + c]; }); })
    }
    for (int rp_ = 0; rp_ < (REP_PH == 6 ? 2 : 1); ++rp_) {
    { Gemm g{(const bf16_t*)(ws + WS_Z), (const bf16_t*)(ws + WS_WGLU), 256, 256, 256, 0, 0}; S.init(T, 256, 1, 0);
      EpiGlu e{(const bf16_t*)(ws + WS_Z), p.in[15], (bf16_t*)(ws + WS_S5)}; gemm_phase(lds, g, S, e); }
    xcd_barrier(bar); TSTAMP(6);
    DBGC({ const bf16_t* Sp = (const bf16_t*)(ws + WS_S5); const float* sn = (const float*)(ws + DB_S5);
      dbg_cmp(ws, 8, NB, 256, [=](int t, int c, float& a, float& b) { a = bf_at(Sp, (size_t)t * 256 + c); b = sn[(size_t)t * 256 + c]; }); })
    }
    for (int rp_ = 0; rp_ < (REP_PH == 7 ? 2 : 1); ++rp_) {
    { Gemm g{(const bf16_t*)(ws + WS_S5), (const bf16_t*)(ws + WS_WB), 256, 256, 256, 0, 0}; S.init(T, 1024, 1, 0);
      EpiMerge e{ws + WS_G, (const bf16_t*)(ws + WS_P), (bf16_t*)(ws + WS_MG)}; gemm_phase(lds, g, S, e); }
    xcd_barrier(bar); TSTAMP(7);
    DBGC({ const bf16_t* Mp = (const bf16_t*)(ws + WS_MG); const float* mn = (const float*)(ws + DB_MG);
      dbg_cmp(ws, 9, NB, 1024, [=](int t, int c, float& a, float& b) { a = bf_at(Mp, (size_t)t * 1024 + c); b = mn[(size_t)t * 1024 + c]; }); })
    }
    for (int rp_ = 0; rp_ < (REP_PH == 8 ? 2 : 1); ++rp_) {
    { Gemm g{(const bf16_t*)(ws + WS_MG), (const bf16_t*)(ws + WS_WOUT), 1024, 1024, 1024, 0, 0}; S.init(T, 1024, 1, 0);
      EpiX1 e{(const float*)(ws + WS_RINV), (bf16_t*)(ws + WS_X1B), (float*)(ws + WS_RS2P)}; gemm_phase(lds, g, S, e); }
    xcd_barrier(bar); TSTAMP(8);
    DBGC({ const bf16_t* Xp = (const bf16_t*)(ws + WS_X1B); const float* xn1 = (const float*)(ws + DB_X1);
      dbg_cmp(ws, 10, NB, 1024, [=](int t, int c, float& a, float& b) { a = bf_at(Xp, (size_t)t * 1024 + c); b = xn1[(size_t)t * 1024 + c]; }); })
    }
    }
    for (int hh = 0; hh < REP_I; ++hh) {
        { Gemm g{(const bf16_t*)(ws + WS_X1B), (const bf16_t*)(ws + WS_WS), 1024, 1024, 1024, 0, 0}; S.init(T, 2048, 1, 0);
          EpiSC e{(unsigned short*)(ws + WS_SC)}; gemm_phase(lds, g, S, e); }
        xcd_barrier(bar); TSTAMP(9);
    }
    DBGC({ const float* SCp = (const float*)(ws + WS_SC); const float* qn = (const float*)(ws + DB_Q); const float* RSp = (const float*)(ws + WS_RS2P); const float* kk1 = p.in[21]; const float* kk2 = p.in[22];
          dbg_cmp(ws, 11, NB, 2048, [=](int t, int c, float& a, float& b) { float ss = 0.f; for (int i = 0; i < 16; ++i) ss += RSp[(size_t)t * 16 + i];
            a = SCp[(size_t)t * 2048 + c] * rsqrtf(ss * (1.0f / D) + RMS_EPS); const int hs = c >> 7, j = c & 127; const float* kp = ((hs & 1) ? kk2 : kk1) + j * 128; const float* qq = qn + (size_t)t * 2048 + hs * 128;
            float sr = 0.f; for (int k = 0; k < 128; ++k) sr += qq[k] * kp[k]; b = sr; }); })
    for (int rep = 0; rep < REP_J; ++rep) { for (int rtk = 0; rtk < REP_TK; ++rtk) phase_topk(p, lds); asm volatile("s_waitcnt vmcnt(0) lgkmcnt(0)" ::: "memory"); __syncthreads();     phase_expert(p, lds); __syncthreads(); }
#if TIMING
    xcd_barrier(bar); TSTAMP(13);
    xcd_barrier(bar);
    { const unsigned long long* ts = (const unsigned long long*)(p.ws + WS_RSTD1 - 1024);
      const float ua = (float)(ts[TIME_A] - ts[TIME_A - 1]) * 0.01f, ub = (float)(ts[TIME_B] - ts[TIME_B - 1]) * 0.01f;
      const float c = sqrtf(ua);
      for (size_t i = (size_t)blockIdx.x * NTHR + threadIdx.x; i < (size_t)T * D; i += (size_t)NBLK * NTHR) p.out[i] = (i == 0) ? ub : c; }
#endif
    DBGC(xcd_barrier(bar); { const float* On = (const float*)(ws + DB_OUT); const float* Op = p.out;
      { const int* Ep = (const int*)(ws + WS_EIDX); const int* En = (const int*)(ws + DB_EIDX); const float* Gp2 = (const float*)(ws + WS_GATE); const float* Gn = (const float*)(ws + DB_GATE);
          dbg_cmp(ws, 12, NB, 128, [=](int t, int c, float& a, float& b) { const int e = Ep[(size_t)t * 128 + c]; const int* nn = En + (size_t)t * 128 + (c & ~15); int f = 0; for (int k = 0; k < 16; ++k) f |= (nn[k] == e); a = f ? 1.f : 0.f; b = 1.f; });
          dbg_cmp(ws, 13, NB, 128, [=](int t, int c, float& a, float& b) { const int e = Ep[(size_t)t * 128 + c]; const int* nn = En + (size_t)t * 128 + (c & ~15); a = Gp2[(size_t)t * 128 + c]; b = a; for (int k = 0; k < 16; ++k) if (nn[k] == e) b = Gn[(size_t)t * 128 + (c & ~15) + k]; }); }
      dbg_cmp(ws, 14, NB, 1024, [=](int t, int c, float& a, float& b) { a = Op[(size_t)t * 1024 + c]; b = On[(size_t)t * 1024 + c]; }); })
}
}

extern "C" void kernel_launch(void* const* d_in, const int* in_sizes, int n_in, void* d_out, int out_size, void* d_ws, size_t ws_size, hipStream_t stream) {
    static int ready = 0;
    if (ready == 0) {
        if (n_in != 26 || out_size != 32768 * D || ws_size < WS_END) { fprintf(stderr, "kernel_launch: unexpected shapes (n_in %d out %d ws %zu need %zu)\n", n_in, out_size, ws_size, (size_t)WS_END); ready = -1; return; }
        if (hipFuncSetAttribute((const void*)fwd_megakernel, hipFuncAttributeMaxDynamicSharedMemorySize, LDS_BYTES) != hipSuccess) { fprintf(stderr, "kernel_launch: hipFuncSetAttribute failed\n"); ready = -1; return; }
        ready = 1;
    }
    if (ready < 0) return;
    (void)hipMemsetAsync((char*)d_ws + WS_CTL, 0, 65536, stream);
#if DBG
    {
        char* wsb = (char*)d_ws; const int S = NB;
        const float* x = (const float*)d_in[0];
        float* cst = (float*)(wsb + DB_CST); float* hn = (float*)(wsb + DB_HN); float* proj = (float*)(wsb + DB_PROJ); float* am = (float*)(wsb + DB_AM); float* ya = (float*)(wsb + DB_YA);
        float* xr = (float*)(wsb + DB_XR); float* xi = (float*)(wsb + DB_XI); float* z = (float*)(wsb + DB_Z); float* lin = (float*)(wsb + DB_LIN); float* s5 = (float*)(wsb + DB_S5);
        float* yb = (float*)(wsb + DB_YB); float* merged = (float*)(wsb + DB_MG); float* x1 = (float*)(wsb + DB_X1); float* xn = (float*)(wsb + DB_XN); float* q = (float*)(wsb + DB_Q);
        int* eidx = (int*)(wsb + DB_EIDX); float* gate = (float*)(wsb + DB_GATE); float* outn = (float*)(wsb + DB_OUT);
        auto F = [&](int i) { return (const float*)d_in[i]; };
        auto gemm = [&](const float* A, int lda, const float* B, int ldb, float* C, int ldc, int M, int N, int K) { ngemm<<<dim3(N / 64, M / 64), 256, 0, stream>>>(A, lda, B, ldb, C, ldc, M, N, K); };
        (void)hipMemsetAsync(wsb + DB_ACC, 0, 4096, stream);
        n_ssm_const<<<4, 256, 0, stream>>>(F(6), F(7), F(8), cst);
        n_rmsnorm<<<S, 256, 0, stream>>>(x, F(1), hn);
        gemm(hn, D, F(2), IN_COLS, proj, IN_COLS, S, IN_COLS, D);
        n_conv<<<(S * CONV_CH) / 256, 256, 0, stream>>>(proj, F(4), F(5), am, S);
        gemm(am, CONV_CH, F(16), D, ya, D, S, D, CONV_CH);
        n_ssm_x<<<(S * 1024) / 256, 256, 0, stream>>>(proj, F(9), F(10), cst, xr, xi, S);
        n_ssm_scan<<<4, 256, 0, stream>>>(cst, xr, xi, S);
        n_ssm_y<<<(S * 256) / 256, 256, 0, stream>>>(proj, xr, xi, F(11), F(12), F(13), z, S);
        gemm(z, 256, F(14), 256, lin, 256, S, 256, 256);
        n_glu<<<(S * 256) / 256, 256, 0, stream>>>(z, lin, F(15), s5, (size_t)S * 256);
        gemm(s5, 256, F(17), D, yb, D, S, D, 256);
        n_merge<<<(S * D) / 256, 256, 0, stream>>>(proj, F(3), ya, yb, merged, (size_t)S * D);
        gemm(merged, D, F(18), D, x1, D, S, D, D);
        n_add<<<(S * D) / 256, 256, 0, stream>>>(x, x1, (size_t)S * D);
        n_rmsnorm<<<S, 256, 0, stream>>>(x1, F(19), xn);
        gemm(xn, D, F(20), PEER_QD, q, PEER_QD, S, PEER_QD, D);
        n_route<<<S, 256, 0, stream>>>(q, F(21), F(22), eidx, gate);
        n_expert<<<S / 4, 256, 0, stream>>>(xn, x1, eidx, gate, F(23), F(24), F(25), outn);
    }
#endif
    Params p{};
    for (int i = 0; i < 26; ++i) p.in[i] = (const float*)d_in[i];
    p.out = (float*)d_out; p.ws = (unsigned char*)d_ws;
    hipLaunchKernelGGL(fwd_megakernel, dim3(NBLK), dim3(NTHR), LDS_BYTES, stream, p);
#if DBG
    dbg_report<<<1024, 256, 0, stream>>>((const float*)((char*)d_ws + DB_ACC), (float*)d_out, out_size, DBG_FIRST);
#endif
}
```

```cpp
#include <hip/hip_runtime.h>
#include <cstdint>
#include <cstddef>
#include <cstdio>

#define LAS __attribute__((address_space(3)))
#ifndef DBG
#define DBG 0
#endif
#ifndef TIMING
#define TIMING 0
#endif
#ifndef REP_J
#define REP_J 1
#endif
#ifndef REP_AH
#define REP_AH 1
#endif
#ifndef REP_I
#define REP_I 1
#endif
#ifndef REP_PH
#define REP_PH 0
#endif
#ifndef NULLG1
#define NULLG1 0
#endif
#ifndef SKIPA
#define SKIPA 0
#endif
#ifndef REP_TK
#define REP_TK 1
#endif
#ifndef TIME_A
#define TIME_A 13
#endif
#ifndef TIME_B
#define TIME_B 2
#endif
#ifndef DBG_THR
#define DBG_THR 0.03f
#endif
#ifndef DBG_FIRST
#define DBG_FIRST 1
#endif
#if TIMING
#define TSTAMP(k) do { if (blockIdx.x == 0 && threadIdx.x == 0) ((unsigned long long*)(p.ws + WS_RSTD1 - 1024))[k] = __builtin_amdgcn_s_memrealtime(); } while (0)
#else
#define TSTAMP(k)
#endif
#if DBG
#define DBGC(...) __VA_ARGS__
#else
#define DBGC(...)
#endif
namespace {
typedef unsigned short bf16_t;
typedef short bf16x8 __attribute__((ext_vector_type(8)));
typedef float f32x4 __attribute__((ext_vector_type(4)));
typedef unsigned u32x4 __attribute__((ext_vector_type(4)));
typedef unsigned u32x2 __attribute__((ext_vector_type(2)));
typedef float f32x2 __attribute__((ext_vector_type(2)));
typedef _Float16 h2 __attribute__((ext_vector_type(2)));

constexpr int D = 1024, T = DBG ? 16384 : 32768, SEQ = 8192;
constexpr int CONV_CH = 768, IN_COLS = 4608;
constexpr float RMS_EPS = 1e-6f;
constexpr int NBLK = 256, NTHR = 512, NWAVE = 8, NGW = NBLK * NWAVE;
constexpr int CL = 32, LOGCL = 5, CK = CL * 16;
constexpr int SUK = CK + 128;
constexpr int NCHUNK = T / CL, CPS = SEQ / CL;

constexpr size_t MB = 1024 * 1024;
constexpr size_t WS_CTL = 0;
constexpr size_t WS_RSTD1 = WS_CTL + 65536;
constexpr size_t WS_RS2P = WS_RSTD1 + (size_t)T * 4;
constexpr size_t WS_WIN = WS_RS2P + (size_t)T * 64;
constexpr size_t WS_WA = WS_WIN + (size_t)4608 * 1024 * 2;
constexpr size_t WS_WB = WS_WA + (size_t)1024 * 768 * 2;
constexpr size_t WS_WOUT = WS_WB + (size_t)1024 * 256 * 2;
constexpr size_t WS_WGLU = WS_WOUT + (size_t)1024 * 1024 * 2;
constexpr size_t WS_WS = WS_WGLU + (size_t)256 * 256 * 2;
constexpr size_t WS_UH = WS_WS + (size_t)2048 * 1024 * 2;
constexpr size_t WS_USC = WS_UH + (size_t)16384 * 1024;
constexpr size_t WS_VH = WS_USC + (size_t)16384 * 4;
constexpr size_t WS_VSC = WS_VH + (size_t)16384 * 1024;
constexpr size_t WS_RINV = WS_VSC + (size_t)16384 * 4;
constexpr size_t WS_POW = WS_RINV + (size_t)T * 4;
constexpr size_t WS_BBAR = WS_POW + (size_t)16 * 65 * 64 * 2 * 4;
constexpr size_t WS_KC = WS_BBAR + (size_t)16 * 64 * 16 * 2 * 4;
constexpr size_t WS_E = WS_KC + (size_t)16 * 64 * 256 * 4;
constexpr size_t WS_MEND = WS_E + (size_t)16 * NCHUNK * 128 * 4;
constexpr size_t WS_MY = WS_MEND + (size_t)16 * 256 * CK * 2;
constexpr size_t WS_EIDX = WS_MY + (size_t)16 * CK * SUK * 2;
constexpr size_t WS_GATE = WS_EIDX + (size_t)T * 128 * 4;
constexpr size_t WS_XB = WS_GATE + (size_t)T * 128 * 4;
constexpr size_t WS_G = WS_XB + (size_t)T * 1024 * 2;
constexpr size_t WS_CB = WS_G + (size_t)T * 2048 * 2;
constexpr size_t WS_V = WS_CB + (size_t)T * 768 * 2;
constexpr size_t WS_SU = WS_V + (size_t)T * 768 * 2;
constexpr size_t WS_A2 = WS_SU + (size_t)16 * NCHUNK * SUK * 2;
constexpr size_t WS_END = WS_A2 + (size_t)T * 768 * 2;
constexpr size_t WS_XQ = WS_A2 + (size_t)T * 512;
constexpr size_t WS_P = WS_CB, WS_X1B = WS_XB, WS_X1 = WS_G, WS_MG = WS_CB, WS_SC = WS_CB, WS_Z = WS_V + (size_t)T * 256 * 2, WS_S5 = WS_V + (size_t)T * 512 * 2;
static_assert(WS_GATE + (size_t)T * 128 * 4 <= WS_XB, "EIDX/GATE placement");
static_assert(WS_SC + (size_t)T * 2048 * 2 <= WS_XQ && WS_XQ + (size_t)T * 1024 <= WS_END, "SC / XQ overlay");
static_assert(WS_END <= (size_t)512 * MB, "workspace");
static_assert(WS_MG + (size_t)T * 1024 * 2 <= WS_Z && WS_S5 + (size_t)T * 256 * 2 <= WS_SU, "Z/S5 placement");
#if DBG
constexpr int NB = 2048;
constexpr size_t DB_BASE = (WS_END + 4095) & ~(size_t)4095;
constexpr size_t DB_ACC = DB_BASE;
constexpr size_t DB_CST = DB_ACC + 4096;
constexpr size_t DB_HN = DB_CST + 16384;
constexpr size_t DB_PROJ = DB_HN + (size_t)NB * D * 4;
constexpr size_t DB_AM = DB_PROJ + (size_t)NB * IN_COLS * 4;
constexpr size_t DB_YA = DB_AM + (size_t)NB * CONV_CH * 4;
constexpr size_t DB_XR = DB_YA + (size_t)NB * D * 4;
constexpr size_t DB_XI = DB_XR + (size_t)NB * D * 4;
constexpr size_t DB_Z = DB_XI + (size_t)NB * D * 4;
constexpr size_t DB_LIN = DB_Z + (size_t)NB * 256 * 4;
constexpr size_t DB_S5 = DB_LIN + (size_t)NB * 256 * 4;
constexpr size_t DB_YB = DB_S5 + (size_t)NB * 256 * 4;
constexpr size_t DB_MG = DB_YB + (size_t)NB * D * 4;
constexpr size_t DB_X1 = DB_MG + (size_t)NB * D * 4;
constexpr size_t DB_XN = DB_X1 + (size_t)NB * D * 4;
constexpr size_t DB_Q = DB_XN + (size_t)NB * D * 4;
constexpr size_t DB_EIDX = DB_Q + (size_t)NB * 2048 * 4;
constexpr size_t DB_GATE = DB_EIDX + (size_t)NB * 128 * 4;
constexpr size_t DB_OUT = DB_GATE + (size_t)NB * 128 * 4;
constexpr size_t DB_H = DB_OUT + (size_t)NB * D * 4;
constexpr size_t DB_END = DB_H + (size_t)NB * 128 * 4;
static_assert(DB_END <= (size_t)512 * MB, "debug workspace");
constexpr size_t DBH_OFF = DB_H;
#endif

constexpr int LDS_STAGE = 131072, LDS_MISC = LDS_STAGE, LDS_GBIAS = LDS_STAGE + 4096, LDS_BYTES = LDS_GBIAS + 8192;

struct Params { const float* in[26]; float* out; unsigned char* ws; };

__device__ __forceinline__ unsigned pk2bf(float lo, float hi) { unsigned r; asm volatile("v_cvt_pk_bf16_f32 %0, %1, %2" : "=v"(r) : "v"(lo), "v"(hi)); return r; }
__device__ __forceinline__ int dot4z(unsigned a, int b) { int r; asm("v_dot4_i32_i8 %0, %1, %2, 0" : "=v"(r) : "v"(a), "v"(b)); return r; }
__device__ __forceinline__ h2 as_h2(unsigned v) { return __builtin_bit_cast(h2, v); }
__device__ __forceinline__ unsigned pk2h(float lo, float hi) { unsigned r; asm("v_cvt_pkrtz_f16_f32 %0, %1, %2" : "=v"(r) : "v"(lo), "v"(hi)); return r; }
__device__ __forceinline__ float bflo(unsigned d) { return __uint_as_float(d << 16); }
__device__ __forceinline__ float bfhi(unsigned d) { return __uint_as_float(d & 0xffff0000u); }
__device__ __forceinline__ float gelu_exact(float v) { return 0.5f * v * (1.0f + erff(v * 0.70710678118654752f)); }
__device__ __forceinline__ float ub0(unsigned w) { return (float)(w & 0xffu); }
__device__ __forceinline__ float ub1(unsigned w) { return (float)((w >> 8) & 0xffu); }
__device__ __forceinline__ float ub2(unsigned w) { return (float)((w >> 16) & 0xffu); }
__device__ __forceinline__ float ub3(unsigned w) { return (float)(w >> 24); }
__device__ __forceinline__ float sigm(float v) { return __builtin_amdgcn_rcpf(1.0f + __builtin_amdgcn_exp2f(v * -1.44269504089f)); }
__device__ __forceinline__ float sigm255(float v) { return __builtin_amdgcn_rcpf(fmaf(__builtin_amdgcn_exp2f(v * -1.44269504089f), 1.0f / 255.0f, 1.0f / 255.0f)); }
__device__ __forceinline__ u32x4 pack8(const f32x4 a, const f32x4 b) { u32x4 w; w.x = pk2bf(a[0], a[1]); w.y = pk2bf(a[2], a[3]); w.z = pk2bf(b[0], b[1]); w.w = pk2bf(b[2], b[3]); return w; }
__device__ __forceinline__ float wave_sum(float v) {
#pragma unroll
    for (int o = 1; o < 64; o <<= 1) v += __shfl_xor(v, o);
    return v;
}

#define XB_TMO      128
#define XB_XCNT(j)  (256  + 64 * (j))
#define XB_XSUB(j)  (1280 + 64 * (j))
#define XB_XGEN(j)  (2304 + 64 * (j))
#define XB_TOP      3328
#define XB_TOPGEN   3392
#define XCD_BAR_WORDS 3456
#define XB_SPIN_CAP (1u << 22)
__device__ __forceinline__ unsigned xb_ld(unsigned* p)              { return __hip_atomic_load(p, __ATOMIC_RELAXED, __HIP_MEMORY_SCOPE_AGENT); }
__device__ __forceinline__ unsigned xb_add(unsigned* p, unsigned v) { return __hip_atomic_fetch_add(p, v, __ATOMIC_RELAXED, __HIP_MEMORY_SCOPE_AGENT); }
__device__ __forceinline__ unsigned xb_xcc_id() { return (unsigned)__builtin_amdgcn_s_getreg((3 << 11) | 20) & 0xFu; }
#define XB_SPIN(cond, bar) do { unsigned _sp = 0; while (cond) { __builtin_amdgcn_s_sleep(1); \
    if ((++_sp & 255u) == 0u) { if (xb_ld(&(bar)[XB_TMO])) break; if (_sp > XB_SPIN_CAP) { atomicAdd(&(bar)[XB_TMO], 1u); break; } } } } while (0)
struct XcdBarrier { unsigned* bar; unsigned x; volatile LAS unsigned* st; };
__device__ __forceinline__ XcdBarrier xcd_barrier_post(unsigned* bar, volatile LAS unsigned* st) {
    XcdBarrier b; b.bar = bar; b.x = xb_xcc_id(); b.st = st;
    if (threadIdx.x == 0) (void)xb_add(&bar[XB_XCNT(b.x)], 1u);
    return b;
}
__device__ __forceinline__ void xcd_barrier_complete(unsigned* bar, unsigned x, unsigned& nloc, unsigned& nx) {
    const unsigned G = gridDim.x * gridDim.y * gridDim.z;
    unsigned sum, cnt, mine, sp = 0u;
    for (;;) {
        sum = 0u; cnt = 0u; mine = 0u;
#pragma unroll
        for (unsigned j = 0; j < 16; ++j) { const unsigned c = xb_ld(&bar[XB_XCNT(j)]); sum += c; cnt += (c > 0u) ? 1u : 0u; mine = (j == x) ? c : mine; }
        if (sum == G) break;
        __builtin_amdgcn_s_sleep(1);
        if ((++sp & 255u) == 0u) { if (xb_ld(&bar[XB_TMO])) break; if (sp > XB_SPIN_CAP) { atomicAdd(&bar[XB_TMO], 1u); break; } }
    }
    nloc = mine > 0u ? mine : 1u; nx = cnt > 0u ? cnt : 1u;
}
__device__ __forceinline__ void xcd_barrier(const XcdBarrier& b) {
    asm volatile("s_waitcnt vmcnt(0)" ::: "memory");
    __syncthreads();
    if (threadIdx.x == 0) {
        unsigned* bar = b.bar;
        __builtin_amdgcn_s_waitcnt(0);
        unsigned nloc = b.st[0], nx = b.st[1];
        if (nloc == 0u) { xcd_barrier_complete(bar, b.x, nloc, nx); b.st[0] = nloc; b.st[1] = nx; }
        const unsigned old = xb_add(&bar[XB_XSUB(b.x)], 1u);
        const unsigned gen = old / nloc;
        if (old + 1u == (gen + 1u) * nloc) {
            __builtin_amdgcn_fence(__ATOMIC_RELEASE, "agent");
            asm volatile("s_waitcnt vmcnt(0)" ::: "memory");
            const unsigned og = xb_add(&bar[XB_TOP], 1u);
            const unsigned tg = og / nx;
            if (og + 1u == (tg + 1u) * nx) xb_add(&bar[XB_TOPGEN], 1u);
            else XB_SPIN(xb_ld(&bar[XB_TOPGEN]) == tg, bar);
            __builtin_amdgcn_fence(__ATOMIC_ACQUIRE, "agent");
            xb_add(&bar[XB_XGEN(b.x)], 1u);
            asm volatile("s_waitcnt vmcnt(0)" ::: "memory");
        } else {
            XB_SPIN(xb_ld(&bar[XB_XGEN(b.x)]) == gen, bar);
            __builtin_amdgcn_fence(__ATOMIC_ACQUIRE, "agent");
            asm volatile("s_waitcnt vmcnt(0)" ::: "memory");
        }
    }
    __syncthreads();
}

constexpr int BM = 256, BK = 64, HALF = 128, HTB = HALF * BK * 2, NXCD = 8, WGM = 8;
__device__ __forceinline__ int lds_byte(int r, int c) { const int st = (r >> 4) * 2 + (c >> 5), rr = r & 15, cc = c & 31, ob = rr * 64 + cc * 2; return st * 1024 + (ob ^ (((ob >> 9) & 1) << 5)); }
__device__ __forceinline__ void stage_rc(int b, int& R, int& C) { const int st = b / 1024, sb = b % 1024, swz = sb ^ (((sb >> 9) & 1) << 5); R = (st >> 1) * 16 + swz / 64; C = (st & 1) * 32 + (swz % 64) / 2; }
__device__ __forceinline__ int perm32(int rho) { const int n = rho >> 4, i = rho & 15; return 8 * (i >> 2) + 4 * n + (i & 3); }

struct Unit { int pm, pn, z; };
struct Gemm { const bf16_t* A; const bf16_t* Bt; int lda, ldb, K; long sAz, sBz; };
struct Order {
    int nM, nN, nZ, G, c, pm_off; long u0, u1; int b0;
    __device__ void init(int M, int N, int Z, int pmo) { nM = M / BM; nN = N / BM; nZ = Z; G = gridDim.x; c = blockIdx.x; pm_off = pmo; u0 = 0; u1 = (long)nM * nN * nZ; b0 = 0; }
    __device__ void window(long first_unit, long end_unit, int first_block, int nblocks) { u0 = first_unit; u1 = end_unit; b0 = first_block; G = nblocks; }
    __device__ bool next(int i, Unit& u) const {
        if (c < b0 || c >= b0 + G) return false;
        const long L = u0 + (long)i * G + (c - b0); const int nwg = nM * nN;
        if (L >= u1) return false;
        if (nZ == 1) {
            int wgid = (int)L; { const int q = nwg / NXCD, r = nwg % NXCD, xcd = wgid % NXCD, off = wgid / NXCD; wgid = (xcd < r ? xcd * (q + 1) : r * (q + 1) + (xcd - r) * q) + off; }
            const int nig = WGM * nN, gid = wgid / nig, fm = gid * WGM, gsz = (nM - fm) < WGM ? (nM - fm) : WGM;
            u.pm = pm_off + fm + ((wgid % nig) % gsz); u.pn = (wgid % nig) / gsz; u.z = 0;
        } else { u.z = (int)(L / nwg); const int r = (int)(L % nwg); u.pm = r % nM; u.pn = r / nM; }
        return true;
    }
};

template <class Epi>
__device__ __forceinline__ void gemm_phase(LAS unsigned char* lds, const Gemm g, const Order& S, const Epi& E) {
    int tid = threadIdx.x; asm volatile("" : "+v"(tid));
    const int wid = __builtin_amdgcn_readfirstlane(tid >> 6), lane = tid & 63, wr = wid >> 2, wc = wid & 3, fr = lane & 15, fq = lane >> 4;
    const int K = g.K, nt = K / BK;
    unsigned voffA[2], voffB[2];
#pragma unroll
    for (int i = 0; i < 2; ++i) { int R, C; stage_rc(tid * 16 + i * 8192, R, C); const int Rb = Epi::PERM ? ((R & ~31) + perm32(R & 31)) : R;
        voffA[i] = (unsigned)(R * g.lda + C) * 2u; voffB[i] = (unsigned)(Rb * g.ldb + C) * 2u; }
    const size_t kstep = (size_t)(BK * 2);
    const size_t hstepA = (size_t)HALF * g.lda * 2, hstepB = (size_t)HALF * g.ldb * 2;
    const unsigned ldsw = (unsigned)wid * 1024u;
    const int aoff = lds_byte(wr * 64 + fr, fq * 8), boff = lds_byte(wc * 32 + fr, fq * 8);
#define PG8_SA(b, h) (((b) * 2 + (h)) * HTB)
#define PG8_SB(b, h) ((4 + (b) * 2 + (h)) * HTB)
#define PG8_STAGE(bufoff, gbase, voff) do { _Pragma("unroll") for (int _i = 0; _i < 2; ++_i) \
        __builtin_amdgcn_global_load_lds((const unsigned*)((const char*)(gbase) + (voff)[_i]), (LAS unsigned*)(lds + (bufoff) + ldsw + _i * 8192), 16, 0, 0); } while (0)
#define PG8_LDA(dst, b, h) do { _Pragma("unroll") for (int m = 0; m < 4; ++m) _Pragma("unroll") for (int k = 0; k < 2; ++k) dst[m][k] = *(const LAS bf16x8*)(lds + PG8_SA(b, h) + aoff + m * 2048 + k * 1024); } while (0)
#define PG8_LDB(dst, b, h) do { _Pragma("unroll") for (int n = 0; n < 2; ++n) _Pragma("unroll") for (int k = 0; k < 2; ++k) dst[n][k] = *(const LAS bf16x8*)(lds + PG8_SB(b, h) + boff + n * 2048 + k * 1024); } while (0)
#define PG8_MMA(ai, bj, At, Bt) do { __builtin_amdgcn_s_setprio(1); _Pragma("unroll") for (int m = 0; m < 4; ++m) _Pragma("unroll") for (int n = 0; n < 2; ++n) _Pragma("unroll") for (int k = 0; k < 2; ++k) \
        acc[ai][bj][m][n] = __builtin_amdgcn_mfma_f32_16x16x32_bf16(Bt[n][k], At[m][k], acc[ai][bj][m][n], 0, 0, 0); __builtin_amdgcn_s_setprio(0); } while (0)
#define PG8_WAIT_V(n) asm volatile("s_waitcnt vmcnt(" #n ")" ::: "memory")
#define PG8_WAIT_L(n) asm volatile("s_waitcnt lgkmcnt(" #n ")" ::: "memory")
#define PG8_BAR __builtin_amdgcn_s_barrier()
#define PG8_SCHED __builtin_amdgcn_sched_barrier(0)
    Unit cur, nxt; int ui = 0;
    if (!S.next(0, cur)) return;
    f32x4 acc[2][2][4][2];
#pragma unroll
    for (int a = 0; a < 2; ++a)
#pragma unroll
        for (int b = 0; b < 2; ++b)
#pragma unroll
            for (int m = 0; m < 4; ++m)
#pragma unroll
                for (int n = 0; n < 2; ++n) acc[a][b][m][n] = (f32x4){0.f, 0.f, 0.f, 0.f};
    bf16x8 At[4][2], B0[2][2], B1[2][2];
    const char* cA = (const char*)g.A + ((size_t)cur.z * g.sAz) * 2 + (size_t)cur.pm * 2 * hstepA;
    const char* cB = (const char*)g.Bt + ((size_t)cur.z * g.sBz) * 2 + (size_t)cur.pn * 2 * hstepB;
    PG8_STAGE(PG8_SB(0, 0), cB, voffB); PG8_STAGE(PG8_SB(0, 1), cB + hstepB, voffB); PG8_STAGE(PG8_SA(0, 0), cA, voffA); PG8_STAGE(PG8_SA(0, 1), cA + hstepA, voffA);
    if (wr == 1) PG8_BAR;
    PG8_WAIT_V(2); PG8_BAR;
    PG8_STAGE(PG8_SB(1, 0), cB + kstep, voffB); PG8_STAGE(PG8_SA(1, 0), cA + kstep, voffA); PG8_STAGE(PG8_SB(1, 1), cB + hstepB + kstep, voffB);
    PG8_WAIT_V(6); PG8_BAR;
    for (;;) {
        const bool has_next = S.next(ui + 1, nxt);
        const char* nA = has_next ? (const char*)g.A + ((size_t)nxt.z * g.sAz) * 2 + (size_t)nxt.pm * 2 * hstepA : cA;
        const char* nB = has_next ? (const char*)g.Bt + ((size_t)nxt.z * g.sBz) * 2 + (size_t)nxt.pn * 2 * hstepB : cB;
#pragma unroll 1
        for (int t = 0; t < nt; t += 2) {
            const bool last = (t == nt - 2);
            const char* a1 = cA + (size_t)(t + 1) * kstep;
            const char* a2 = last ? nA : cA + (size_t)(t + 2) * kstep; const char* b2 = last ? nB : cB + (size_t)(t + 2) * kstep;
            const char* a3 = a2 + kstep; const char* b3 = b2 + kstep;
            PG8_LDB(B0, 0, 0); PG8_LDB(B1, 0, 1); PG8_SCHED; PG8_LDA(At, 0, 0); PG8_STAGE(PG8_SA(1, 1), a1 + hstepA, voffA);
            PG8_WAIT_V(8); PG8_WAIT_L(0); PG8_BAR; PG8_MMA(0, 0, At, B0); PG8_MMA(0, 1, At, B1); PG8_BAR; PG8_SCHED;
            PG8_LDA(At, 0, 1); PG8_STAGE(PG8_SB(0, 0), b2, voffB); PG8_STAGE(PG8_SB(0, 1), b2 + hstepB, voffB); PG8_STAGE(PG8_SA(0, 0), a2, voffA);
            PG8_WAIT_V(8); PG8_WAIT_L(0); PG8_BAR; PG8_MMA(1, 0, At, B0); PG8_MMA(1, 1, At, B1); PG8_BAR; PG8_SCHED;
            PG8_LDB(B0, 1, 0); PG8_LDB(B1, 1, 1); PG8_SCHED; PG8_LDA(At, 1, 0); PG8_STAGE(PG8_SA(0, 1), a2 + hstepA, voffA);
            PG8_WAIT_V(8); PG8_WAIT_L(0); PG8_BAR; PG8_MMA(0, 0, At, B0); PG8_MMA(0, 1, At, B1); PG8_BAR; PG8_SCHED;
            PG8_LDA(At, 1, 1); PG8_STAGE(PG8_SB(1, 0), b3, voffB); PG8_STAGE(PG8_SB(1, 1), b3 + hstepB, voffB); PG8_STAGE(PG8_SA(1, 0), a3, voffA);
            PG8_WAIT_V(8); PG8_WAIT_L(0); PG8_BAR; PG8_MMA(1, 0, At, B0); PG8_MMA(1, 1, At, B1); PG8_BAR; PG8_SCHED;
        }
        if (wr == 0) PG8_BAR;
        { int fr_e = fr, fq_e = fq; asm volatile("" : "+v"(fr_e), "+v"(fq_e));
          E(acc, cur, wr, wc, fr_e, fq_e); }
        if (!has_next) break;
#pragma unroll
        for (int a = 0; a < 2; ++a)
#pragma unroll
            for (int b = 0; b < 2; ++b)
#pragma unroll
                for (int m = 0; m < 4; ++m)
#pragma unroll
                    for (int n = 0; n < 2; ++n) acc[a][b][m][n] = (f32x4){0.f, 0.f, 0.f, 0.f};
        cur = nxt; cA = nA; cB = nB; ++ui;
        if (wr == 1) PG8_BAR;
    }
    PG8_WAIT_V(0);
    PG8_BAR;
#undef PG8_SA
#undef PG8_SB
#undef PG8_STAGE
#undef PG8_LDA
#undef PG8_LDB
#undef PG8_MMA
#undef PG8_WAIT_V
#undef PG8_WAIT_L
#undef PG8_BAR
#undef PG8_SCHED
}

__device__ __forceinline__ u32x4 xpose16(const u32x4 v, int src_addr) {
    u32x4 r; r.x = (unsigned)__builtin_amdgcn_ds_bpermute(src_addr, (int)v.x); r.y = (unsigned)__builtin_amdgcn_ds_bpermute(src_addr, (int)v.y);
    r.z = (unsigned)__builtin_amdgcn_ds_bpermute(src_addr, (int)v.z); r.w = (unsigned)__builtin_amdgcn_ds_bpermute(src_addr, (int)v.w); return r;
}
typedef const f32x4 (&AccRef)[2][2][4][2];
template <bool NOST> struct EpiG1T {
    static constexpr bool PERM = true;
    const LAS float* bgate; bf16_t *CB, *V, *SU; unsigned char* G8;
    __device__ __forceinline__ void operator()(AccRef acc, const Unit& u, int wr, int wc, int fr, int fq) const {
        const int pn = u.pn, c0 = wc * 32 + 8 * fq;
        const int lane = fq * 16 + fr, sa = ((lane & 3) * 16 + (lane >> 2)) * 4, tr = lane >> 2, tc0 = wc * 32 + 8 * (lane & 3);
#pragma unroll
        for (int ai = 0; ai < 2; ++ai)
#pragma unroll
            for (int m = 0; m < 4; ++m) {
                const int row = u.pm * BM + ai * HALF + wr * 64 + m * 16 + tr;
                if (pn < 3) {
#pragma unroll
                    for (int bj = 0; bj < 2; ++bj) { const u32x4 w_ = xpose16(pack8(acc[ai][bj][m][0], acc[ai][bj][m][1]), sa); if (NOST) asm volatile("" :: "v"(w_)); else *(u32x4*)(CB + (size_t)row * CONV_CH + pn * 256 + bj * HALF + tc0) = w_; }
                } else if (pn < 9) {
                    { const u32x4 w_ = xpose16(pack8(acc[ai][0][m][0] * acc[ai][1][m][0], acc[ai][0][m][1] * acc[ai][1][m][1]), sa); if (NOST) asm volatile("" :: "v"(w_)); else *(u32x4*)(V + (size_t)row * CONV_CH + (pn - 3) * HALF + tc0) = w_; }
                } else if (pn == 9) {
#pragma unroll
                    for (int bj = 0; bj < 2; ++bj) { const int c = bj * HALF + tc0, gq = c >> 4, h0 = c & 15;
                        const u32x4 w_ = xpose16(pack8(acc[ai][bj][m][0], acc[ai][bj][m][1]), sa); if (NOST) asm volatile("" :: "v"(w_)); else *(u32x4*)(SU + ((size_t)(gq * NCHUNK + (row >> LOGCL))) * SUK + (row & (CL - 1)) * 16 + h0) = w_; }
                } else {
#pragma unroll
                    for (int bj = 0; bj < 2; ++bj) { const int col = (pn - 10) * 256 + bj * HALF + c0;
                        const f32x4 b0 = *(const LAS f32x4*)(bgate + col), b1 = *(const LAS f32x4*)(bgate + col + 4);
                        const f32x4 v0 = acc[ai][bj][m][0] + b0, v1 = acc[ai][bj][m][1] + b1; unsigned lo = 0u, hi = 0u;
#pragma unroll
                        for (int e = 0; e < 4; ++e) { lo = __builtin_amdgcn_cvt_pk_u8_f32(sigm255(v0[e]), e, lo); hi = __builtin_amdgcn_cvt_pk_u8_f32(sigm255(v1[e]), e, hi); }
                        const int rowd = u.pm * BM + ai * HALF + wr * 64 + m * 16 + fr; const u32x2 w_ = {lo, hi};
                        if (NOST) asm volatile("" :: "v"(w_)); else *(u32x2*)(G8 + (size_t)rowd * 2048 + col) = w_; }
                }
            }
    }
};
typedef EpiG1T<false> EpiG1;
struct EpiNull {
    static constexpr bool PERM = true;
    __device__ __forceinline__ void operator()(AccRef acc, const Unit& u, int wr, int wc, int fr, int fq) const {
#pragma unroll
        for (int ai = 0; ai < 2; ++ai)
#pragma unroll
            for (int bj = 0; bj < 2; ++bj)
#pragma unroll
                for (int m = 0; m < 4; ++m)
#pragma unroll
                    for (int n = 0; n < 2; ++n) asm volatile("" :: "v"(acc[ai][bj][m][n]));
    }
};
#define EPI_WAIT() asm volatile("s_waitcnt vmcnt(0)" ::: "memory")
struct EpiP {
    static constexpr bool PERM = true;
    const unsigned char* G8; bf16_t* P;
    __device__ __forceinline__ void operator()(AccRef acc, const Unit& u, int wr, int wc, int fr, int fq) const {
        const int col0 = u.pn * BM + wc * 32 + 8 * fq;
#pragma unroll
        for (int ai = 0; ai < 2; ++ai) {
            u32x2 gg[4][2];
#pragma unroll
            for (int m = 0; m < 4; ++m) { const int row = u.pm * BM + ai * HALF + wr * 64 + m * 16 + fr;
#pragma unroll
                for (int bj = 0; bj < 2; ++bj) gg[m][bj] = *(const u32x2*)(G8 + (size_t)row * 2048 + col0 + bj * HALF); }
            EPI_WAIT();
#pragma unroll
            for (int m = 0; m < 4; ++m) { const int row = u.pm * BM + ai * HALF + wr * 64 + m * 16 + fr;
#pragma unroll
                for (int bj = 0; bj < 2; ++bj) { const u32x2 g2 = gg[m][bj];
                    f32x4 v0 = acc[ai][bj][m][0], v1 = acc[ai][bj][m][1];
                    v0[0] *= ub0(g2.x); v0[1] *= ub1(g2.x); v0[2] *= ub2(g2.x); v0[3] *= ub3(g2.x); v1[0] *= ub0(g2.y); v1[1] *= ub1(g2.y); v1[2] *= ub2(g2.y); v1[3] *= ub3(g2.y);
                    *(u32x4*)(P + (size_t)row * D + col0 + bj * HALF) = pack8(v0, v1); } }
        }
    }
};
struct EpiE {
    static constexpr bool PERM = false;
    float* E;
    __device__ __forceinline__ void operator()(AccRef acc, const Unit& u, int wr, int wc, int fr, int fq) const {
#pragma unroll
        for (int ai = 0; ai < 2; ++ai)
#pragma unroll
            for (int m = 0; m < 4; ++m) { const int row = u.pm * BM + ai * HALF + wr * 64 + m * 16 + fr;
#pragma unroll
                for (int n = 0; n < 2; ++n) *(f32x4*)(E + ((size_t)u.z * NCHUNK + row) * 128 + wc * 32 + n * 16 + 4 * fq) = acc[ai][0][m][n]; }
    }
};
struct EpiY {
    static constexpr bool PERM = true;
    const bf16_t* SU; const float* dskip; bf16_t* Z;
    __device__ __forceinline__ void operator()(AccRef acc, const Unit& u, int wr, int wc, int fr, int fq) const {
        f32x4 d0[2], d1[2];
#pragma unroll
        for (int bj = 0; bj < 2; ++bj) { const int col = u.pn * BM + bj * HALF + wc * 32 + 8 * fq, h0 = col & 15; d0[bj] = *(const f32x4*)(dskip + u.z * 16 + h0); d1[bj] = *(const f32x4*)(dskip + u.z * 16 + h0 + 4); }
#pragma unroll
        for (int ai = 0; ai < 2; ++ai) {
            u32x4 uu[4][2];
#pragma unroll
            for (int m = 0; m < 4; ++m) { const int chunk = u.pm * BM + ai * HALF + wr * 64 + m * 16 + fr;
#pragma unroll
                for (int bj = 0; bj < 2; ++bj) { const int col = u.pn * BM + bj * HALF + wc * 32 + 8 * fq;
                    uu[m][bj] = *(const u32x4*)(SU + ((size_t)u.z * NCHUNK + chunk) * SUK + col); } }
            EPI_WAIT();
#pragma unroll
            for (int m = 0; m < 4; ++m) { const int chunk = u.pm * BM + ai * HALF + wr * 64 + m * 16 + fr;
#pragma unroll
                for (int bj = 0; bj < 2; ++bj) { const int col = u.pn * BM + bj * HALF + wc * 32 + 8 * fq, j = col >> 4, h0 = col & 15; const u32x4 u4 = uu[m][bj];
                    f32x4 v0 = acc[ai][bj][m][0], v1 = acc[ai][bj][m][1];
                    v0[0] += d0[bj][0] * bflo(u4.x); v0[1] += d0[bj][1] * bfhi(u4.x); v0[2] += d0[bj][2] * bflo(u4.y); v0[3] += d0[bj][3] * bfhi(u4.y);
                    v1[0] += d1[bj][0] * bflo(u4.z); v1[1] += d1[bj][1] * bfhi(u4.z); v1[2] += d1[bj][2] * bflo(u4.w); v1[3] += d1[bj][3] * bfhi(u4.w);
#pragma unroll
                    for (int e = 0; e < 4; ++e) { v0[e] = gelu_exact(v0[e]); v1[e] = gelu_exact(v1[e]); }
                    *(u32x4*)(Z + ((size_t)chunk * CL + j) * 256 + u.z * 16 + h0) = pack8(v0, v1); } }
        }
    }
};
struct EpiGlu {
    static constexpr bool PERM = true;
    const bf16_t* Z; const float* bglu; bf16_t* S5;
    __device__ __forceinline__ void operator()(AccRef acc, const Unit& u, int wr, int wc, int fr, int fq) const {
        f32x4 b0[2], b1[2];
#pragma unroll
        for (int bj = 0; bj < 2; ++bj) { const int col = bj * HALF + wc * 32 + 8 * fq; b0[bj] = *(const f32x4*)(bglu + col); b1[bj] = *(const f32x4*)(bglu + col + 4); }
#pragma unroll
        for (int ai = 0; ai < 2; ++ai) {
            u32x4 zz[4][2];
#pragma unroll
            for (int m = 0; m < 4; ++m) { const int row = u.pm * BM + ai * HALF + wr * 64 + m * 16 + fr;
#pragma unroll
                for (int bj = 0; bj < 2; ++bj) zz[m][bj] = *(const u32x4*)(Z + (size_t)row * 256 + bj * HALF + wc * 32 + 8 * fq); }
            EPI_WAIT();
#pragma unroll
            for (int m = 0; m < 4; ++m) { const int row = u.pm * BM + ai * HALF + wr * 64 + m * 16 + fr;
#pragma unroll
                for (int bj = 0; bj < 2; ++bj) { const int col = bj * HALF + wc * 32 + 8 * fq; const u32x4 z4 = zz[m][bj];
                    f32x4 v0 = acc[ai][bj][m][0] + b0[bj], v1 = acc[ai][bj][m][1] + b1[bj];
                    v0[0] = bflo(z4.x) * sigm(v0[0]); v0[1] = bfhi(z4.x) * sigm(v0[1]); v0[2] = bflo(z4.y) * sigm(v0[2]); v0[3] = bfhi(z4.y) * sigm(v0[3]);
                    v1[0] = bflo(z4.z) * sigm(v1[0]); v1[1] = bfhi(z4.z) * sigm(v1[1]); v1[2] = bflo(z4.w) * sigm(v1[2]); v1[3] = bfhi(z4.w) * sigm(v1[3]);
                    *(u32x4*)(S5 + (size_t)row * 256 + col) = pack8(v0, v1); } }
        }
    }
};
struct EpiMerge {
    static constexpr bool PERM = true;
    const unsigned char* G8; const bf16_t* P; bf16_t* MG;
    __device__ __forceinline__ void operator()(AccRef acc, const Unit& u, int wr, int wc, int fr, int fq) const {
        const int col0 = u.pn * BM + wc * 32 + 8 * fq;
#pragma unroll
        for (int ai = 0; ai < 2; ++ai) {
            u32x2 gg[4][2]; u32x4 pp[4][2];
#pragma unroll
            for (int m = 0; m < 4; ++m) { const int row = u.pm * BM + ai * HALF + wr * 64 + m * 16 + fr;
#pragma unroll
                for (int bj = 0; bj < 2; ++bj) { gg[m][bj] = *(const u32x2*)(G8 + (size_t)row * 2048 + D + col0 + bj * HALF); pp[m][bj] = *(const u32x4*)(P + (size_t)row * D + col0 + bj * HALF); } }
            EPI_WAIT();
#pragma unroll
            for (int m = 0; m < 4; ++m) { const int row = u.pm * BM + ai * HALF + wr * 64 + m * 16 + fr;
#pragma unroll
                for (int bj = 0; bj < 2; ++bj) { const u32x2 g2 = gg[m][bj]; const u32x4 p4 = pp[m][bj];
                    f32x4 v0 = acc[ai][bj][m][0], v1 = acc[ai][bj][m][1];
                    v0[0] = bflo(p4.x) + ub0(g2.x) * v0[0]; v0[1] = bfhi(p4.x) + ub1(g2.x) * v0[1]; v0[2] = bflo(p4.y) + ub2(g2.x) * v0[2]; v0[3] = bfhi(p4.y) + ub3(g2.x) * v0[3];
                    v1[0] = bflo(p4.z) + ub0(g2.y) * v1[0]; v1[1] = bfhi(p4.z) + ub1(g2.y) * v1[1]; v1[2] = bflo(p4.w) + ub2(g2.y) * v1[2]; v1[3] = bfhi(p4.w) + ub3(g2.y) * v1[3];
                    *(u32x4*)(MG + (size_t)row * D + col0 + bj * HALF) = pack8(v0, v1); } }
        }
    }
};
struct EpiX1 {
    static constexpr bool PERM = true;
    const float* RINV; bf16_t* X1B; float* RS2P;
    __device__ __forceinline__ void operator()(AccRef acc, const Unit& u, int wr, int wc, int fr, int fq) const {
        const int col0 = u.pn * BM + wc * 32 + 8 * fq;
#pragma unroll
        for (int ai = 0; ai < 2; ++ai) {
            u32x4 xb[4][2]; float ri[4];
#pragma unroll
            for (int m = 0; m < 4; ++m) { const int row = u.pm * BM + ai * HALF + wr * 64 + m * 16 + fr; ri[m] = RINV[row];
#pragma unroll
                for (int bj = 0; bj < 2; ++bj) xb[m][bj] = *(const u32x4*)(X1B + (size_t)row * D + col0 + bj * HALF); }
            EPI_WAIT();
#pragma unroll
            for (int m = 0; m < 4; ++m) { const int row = u.pm * BM + ai * HALF + wr * 64 + m * 16 + fr; float ss = 0.f; const float r_ = ri[m];
#pragma unroll
                for (int bj = 0; bj < 2; ++bj) { const size_t o = (size_t)row * D + col0 + bj * HALF; const u32x4 w = xb[m][bj];
                    const f32x4 v0 = acc[ai][bj][m][0] + (f32x4){bflo(w.x), bfhi(w.x), bflo(w.y), bfhi(w.y)} * r_, v1 = acc[ai][bj][m][1] + (f32x4){bflo(w.z), bfhi(w.z), bflo(w.w), bfhi(w.w)} * r_;
                    *(u32x4*)(X1B + o) = pack8(v0, v1);
                    ss += (v0[0] * v0[0] + v0[1] * v0[1]) + (v0[2] * v0[2] + v0[3] * v0[3]) + (v1[0] * v1[0] + v1[1] * v1[1]) + (v1[2] * v1[2] + v1[3] * v1[3]); }
                ss += __shfl_xor(ss, 16); ss += __shfl_xor(ss, 32);
                if (fq == 0) RS2P[(size_t)row * 16 + u.pn * 4 + wc] = ss; }
        }
    }
};
struct EpiSC {
    static constexpr bool PERM = true;
    unsigned short* SC;
    __device__ __forceinline__ void operator()(AccRef acc, const Unit& u, int wr, int wc, int fr, int fq) const {
        const int col0 = u.pn * BM + wc * 32 + 8 * fq;
#pragma unroll
        for (int ai = 0; ai < 2; ++ai)
#pragma unroll
            for (int m = 0; m < 4; ++m) { const int row = u.pm * BM + ai * HALF + wr * 64 + m * 16 + fr;
#pragma unroll
                for (int bj = 0; bj < 2; ++bj) { const f32x4 v0 = acc[ai][bj][m][0], v1 = acc[ai][bj][m][1]; u32x4 o;
                    o.x = pk2h(v0[0], v0[1]); o.y = pk2h(v0[2], v0[3]); o.z = pk2h(v1[0], v1[1]); o.w = pk2h(v1[2], v1[3]);
                    *(u32x4*)(SC + (size_t)row * 2048 + col0 + bj * HALF) = o; } }
    }
};

__device__ __forceinline__ void transpose_item(const float* W, int ldw, int src_col0, bf16_t* WT, int ldt, int dst_row0, int k0, const float* scale, LAS float* scr, int lane, float cs = 1.0f) {
#pragma unroll
    for (int i = 0; i < 32; ++i) { const int kk = 2 * i + (lane >> 5); float v = W[(size_t)(k0 + kk) * ldw + src_col0 + (lane & 31)] * cs; if (scale) v *= scale[k0 + kk]; scr[kk * 33 + (lane & 31)] = v; }
    asm volatile("s_waitcnt lgkmcnt(0)" ::: "memory");
    const int c = lane & 7;
#pragma unroll
    for (int j = 0; j < 4; ++j) { const int n = (lane >> 3) + 8 * j; const LAS float* s = scr + (8 * c) * 33 + n;
        u32x4 o; o.x = pk2bf(s[0 * 33], s[1 * 33]); o.y = pk2bf(s[2 * 33], s[3 * 33]); o.z = pk2bf(s[4 * 33], s[5 * 33]); o.w = pk2bf(s[6 * 33], s[7 * 33]);
        *(u32x4*)(WT + (size_t)(dst_row0 + n) * ldt + k0 + 8 * c) = o; }
    asm volatile("s_waitcnt lgkmcnt(0)" ::: "memory");
}
struct TrIt { const float* src; bf16_t* dst; const float* scale; int ldw, ldt; float cs; };
__device__ __forceinline__ void tr_load(const TrIt& t, int lane, float (&v)[32]) {
#pragma unroll
    for (int i = 0; i < 32; ++i) v[i] = t.src[(size_t)(2 * i + (lane >> 5)) * t.ldw + (lane & 31)];
}
__device__ __forceinline__ void tr_flush(const TrIt& t, const float (&v)[32], LAS float* scr, int lane) {
#pragma unroll
    for (int i = 0; i < 32; ++i) scr[(2 * i + (lane >> 5)) * 33 + (lane & 31)] = v[i];
    asm volatile("s_waitcnt lgkmcnt(0)" ::: "memory");
    const int c = lane & 7;
    f32x4 s0 = (f32x4){t.cs, t.cs, t.cs, t.cs}, s1 = s0;
    if (t.scale) { s0 = *(const f32x4*)(t.scale + 8 * c) * t.cs; s1 = *(const f32x4*)(t.scale + 8 * c + 4) * t.cs; }
#pragma unroll
    for (int j = 0; j < 4; ++j) { const int n = (lane >> 3) + 8 * j; const LAS float* s = scr + (8 * c) * 33 + n;
        u32x4 o; o.x = pk2bf(s[0 * 33] * s0[0], s[1 * 33] * s0[1]); o.y = pk2bf(s[2 * 33] * s0[2], s[3 * 33] * s0[3]); o.z = pk2bf(s[4 * 33] * s1[0], s[5 * 33] * s1[1]); o.w = pk2bf(s[6 * 33] * s1[2], s[7 * 33] * s1[3]);
        *(u32x4*)(t.dst + (size_t)n * t.ldt + 8 * c) = o; }
    asm volatile("s_waitcnt lgkmcnt(0)" ::: "memory");
}
__device__ __forceinline__ int win_src_col(int n) {
    if (n < 768 || n >= 2304) return n;
    const int q = n - 768, j = q >> 8, r = q & 255;
    return r < 128 ? 768 + j * 128 + r : 1536 + j * 128 + (r - 128);
}
__device__ __forceinline__ void phase_prologue(const Params& p, LAS unsigned char* lds, int skip) {
    int tid = threadIdx.x; asm volatile("" : "+v"(tid));
    const int lane = tid & 63, wave = __builtin_amdgcn_readfirstlane(tid >> 6), gw = blockIdx.x * NWAVE + wave;
    unsigned char* ws = p.ws;
    const float* x = p.in[0]; const float* g_mix = p.in[1]; const float* w_in = p.in[2];
    const float* lam_re = p.in[6]; const float* lam_im = p.in[7]; const float* log_dt = p.in[8]; const float* b_re = p.in[9]; const float* b_im = p.in[10];
    const float* w_glu = p.in[14]; const float* w_a = p.in[16]; const float* w_b = p.in[17]; const float* w_out = p.in[18]; const float* g_ffn = p.in[19]; const float* w_q = p.in[20];
    const float* k1 = p.in[21]; const float* k2 = p.in[22]; const float* eu = p.in[23]; const float* ev = p.in[24];
    const int hw = wave & 3, ghw = blockIdx.x * 4 + hw;
    { const int hs_b = (blockIdx.x * 4) >> 6; const float* keys = (hs_b & 1) ? k2 : k1;
      if (!(skip & 1)) { for (int i = tid; i < 128 * 32; i += NTHR) *(LAS f32x4*)(lds + (size_t)i * 16) = *(const f32x4*)(keys + i * 4); }
      __syncthreads(); }
    if (wave >= 4) {
    if (!(skip & 1)) {
        const int hs = ghw >> 6, dblk = (ghw >> 2) & 15, jq = ghw & 3, d = dblk * 64 + lane;
        f32x4 wq[32];
#pragma unroll
        for (int i = 0; i < 32; ++i) wq[i] = *(const f32x4*)(w_q + (size_t)d * 2048 + hs * 128 + i * 4);
        const float gd = g_ffn[d];
        bf16_t* WS = (bf16_t*)(ws + WS_WS);
        for (int j = jq * 32; j < jq * 32 + 32; ++j) {
            const LAS f32x4* kp = (const LAS f32x4*)(lds + (size_t)j * 512); float s0 = 0.f, s1 = 0.f;
#pragma unroll
            for (int i = 0; i < 32; i += 2) { const f32x4 ka = kp[i], kb = kp[i + 1];
                s0 = fmaf(wq[i][0], ka[0], s0); s0 = fmaf(wq[i][1], ka[1], s0); s0 = fmaf(wq[i][2], ka[2], s0); s0 = fmaf(wq[i][3], ka[3], s0);
                s1 = fmaf(wq[i + 1][0], kb[0], s1); s1 = fmaf(wq[i + 1][1], kb[1], s1); s1 = fmaf(wq[i + 1][2], kb[2], s1); s1 = fmaf(wq[i + 1][3], kb[3], s1); }
            WS[(size_t)(hs * 128 + j) * D + d] = (bf16_t)(pk2bf((s0 + s1) * gd, 0.f) & 0xffffu);
        }
    }
    if (!(skip & 2)) {
        LAS float* scr = (LAS float*)(lds + 65536 + hw * 16384);
        constexpr int I_IN = 16 * 144, I_A = 12 * 32, I_B = 4 * 32, I_O = 16 * 32, I_G = 4 * 8, NIT = I_IN + I_A + I_B + I_O + I_G;
        auto decode = [=](int r) -> TrIt {
            if (r < I_IN) { const int kb = r / 144, nb = r % 144; return TrIt{w_in + (size_t)(kb * 64) * IN_COLS + win_src_col(nb * 32), (bf16_t*)(ws + WS_WIN) + (size_t)(nb * 32) * 1024 + kb * 64, g_mix + kb * 64, IN_COLS, 1024, 1.0f}; } r -= I_IN;
            if (r < I_A) { const int kb = r / 32, nb = r % 32; return TrIt{w_a + (size_t)(kb * 64) * 1024 + nb * 32, (bf16_t*)(ws + WS_WA) + (size_t)(nb * 32) * 768 + kb * 64, nullptr, 1024, 768, 1.0f / 255.0f}; }     r -= I_A;
            if (r < I_B) { const int kb = r / 32, nb = r % 32; return TrIt{w_b + (size_t)(kb * 64) * 1024 + nb * 32, (bf16_t*)(ws + WS_WB) + (size_t)(nb * 32) * 256 + kb * 64, nullptr, 1024, 256, 1.0f / 255.0f}; } r -= I_B;
            if (r < I_O) { const int kb = r / 32, nb = r % 32; return TrIt{w_out + (size_t)(kb * 64) * 1024 + nb * 32, (bf16_t*)(ws + WS_WOUT) + (size_t)(nb * 32) * 1024 + kb * 64, nullptr, 1024, 1024, 1.0f}; } r -= I_O;
            { const int kb = r / 8, nb = r % 8; return TrIt{w_glu + (size_t)(kb * 64) * 256 + nb * 32, (bf16_t*)(ws + WS_WGLU) + (size_t)(nb * 32) * 256 + kb * 64, nullptr, 256, 256, 1.0f}; }
        };
        static_assert(NIT >= 3 * (NGW / 2) && NIT <= 4 * (NGW / 2), "three or four transpose items per wave");
        const bool has3 = ghw + 3 * (NGW / 2) < NIT;
        const TrIt t0 = decode(ghw), t1 = decode(ghw + NGW / 2), t2 = decode(ghw + 2 * (NGW / 2)), t3 = decode(has3 ? ghw + 3 * (NGW / 2) : ghw);
        float v0[32], v1[32], v2[32], v3[32];
        tr_load(t0, lane, v0); tr_load(t1, lane, v1); tr_load(t2, lane, v2); if (has3) tr_load(t3, lane, v3);
        tr_flush(t0, v0, scr, lane); tr_flush(t1, v1, scr, lane); tr_flush(t2, v2, scr, lane); if (has3) tr_flush(t3, v3, scr, lane);
    }
    if (!(skip & 16)) {
        const int g = blockIdx.x >> 4, h = blockIdx.x & 15;
        const float dt = expf(log_dt[g]);
        bf16_t* MEND = (bf16_t*)(ws + WS_MEND); bf16_t* MY = (bf16_t*)(ws + WS_MY);
        {
            const int gp = g * 64 + lane; const float lr = lam_re[gp], li = lam_im[gp];
            float sn1, cs1; sincosf(li * dt, &sn1, &cs1); const float mag1 = expf(lr * dt), ar = mag1 * cs1, ai = mag1 * sn1;
            const float den = lr * lr + li * li, nr = ar - 1.0f, ni = ai, kr = (nr * lr + ni * li) / den, ki = (ni * lr - nr * li) / den;
            float bbr[16], bbi[16];
#pragma unroll
            for (int q = 0; q < 4; ++q) { const f32x4 br = *(const f32x4*)(b_re + (size_t)gp * 16 + q * 4), bi = *(const f32x4*)(b_im + (size_t)gp * 16 + q * 4);
#pragma unroll
                for (int c = 0; c < 4; ++c) { bbr[q * 4 + c] = kr * br[c] - ki * bi[c]; bbi[q * 4 + c] = kr * bi[c] + ki * br[c]; } }
            const float cr = p.in[11][(g * 16 + h) * 64 + lane], ci = p.in[12][(g * 16 + h) * 64 + lane];
            const bool b32 = lane & 32, b16 = lane & 16, b8 = lane & 8, b4 = lane & 4;
            const int jl = ((lane >> 5) & 1) * 8 + ((lane >> 4) & 1) * 4 + ((lane >> 3) & 1) * 2 + ((lane >> 2) & 1);
            LAS float* KCL = (LAS float*)(lds + 77824);
            float pr, pi; { const float d0 = (float)(hw * (CL / 4)); float sn, cs; sincosf(li * dt * d0, &sn, &cs); const float mg = expf(lr * dt * d0); pr = mg * cs; pi = mg * sn; }
#pragma unroll 1
            for (int d = hw * (CL / 4); d < (hw + 1) * (CL / 4); ++d) {
                const float wr_ = cr * pr - ci * pi, wi_ = cr * pi + ci * pr;
                float pd[16];
#pragma unroll
                for (int e = 0; e < 16; ++e) pd[e] = wr_ * bbr[e] - wi_ * bbi[e];
                float q8[8], q4[4], q2[2];
#pragma unroll
                for (int j = 0; j < 8; ++j) { const float keep = b32 ? pd[8 + j] : pd[j], send = b32 ? pd[j] : pd[8 + j]; q8[j] = keep + __shfl_xor(send, 32); }
#pragma unroll
                for (int j = 0; j < 4; ++j) { const float keep = b16 ? q8[4 + j] : q8[j], send = b16 ? q8[j] : q8[4 + j]; q4[j] = keep + __shfl_xor(send, 16); }
#pragma unroll
                for (int j = 0; j < 2; ++j) { const float keep = b8 ? q4[2 + j] : q4[j], send = b8 ? q4[j] : q4[2 + j]; q2[j] = keep + __shfl_xor(send, 8); }
                float hsum; { const float keep = b4 ? q2[1] : q2[0], send = b4 ? q2[0] : q2[1]; hsum = keep + __shfl_xor(send, 4); }
                hsum += __shfl_xor(hsum, 2); hsum += __shfl_xor(hsum, 1);
                if ((lane & 3) == 0) KCL[d * 16 + jl] = hsum;
                const float npr = pr * ar - pi * ai, npi = pr * ai + pi * ar; pr = npr; pi = npi;
            }
        }
        {
            constexpr int JP = CL / 16;
            const int it = tid - 256, n = 16 * h + (it >> 4), jseg = it & 15;
            bf16_t* rowp = MEND + (size_t)(g * 256 + n) * CK;
            if (n < 128) {
                const int gp = g * 64 + (n & 63); const float lr = lam_re[gp], li = lam_im[gp];
                float sn1, cs1; sincosf(li * dt, &sn1, &cs1); const float mag1 = expf(lr * dt), ar = mag1 * cs1, ai = mag1 * sn1;
                const float den = lr * lr + li * li, nr = ar - 1.0f, ni = ai, kr = (nr * lr + ni * li) / den, ki = (ni * lr - nr * li) / den;
                float bbr[16], bbi[16];
#pragma unroll
                for (int q = 0; q < 4; ++q) { const f32x4 br = *(const f32x4*)(b_re + (size_t)gp * 16 + q * 4), bi = *(const f32x4*)(b_im + (size_t)gp * 16 + q * 4);
#pragma unroll
                    for (int c = 0; c < 4; ++c) { bbr[q * 4 + c] = kr * br[c] - ki * bi[c]; bbi[q * 4 + c] = kr * bi[c] + ki * br[c]; } }
                float pr, pi; { const float d0 = (float)(CL - 1 - (jseg * JP + JP - 1)); float sn, cs; sincosf(li * dt * d0, &sn, &cs); const float mg = expf(lr * dt * d0); pr = mg * cs; pi = mg * sn; }
#pragma unroll
                for (int jj = JP - 1; jj >= 0; --jj) { const int jp = jseg * JP + jj;
                    float v[16];
#pragma unroll
                    for (int e = 0; e < 16; ++e) v[e] = n < 64 ? pr * bbr[e] - pi * bbi[e] : pr * bbi[e] + pi * bbr[e];
                    u32x4 o; o.x = pk2bf(v[0], v[1]); o.y = pk2bf(v[2], v[3]); o.z = pk2bf(v[4], v[5]); o.w = pk2bf(v[6], v[7]); *(u32x4*)(rowp + jp * 16) = o;
                    o.x = pk2bf(v[8], v[9]); o.y = pk2bf(v[10], v[11]); o.z = pk2bf(v[12], v[13]); o.w = pk2bf(v[14], v[15]); *(u32x4*)(rowp + jp * 16 + 8) = o;
                    const float npr = pr * ar - pi * ai, npi = pr * ai + pi * ar; pr = npr; pi = npi; }
            } else {
#pragma unroll
                for (int jj = 0; jj < JP; ++jj) { *(u32x4*)(rowp + (jseg * JP + jj) * 16) = (u32x4){0u, 0u, 0u, 0u}; *(u32x4*)(rowp + (jseg * JP + jj) * 16 + 8) = (u32x4){0u, 0u, 0u, 0u}; }
            }
        }
        {
            const int it = tid - 256, pp = it & 63, jseg = it >> 6, gp = g * 64 + pp; const float lr = lam_re[gp], li = lam_im[gp];
            float sn1, cs1; sincosf(li * dt, &sn1, &cs1); const float mag1 = expf(lr * dt), ar = mag1 * cs1, ai = mag1 * sn1;
            const float cr = p.in[11][(g * 16 + h) * 64 + pp], ci = p.in[12][(g * 16 + h) * 64 + pp];
            float pr, pi; { const float d0 = (float)(jseg * (CL / 4) + 1); float sn, cs; sincosf(li * dt * d0, &sn, &cs); const float mg = expf(lr * dt * d0); pr = mg * cs; pi = mg * sn; }
#pragma unroll 1
            for (int j = jseg * (CL / 4); j < (jseg + 1) * (CL / 4); ++j) {
                bf16_t* rowp = MY + ((size_t)(g * CK + j * 16 + h)) * SUK;
                rowp[CK + pp] = (bf16_t)(pk2bf(cr * pr - ci * pi, 0.f) & 0xffffu); rowp[CK + 64 + pp] = (bf16_t)(pk2bf(-(cr * pi + ci * pr), 0.f) & 0xffffu);
                const float npr = pr * ar - pi * ai, npi = pr * ai + pi * ar; pr = npr; pi = npi;
            }
        }
    }
    }
    if (wave < 4) {
    if (!(skip & 4)) {
        bf16_t* XB = (bf16_t*)(ws + WS_XB); float* RINV = (float*)(ws + WS_RINV);
        for (int t0 = ghw; t0 < T; t0 += 2 * NGW) {
            f32x4 a[4][4];
#pragma unroll
            for (int u = 0; u < 4; ++u) { const float* xr = x + (size_t)(t0 + u * (NGW / 2)) * D;
                a[u][0] = *(const f32x4*)(xr + lane * 8); a[u][1] = *(const f32x4*)(xr + lane * 8 + 4); a[u][2] = *(const f32x4*)(xr + 512 + lane * 8); a[u][3] = *(const f32x4*)(xr + 512 + lane * 8 + 4); }
#pragma unroll
            for (int u = 0; u < 4; ++u) { const int t = t0 + u * (NGW / 2); float sq = 0.f;
#pragma unroll
                for (int q = 0; q < 4; ++q) sq += (a[u][q][0] * a[u][q][0] + a[u][q][1] * a[u][q][1]) + (a[u][q][2] * a[u][q][2] + a[u][q][3] * a[u][q][3]);
                sq = wave_sum(sq);
                const float rsd = rsqrtf(sq * (1.0f / D) + RMS_EPS);
                if (lane == 0) RINV[t] = sqrtf(sq * (1.0f / D) + RMS_EPS);
                *(u32x4*)(XB + (size_t)t * D + lane * 8) = pack8(a[u][0] * rsd, a[u][1] * rsd); *(u32x4*)(XB + (size_t)t * D + 512 + lane * 8) = pack8(a[u][2] * rsd, a[u][3] * rsd); }
        }
    }
    if (!(skip & 8)) {
        unsigned char* UQ = ws + WS_UH; unsigned char* VQ = ws + WS_VH; float* USC = (float*)(ws + WS_USC); float* VSC = (float*)(ws + WS_VSC);
        f32x4 gf[4];
#pragma unroll
        for (int q = 0; q < 4; ++q) gf[q] = *(const f32x4*)(g_ffn + lane * 16 + q * 4);
        for (int r0 = ghw; r0 < 2 * 16384; r0 += 2 * NGW) {
            f32x4 v[4][4];
#pragma unroll
            for (int u = 0; u < 4; ++u) { const int r = r0 + u * (NGW / 2); const bool isv = r >= 16384; const int e = isv ? r - 16384 : r; const float* src = (isv ? ev : eu) + (size_t)e * D + lane * 16;
#pragma unroll
                for (int q = 0; q < 4; ++q) v[u][q] = *(const f32x4*)(src + q * 4); }
#pragma unroll
            for (int u = 0; u < 4; ++u) { const int r = r0 + u * (NGW / 2); const bool isv = r >= 16384; const int e = isv ? r - 16384 : r;
                float mx = 0.f;
#pragma unroll
                for (int q = 0; q < 4; ++q) { if (!isv) v[u][q] = v[u][q] * gf[q];
#pragma unroll
                    for (int c = 0; c < 4; ++c) mx = fmaxf(mx, fabsf(v[u][q][c])); }
#pragma unroll
                for (int o = 1; o < 64; o <<= 1) mx = fmaxf(mx, __shfl_xor(mx, o));
                const float sc = mx > 0.f ? mx * (1.0f / 127.0f) : 1.0f, inv = 1.0f / sc;
                u32x4 w;
#pragma unroll
                for (int q = 0; q < 4; ++q) { unsigned d = 0;
#pragma unroll
                    for (int c = 0; c < 4; ++c) { int qi = (int)rintf(v[u][q][c] * inv); qi = qi > 127 ? 127 : (qi < -127 ? -127 : qi); d |= ((unsigned)qi & 0xffu) << (8 * c); }
                    w[q] = d; }
                *(u32x4*)((isv ? VQ : UQ) + ((size_t)(lane >> 3) * 16384 + e) * 128 + (lane & 7) * 16) = w;
                if (lane == 0) (isv ? VSC : USC)[e] = sc; }
        }
    }
    }
    asm volatile("s_waitcnt lgkmcnt(0)" ::: "memory");
    __syncthreads();
    if (!(skip & 16)) {
        const int g = blockIdx.x >> 4, h = blockIdx.x & 15; bf16_t* MY = (bf16_t*)(ws + WS_MY); const LAS float* KCL = (const LAS float*)(lds + 77824);
        for (int it = tid; it < CL * (CK / 8); it += NTHR) {
            const int j = it / (CK / 8), kc = it % (CK / 8), jp = kc >> 1, h0 = (kc & 1) * 8;
            u32x4 w = (u32x4){0u, 0u, 0u, 0u};
            if (j >= jp) { const LAS f32x4* src = (const LAS f32x4*)(KCL + (j - jp) * 16 + h0); const f32x4 a = src[0], b = src[1]; w = pack8(a, b); }
            *(u32x4*)(MY + ((size_t)(g * CK + j * 16 + h)) * SUK + kc * 8) = w;
        }
    }
}

__device__ __forceinline__ void phase_ssm_tables(const Params& p) {
    unsigned char* ws = p.ws; const float* c_re = p.in[11]; const float* c_im = p.in[12];
    const float* POW = (const float*)(ws + WS_POW); const float* BBAR = (const float*)(ws + WS_BBAR);
    float* KC = (float*)(ws + WS_KC); bf16_t* MEND = (bf16_t*)(ws + WS_MEND);
    int tid = threadIdx.x; asm volatile("" : "+v"(tid));
    const int gt = blockIdx.x * NTHR + tid, NT = NBLK * NTHR;
    {
        const int lane = tid & 63, wave = __builtin_amdgcn_readfirstlane(tid >> 6), gw = blockIdx.x * NWAVE + wave;
        const bool b32 = lane & 32, b16 = lane & 16, b8 = lane & 8, b4 = lane & 4;
        const int jl = ((lane >> 5) & 1) * 8 + ((lane >> 4) & 1) * 4 + ((lane >> 3) & 1) * 2 + ((lane >> 2) & 1);
        for (int it = gw; it < 16 * 64 * 16; it += NGW) {
            const int g = it >> 10, d = (it >> 4) & 63, h = it & 15;
            const float cr = c_re[(g * 16 + h) * 64 + lane], ci = c_im[(g * 16 + h) * 64 + lane];
            const float pr = POW[((size_t)(g * 65 + d) * 64 + lane) * 2], pi = POW[((size_t)(g * 65 + d) * 64 + lane) * 2 + 1];
            const float wr_ = cr * pr - ci * pi, wi_ = cr * pi + ci * pr;
            const f32x4* bb = (const f32x4*)(BBAR + (size_t)(g * 64 + lane) * 32);
            float pd[16];
#pragma unroll
            for (int q = 0; q < 8; ++q) { const f32x4 v = bb[q]; pd[2 * q] = wr_ * v[0] - wi_ * v[1]; pd[2 * q + 1] = wr_ * v[2] - wi_ * v[3]; }
            float q8[8], q4[4], q2[2];
#pragma unroll
            for (int j = 0; j < 8; ++j) { const float keep = b32 ? pd[8 + j] : pd[j], send = b32 ? pd[j] : pd[8 + j]; q8[j] = keep + __shfl_xor(send, 32); }
#pragma unroll
            for (int j = 0; j < 4; ++j) { const float keep = b16 ? q8[4 + j] : q8[j], send = b16 ? q8[j] : q8[4 + j]; q4[j] = keep + __shfl_xor(send, 16); }
#pragma unroll
            for (int j = 0; j < 2; ++j) { const float keep = b8 ? q4[2 + j] : q4[j], send = b8 ? q4[j] : q4[2 + j]; q2[j] = keep + __shfl_xor(send, 8); }
            float hsum; { const float keep = b4 ? q2[1] : q2[0], send = b4 ? q2[0] : q2[1]; hsum = keep + __shfl_xor(send, 4); }
            hsum += __shfl_xor(hsum, 2); hsum += __shfl_xor(hsum, 1);
            if ((lane & 3) == 0) KC[(size_t)it * 16 + jl] = hsum;
        }
    }
    for (int i = gt; i < 16 * 256 * 128; i += NT) {
        const int g = i >> 15, n = (i >> 7) & 255, k8 = (i & 127) * 8, jp = k8 >> 4, h0 = k8 & 15;
        u32x4 o = (u32x4){0u, 0u, 0u, 0u};
        if (n < 128) {
            const int pp = n & 63; const float pr = POW[((size_t)(g * 65 + 63 - jp) * 64 + pp) * 2], pi = POW[((size_t)(g * 65 + 63 - jp) * 64 + pp) * 2 + 1];
            float v[8];
#pragma unroll
            for (int e = 0; e < 8; ++e) { const float br = BBAR[((size_t)(g * 64 + pp) * 16 + h0 + e) * 2], bi = BBAR[((size_t)(g * 64 + pp) * 16 + h0 + e) * 2 + 1];
                v[e] = n < 64 ? pr * br - pi * bi : pr * bi + pi * br; }
            o.x = pk2bf(v[0], v[1]); o.y = pk2bf(v[2], v[3]); o.z = pk2bf(v[4], v[5]); o.w = pk2bf(v[6], v[7]);
        }
        *(u32x4*)(MEND + (size_t)i * 8) = o;
    }
}

__device__ __forceinline__ void phase_conv_my(const Params& p, int first_block) {
    if ((int)blockIdx.x < first_block) return;
    unsigned char* ws = p.ws; const float* conv_w = p.in[4]; const float* conv_b = p.in[5]; const float* c_re = p.in[11]; const float* c_im = p.in[12];
    const bf16_t* CB = (const bf16_t*)(ws + WS_CB); const bf16_t* V = (const bf16_t*)(ws + WS_V); bf16_t* A2 = (bf16_t*)(ws + WS_A2);
    const float* KC = (const float*)(ws + WS_KC); const float* POW = (const float*)(ws + WS_POW); bf16_t* MY = (bf16_t*)(ws + WS_MY);
    int tid = threadIdx.x; asm volatile("" : "+v"(tid));
    const int nb = NBLK - first_block, gt = ((int)blockIdx.x - first_block) * NTHR + tid, NT = nb * NTHR;
    const int lane = tid & 63, wave = __builtin_amdgcn_readfirstlane(tid >> 6), gw = ((int)blockIdx.x - first_block) * NWAVE + wave, NW = nb * NWAVE;
    for (int i = gt; i < 96 * (T / 32); i += NT) {
        const int j8 = (i % 96) * 8, t0 = (i / 96) * 32;
        float w0[8], w1[8], w2[8], bb[8];
#pragma unroll
        for (int e = 0; e < 8; ++e) { w0[e] = conv_w[j8 + e]; w1[e] = conv_w[CONV_CH + j8 + e]; w2[e] = conv_w[2 * CONV_CH + j8 + e]; bb[e] = conv_b[j8 + e]; }
        u32x4 vm2 = (u32x4){0u, 0u, 0u, 0u}, vm1 = (u32x4){0u, 0u, 0u, 0u};
        if ((t0 & (SEQ - 1)) != 0) { vm2 = *(const u32x4*)(V + (size_t)(t0 - 2) * CONV_CH + j8); vm1 = *(const u32x4*)(V + (size_t)(t0 - 1) * CONV_CH + j8); }
#pragma unroll 4
        for (int tt = 0; tt < 32; ++tt) {
            const size_t o = (size_t)(t0 + tt) * CONV_CH + j8;
            const u32x4 cb = *(const u32x4*)(CB + o), v0 = *(const u32x4*)(V + o);
            float r[8];
#pragma unroll
            for (int e = 0; e < 8; ++e) {
                const unsigned dc = cb[e >> 1], d0 = v0[e >> 1], d1 = vm1[e >> 1], d2 = vm2[e >> 1];
                const float fc = (e & 1) ? bfhi(dc) : bflo(dc), f0 = (e & 1) ? bfhi(d0) : bflo(d0), f1 = (e & 1) ? bfhi(d1) : bflo(d1), f2 = (e & 1) ? bfhi(d2) : bflo(d2);
                r[e] = fc * (bb[e] + w0[e] * f2 + w1[e] * f1 + w2[e] * f0);
            }
            u32x4 w; w.x = pk2bf(r[0], r[1]); w.y = pk2bf(r[2], r[3]); w.z = pk2bf(r[4], r[5]); w.w = pk2bf(r[6], r[7]);
            *(u32x4*)(A2 + o) = w;
            vm2 = vm1; vm1 = v0;
        }
    }
}

__device__ __forceinline__ void phase_carry(const Params& p) {
    constexpr int NPL = CPS / 64;
    int tid = threadIdx.x; asm volatile("" : "+v"(tid));
    const int lane = tid & 63, wave = __builtin_amdgcn_readfirstlane(tid >> 6), gw = blockIdx.x * NWAVE + wave;
    unsigned char* ws = p.ws; const float* E = (const float*)(ws + WS_E); bf16_t* SU = (bf16_t*)(ws + WS_SU);
    for (int it = gw; it < (T / SEQ) * 1024; it += NGW) {
        const int b = it >> 10, g = (it >> 6) & 15, pp = it & 63;
        float ar, ai; { const float lr = p.in[6][g * 64 + pp], li = p.in[7][g * 64 + pp], dt = expf(p.in[8][g]); float sn, cs; sincosf(li * dt * (float)CL, &sn, &cs); const float mg = expf(lr * dt * (float)CL); ar = mg * cs; ai = mg * sn; }
        const size_t ch0 = (size_t)g * NCHUNK + b * CPS + NPL * lane;
        float er[NPL], ei[NPL];
#pragma unroll
        for (int k = 0; k < NPL; ++k) { er[k] = E[(ch0 + k) * 128 + pp]; ei[k] = E[(ch0 + k) * 128 + 64 + pp]; }
        float sr = 0.f, si = 0.f, mr = 1.f, mi = 0.f;
#pragma unroll
        for (int k = 0; k < NPL; ++k) { const float nr = ar * sr - ai * si + er[k], ni = ar * si + ai * sr + ei[k]; sr = nr; si = ni; const float tr = mr * ar - mi * ai, ti = mr * ai + mi * ar; mr = tr; mi = ti; }
#pragma unroll
        for (int d = 0; d < 6; ++d) { const int off = 1 << d; const float orr = __shfl_up(sr, off), oii = __shfl_up(si, off);
            if (lane >= off) { sr += mr * orr - mi * oii; si += mr * oii + mi * orr; }
            const float nmr = mr * mr - mi * mi, nmi = 2.0f * mr * mi; mr = nmr; mi = nmi; }
        float xr = __shfl_up(sr, 1), xi = __shfl_up(si, 1); if (lane == 0) { xr = 0.f; xi = 0.f; }
#pragma unroll
        for (int k = 0; k < NPL; ++k) {
            SU[(ch0 + k) * SUK + CK + pp] = (bf16_t)(pk2bf(xr, 0.f) & 0xffffu); SU[(ch0 + k) * SUK + CK + 64 + pp] = (bf16_t)(pk2bf(xi, 0.f) & 0xffffu);
            const float nr = ar * xr - ai * xi + er[k], ni = ar * xi + ai * xr + ei[k]; xr = nr; xi = ni; }
    }
}

__device__ __forceinline__ void ins16(float (&a)[16], float x, float big) {
#pragma unroll
    for (int k = 15; k >= 1; --k) a[k] = __builtin_amdgcn_fmed3f(a[k - 1], a[k], x);
    a[0] = __builtin_amdgcn_fmed3f(a[0], x, big);
}
__device__ __forceinline__ void ins16r(float (&a)[16], float x, float big, int R) {
#pragma unroll
    for (int k = 15; k >= 1; --k) if (k >= R) a[k] = __builtin_amdgcn_fmed3f(a[k - 1], a[k], x);
    if (R == 0) a[0] = __builtin_amdgcn_fmed3f(a[0], x, big);
}
__device__ __forceinline__ void phase_topk(const Params& p, LAS unsigned char* lds) {
    unsigned char* ws = p.ws; const unsigned short* SC = (const unsigned short*)(ws + WS_SC); const float* RS2P = (const float*)(ws + WS_RS2P);
    unsigned short* EIDX = (unsigned short*)(ws + WS_EIDX); unsigned short* GATE = (unsigned short*)(ws + WS_GATE);
    int tid = threadIdx.x; asm volatile("" : "+v"(tid));
    const int lane = tid & 63, wave = __builtin_amdgcn_readfirstlane(tid >> 6);
    LAS unsigned char* wst = lds + wave * 17408;
    LAS unsigned* myl = (LAS unsigned*)(wst + lane * 32);
    const float NINF = -__builtin_inff(); float BIG = 3.0e38f; asm volatile("" : "+s"(BIG));
    const int tw0 = blockIdx.x * (T / NBLK) + wave * (T / NGW);
#define TK_LOAD(it_) do { _Pragma("unroll") for (int i = 0; i < 16; ++i)     \
        r[i] = *(const u32x4*)(SC + (size_t)(tw0 + (it_) * 4 + (i >> 2)) * 2048 + (4 * (i & 3) + (lane >> 4)) * 128 + (lane & 15) * 8); } while (0)
    u32x4 r[16];
    TK_LOAD(0);
#pragma unroll 1
    for (int item = 0; item < (T / NGW) / 4; ++item) {
        const int t = tw0 + item * 4 + (lane >> 4), hs = lane & 15, h = hs >> 1, odd = lane & 1;
        f32x4 pv4[4];
#pragma unroll
        for (int q = 0; q < 4; ++q) pv4[q] = *(const f32x4*)(RS2P + (size_t)t * 16 + q * 4);
        float a[16];
#pragma unroll
        for (int k = 0; k < 16; ++k) a[k] = NINF;
        {
#pragma unroll
            for (int i = 0; i < 16; ++i) *(LAS u32x4*)(wst + (lane >> 4) * 272 + (lane & 15) * 16 + i * 1088) = r[i];
            if (item + 1 < (T / NGW) / 4) TK_LOAD(item + 1);
#pragma unroll
            for (int c = 0; c < 16; ++c) { const u32x4 v = *(const LAS u32x4*)(wst + lane * 272 + c * 16);
                float w[4];
#pragma unroll
                for (int e = 0; e < 4; ++e) { const h2 hv = as_h2(v[e]);
                    const float k0 = __uint_as_float(__float_as_uint((float)hv[0]) | (unsigned)(c * 8 + 2 * e)), k1 = __uint_as_float(__float_as_uint((float)hv[1]) | (unsigned)(c * 8 + 2 * e + 1));
                    w[e] = __builtin_amdgcn_fmed3f(k0, k1, BIG); }
                ins16(a, __builtin_amdgcn_fmed3f(w[0], w[1], BIG), BIG); ins16(a, __builtin_amdgcn_fmed3f(w[2], w[3], BIG), BIG);
                __builtin_amdgcn_sched_barrier(0); }
            { unsigned pi[15]; float l2[15];
#pragma unroll
              for (int k = 0; k < 15; ++k) pi[k] = ((__float_as_uint(a[k]) & 127u) >> 1) ^ 1u;
#pragma unroll
              for (int k = 0; k < 15; ++k) { const h2 hv = as_h2(*(const LAS unsigned*)(wst + lane * 272 + pi[k] * 4));
                  const float k0 = __uint_as_float(__float_as_uint((float)hv[0]) | (pi[k] * 2u)), k1 = __uint_as_float(__float_as_uint((float)hv[1]) | (pi[k] * 2u + 1u));
                  l2[k] = __builtin_amdgcn_fmed3f(k0, k1, BIG); }
#pragma unroll
              for (int k = 0; k < 15; ++k) ins16r(a, l2[k], BIG, k + 1); }
            unsigned li[15]; float lk[15];
#pragma unroll
            for (int k = 0; k < 15; ++k) li[k] = (__float_as_uint(a[k]) & 127u) ^ 1u;
#pragma unroll
            for (int k = 0; k < 15; ++k) { const unsigned short hb = *(const LAS unsigned short*)(wst + lane * 272 + li[k] * 2); lk[k] = __uint_as_float(__float_as_uint((float)__builtin_bit_cast(_Float16, hb)) | li[k]); }
#pragma unroll
            for (int k = 0; k < 15; ++k) ins16r(a, lk[k], BIG, k + 1);
        }
        float A[16], B[16];
#pragma unroll
        for (int k = 0; k < 16; ++k) { const float o = __shfl_xor(a[k], 1); A[k] = odd ? o : a[k]; B[k] = odd ? a[k] : o; }
        float f[16];
#pragma unroll
        for (int k = 0; k < 16; ++k) f[k] = NINF;
#pragma unroll
        for (int ia = 0; ia < 16; ++ia)
#pragma unroll
            for (int ib = 0; ib < 16; ++ib)
                if ((ia + 1) * (ib + 1) <= 16) {
                    const unsigned sb = __float_as_uint(A[ia] + B[ib]), sg = (unsigned)((int)sb >> 31);
                    ins16r(f, __uint_as_float((sb & ~255u) | ((sg ^ (255u - (unsigned)(ia * 16 + ib))) & 255u)), BIG, (ia + 1) * (ib + 1) - 1); }
        u32x4 wa, wb;
        wa.x = (__float_as_uint(A[0]) & 127u) | ((__float_as_uint(A[1]) & 127u) << 8) | ((__float_as_uint(A[2]) & 127u) << 16) | ((__float_as_uint(A[3]) & 127u) << 24);
        wa.y = (__float_as_uint(A[4]) & 127u) | ((__float_as_uint(A[5]) & 127u) << 8) | ((__float_as_uint(A[6]) & 127u) << 16) | ((__float_as_uint(A[7]) & 127u) << 24);
        wa.z = (__float_as_uint(A[8]) & 127u) | ((__float_as_uint(A[9]) & 127u) << 8) | ((__float_as_uint(A[10]) & 127u) << 16) | ((__float_as_uint(A[11]) & 127u) << 24);
        wa.w = (__float_as_uint(A[12]) & 127u) | ((__float_as_uint(A[13]) & 127u) << 8) | ((__float_as_uint(A[14]) & 127u) << 16) | ((__float_as_uint(A[15]) & 127u) << 24);
        wb.x = (__float_as_uint(B[0]) & 127u) | ((__float_as_uint(B[1]) & 127u) << 8) | ((__float_as_uint(B[2]) & 127u) << 16) | ((__float_as_uint(B[3]) & 127u) << 24);
        wb.y = (__float_as_uint(B[4]) & 127u) | ((__float_as_uint(B[5]) & 127u) << 8) | ((__float_as_uint(B[6]) & 127u) << 16) | ((__float_as_uint(B[7]) & 127u) << 24);
        wb.z = (__float_as_uint(B[8]) & 127u) | ((__float_as_uint(B[9]) & 127u) << 8) | ((__float_as_uint(B[10]) & 127u) << 16) | ((__float_as_uint(B[11]) & 127u) << 24);
        wb.w = (__float_as_uint(B[12]) & 127u) | ((__float_as_uint(B[13]) & 127u) << 8) | ((__float_as_uint(B[14]) & 127u) << 16) | ((__float_as_uint(B[15]) & 127u) << 24);
        *(LAS u32x4*)myl = wa; *(LAS u32x4*)(myl + 4) = wb;
        float ssq = 0.f;
#pragma unroll
        for (int q = 0; q < 4; ++q) { const f32x4 pv = pv4[q]; ssq += (pv[0] + pv[1]) + (pv[2] + pv[3]); }
        const float rs = rsqrtf(ssq * (1.0f / D) + RMS_EPS);
        float ex[16], sum = 0.f;
#pragma unroll
        for (int k = 0; k < 16; ++k) { ex[k] = __expf(rs * (f[k] - f[0])); sum += ex[k]; }
        const float inv = 1.0f / sum;
        int eo[8]; float go[8]; const unsigned omask = odd ? 0xffffffffu : 0u;
        const LAS unsigned char* mb = (const LAS unsigned char*)myl;
#pragma unroll
        for (int r = 0; r < 8; ++r) {
            const unsigned fsel = (__float_as_uint(f[8 + r]) & omask) | (__float_as_uint(f[r]) & ~omask);
            const unsigned code = ~(fsel ^ (unsigned)((int)fsel >> 31)) & 255u;
            const unsigned i1 = mb[code >> 4], i2 = mb[16 + (code & 15u)];
            eo[r] = (int)(i1 * 128u + i2); go[r] = __uint_as_float((__float_as_uint(ex[8 + r]) & omask) | (__float_as_uint(ex[r]) & ~omask)) * inv;
        }
        const size_t ob = ((size_t)t * 8 + h) * 16 + odd * 8;
        *(u32x4*)(EIDX + ob) = (u32x4){(unsigned)eo[0] | ((unsigned)eo[1] << 16), (unsigned)eo[2] | ((unsigned)eo[3] << 16), (unsigned)eo[4] | ((unsigned)eo[5] << 16), (unsigned)eo[6] | ((unsigned)eo[7] << 16)};
        *(u32x4*)(GATE + ob) = (u32x4){pk2h(go[0], go[1]), pk2h(go[2], go[3]), pk2h(go[4], go[5]), pk2h(go[6], go[7])};
    }
}

#undef TK_LOAD
#define LANE_OF(j) ((((j) >> 3) & 1) * 32 + (((j) >> 2) & 1) * 16 + (((j) >> 1) & 1) * 8 + ((j) & 1) * 4)
__device__ __forceinline__ void axpy4u(float* acc, unsigned d, float w) {
    acc[0] = fmaf((float)(d & 0xffu), w, acc[0]); acc[1] = fmaf((float)((d >> 8) & 0xffu), w, acc[1]);
    acc[2] = fmaf((float)((d >> 16) & 0xffu), w, acc[2]); acc[3] = fmaf((float)(d >> 24), w, acc[3]);
}
constexpr int TPB = T / NBLK, TPW = TPB / NWAVE;
constexpr int EX_EL = 0, EX_HA = TPB * 128 * 2, EX_HS = EX_HA + TPB * 128 * 4, EX_WS = EX_HS + TPB * 4, EX_SS = EX_WS + TPB * 4;
static_assert(EX_SS + TPB * 4 <= LDS_STAGE && NWAVE * 17408 <= LDS_BYTES, "expert phase / routing LDS");
__device__ __forceinline__ void phase_expert(const Params& p, LAS unsigned char* lds) {
    unsigned char* ws = p.ws;
    const bf16_t* X1B = (const bf16_t*)(ws + WS_X1B); const float* RS2P = (const float*)(ws + WS_RS2P);
    const unsigned short* EIDX = (const unsigned short*)(ws + WS_EIDX); const unsigned short* GATE = (const unsigned short*)(ws + WS_GATE);
    const unsigned char* UQ = ws + WS_UH; const unsigned char* VQ = ws + WS_VH; const float* USC = (const float*)(ws + WS_USC); const float* VSC = (const float*)(ws + WS_VSC);
    unsigned char* XQ = ws + WS_XQ;
    const float* gfin = p.in[25]; float* out = p.out;
    unsigned char* const SCb = ws + WS_SC;
    auto x2tmp = [=](size_t t) -> bf16_t* { return (bf16_t*)(SCb + t * 4096); };
    int tid = threadIdx.x; asm volatile("" : "+v"(tid));
    const int lane = tid & 63, wave = __builtin_amdgcn_readfirstlane(tid >> 6);
    const int g = lane >> 3, ch = lane & 7;
    const bool b1 = lane & 1, b2 = lane & 2, b4 = lane & 4, b8 = lane & 8, b16 = lane & 16, b32 = lane & 32;
    LAS unsigned short* EL = (LAS unsigned short*)(lds + EX_EL); LAS int* HA = (LAS int*)(lds + EX_HA);
    LAS float* HS = (LAS float*)(lds + EX_HS); LAS float* WSUM = (LAS float*)(lds + EX_WS); LAS float* SSQ = (LAS float*)(lds + EX_SS);
    const int tl0 = wave * TPW, tg0 = blockIdx.x * TPB;
#pragma unroll 1
    for (int q0 = 0; q0 < TPW; q0 += 4) {
        u32x4 xa4[4], xb4[4]; float sq4[4]; unsigned ew4[4];
#pragma unroll
        for (int u = 0; u < 4; ++u) { const size_t t = (size_t)(tg0 + tl0 + q0 + u);
            xa4[u] = *(const u32x4*)(X1B + t * D + lane * 16); xb4[u] = *(const u32x4*)(X1B + t * D + lane * 16 + 8);
            sq4[u] = (lane < 16) ? RS2P[t * 16 + lane] : 0.f; ew4[u] = *(const unsigned*)(EIDX + t * 128 + 2 * lane); }
#pragma unroll
        for (int u = 0; u < 4; ++u) { const int tl = tl0 + q0 + u; const size_t t = (size_t)(tg0 + tl); const u32x4 xa = xa4[u], xb = xb4[u];
            float xf[16];
            xf[0] = bflo(xa.x); xf[1] = bfhi(xa.x); xf[2] = bflo(xa.y); xf[3] = bfhi(xa.y); xf[4] = bflo(xa.z); xf[5] = bfhi(xa.z); xf[6] = bflo(xa.w); xf[7] = bfhi(xa.w);
            xf[8] = bflo(xb.x); xf[9] = bfhi(xb.x); xf[10] = bflo(xb.y); xf[11] = bfhi(xb.y); xf[12] = bflo(xb.z); xf[13] = bfhi(xb.z); xf[14] = bflo(xb.w); xf[15] = bfhi(xb.w);
            float mx = 0.f;
#pragma unroll
            for (int i = 0; i < 16; ++i) mx = fmaxf(mx, fabsf(xf[i]));
#pragma unroll
            for (int o = 1; o < 64; o <<= 1) mx = fmaxf(mx, __shfl_xor(mx, o));
            const float xsc = mx > 0.f ? mx * (1.0f / 127.0f) : 1.0f, xinv = 1.0f / xsc;
            u32x4 xq;
#pragma unroll
            for (int k = 0; k < 4; ++k) { unsigned d = 0;
#pragma unroll
                for (int c = 0; c < 4; ++c) d |= ((unsigned)(int)rintf(xf[k * 4 + c] * xinv) & 0xffu) << (8 * c);
                xq[k] = d; }
            *(u32x4*)(XQ + t * D + lane * 16) = xq;
            const float ssq = wave_sum(sq4[u]);
            if (lane == 0) { HS[tl] = rsqrtf(ssq * (1.0f / D) + RMS_EPS) * xsc; SSQ[tl] = 0.f; }
            *(LAS unsigned*)(EL + tl * 128 + 2 * lane) = ew4[u];
            HA[tl * 128 + lane] = 0; HA[tl * 128 + 64 + lane] = 0; }
    }
    asm volatile("s_waitcnt vmcnt(0) lgkmcnt(0)" ::: "memory");
    __syncthreads();
#define EXU_LOAD(R, XS, q_) do { const int tl_ = tl0 + (q_); XS = *(const u32x4*)(XQ + (size_t)(tg0 + tl_) * D + s * 128 + ch * 16); \
        _Pragma("unroll") for (int i = 0; i < 16; ++i) { const int e_ = EL[tl_ * 128 + 8 * i + g]; R[i] = *(const u32x4*)(usl + (unsigned)(e_ * 128 + ch * 16)); } } while (0)
#define EXU_COMP(R, XS, q_) do { const int tl_ = tl0 + (q_); int pd[16]; \
        _Pragma("unroll") for (int i = 0; i < 16; ++i) { int sd = dot4z(R[i].x, (int)XS.x); sd = __builtin_amdgcn_sdot4((int)R[i].y, (int)XS.y, sd, false); \
            sd = __builtin_amdgcn_sdot4((int)R[i].z, (int)XS.z, sd, false); sd = __builtin_amdgcn_sdot4((int)R[i].w, (int)XS.w, sd, false); pd[i] = sd; } \
        int q8[8], q4[4], q2[2]; \
        _Pragma("unroll") for (int j = 0; j < 8; ++j) { const int keep = b4 ? pd[8 + j] : pd[j], send = b4 ? pd[j] : pd[8 + j]; q8[j] = keep + __shfl_xor(send, 4); } \
        _Pragma("unroll") for (int j = 0; j < 4; ++j) { const int keep = b2 ? q8[4 + j] : q8[j], send = b2 ? q8[j] : q8[4 + j]; q4[j] = keep + __shfl_xor(send, 2); } \
        _Pragma("unroll") for (int j = 0; j < 2; ++j) { const int keep = b1 ? q4[2 + j] : q4[j], send = b1 ? q4[j] : q4[2 + j]; q2[j] = keep + __shfl_xor(send, 1); } \
        HA[tl_ * 128 + 16 * ch + g] += q2[0]; HA[tl_ * 128 + 16 * ch + 8 + g] += q2[1]; } while (0)
#pragma unroll 1
    for (int s = 0; s < 8; ++s) {
        u32x4 ra[16], rb[16], xsa, xsb; const unsigned char* usl = UQ + (size_t)s * (16384 * 128);
        EXU_LOAD(ra, xsa, 0);
#pragma unroll 1
        for (int q = 0; q < TPW; q += 2) {
            EXU_LOAD(rb, xsb, q + 1);
            EXU_COMP(ra, xsa, q);
            if (q + 2 < TPW) EXU_LOAD(ra, xsa, q + 2);
            EXU_COMP(rb, xsb, q + 1);
        }
    }
#undef EXU_LOAD
#undef EXU_COMP
#pragma unroll 1
    for (int q0 = 0; q0 < TPW; q0 += 4) {
        float hv[4][2], us[4][2], vs[4][2], gt[4][2];
#pragma unroll
        for (int u = 0; u < 4; ++u) { const int tl = tl0 + q0 + u; const size_t t = (size_t)(tg0 + tl);
#pragma unroll
            for (int hlf = 0; hlf < 2; ++hlf) { const int k = hlf * 64 + lane; const int e = EL[tl * 128 + k];
                hv[u][hlf] = (float)HA[tl * 128 + k]; us[u][hlf] = USC[e]; vs[u][hlf] = VSC[e]; gt[u][hlf] = (float)__builtin_bit_cast(_Float16, GATE[t * 128 + k]); } }
#pragma unroll
        for (int u = 0; u < 4; ++u) { const int tl = tl0 + q0 + u; const float hs = HS[tl];
            float w2[2];
#pragma unroll
            for (int hlf = 0; hlf < 2; ++hlf) w2[hlf] = gt[u][hlf] * gelu_exact(hv[u][hlf] * (hs * us[u][hlf])) * vs[u][hlf];
            float wm = fmaxf(fabsf(w2[0]), fabsf(w2[1]));
#pragma unroll
            for (int o = 1; o < 64; o <<= 1) wm = fmaxf(wm, __shfl_xor(wm, o));
            const float wsc = wm > 0.f ? wm * (1.0f / 127.0f) : 1.0f, winv = 1.0f / wsc;
            LAS signed char* WQ = (LAS signed char*)(HA + tl * 128);
#pragma unroll
            for (int hlf = 0; hlf < 2; ++hlf) { const int i = hlf * 8 + (lane >> 3), gg = lane & 7;
                WQ[((i >> 2) * 8 + gg) * 4 + (i & 3)] = (signed char)(int)rintf(w2[hlf] * winv); }
            if (lane == 0) WSUM[tl] = wsc; }
    }
#define EXV_LOAD(R, XR, q_) do { const int tl_ = tl0 + (q_); XR = *(const unsigned*)(X1B + (size_t)(tg0 + tl_) * D + s * 128 + ch * 16 + 2 * g); \
        _Pragma("unroll") for (int i = 0; i < 16; ++i) { const int e_ = EL[tl_ * 128 + 8 * i + g]; R[i] = *(const u32x4*)(vsl + (unsigned)(e_ * 128 + ch * 16)); } } while (0)
#define EXV_LOADP(PK0, PK1, q_) do { const bf16_t* pr_ = x2tmp((size_t)(tg0 + tl0 + (q_))) + lane * 16; PK0 = *(const u32x4*)pr_; PK1 = *(const u32x4*)(pr_ + 8); } while (0)
#define EXV_COMP(R, XR, q_, FIN, PK0, PK1) do { const int tl_ = tl0 + (q_); const size_t t_ = (size_t)(tg0 + tl_); int acc[16]; \
        _Pragma("unroll") for (int a = 0; a < 4; ++a) { const int wd = HA[tl_ * 128 + a * 8 + g]; \
            _Pragma("unroll") for (int c4 = 0; c4 < 4; ++c4) { const unsigned x0 = R[4 * a][c4], x1 = R[4 * a + 1][c4], x2 = R[4 * a + 2][c4], x3 = R[4 * a + 3][c4]; \
                const unsigned p01l = __builtin_amdgcn_perm(x1, x0, 0x05010400u), p01h = __builtin_amdgcn_perm(x1, x0, 0x07030602u), p23l = __builtin_amdgcn_perm(x3, x2, 0x05010400u), p23h = __builtin_amdgcn_perm(x3, x2, 0x07030602u); \
                { const unsigned tb_ = __builtin_amdgcn_perm(p23l, p01l, 0x05040100u); acc[4 * c4 + 0] = (a == 0) ? dot4z(tb_, wd) : __builtin_amdgcn_sdot4((int)tb_, wd, acc[4 * c4 + 0], false); } \
                { const unsigned tb_ = __builtin_amdgcn_perm(p23l, p01l, 0x07060302u); acc[4 * c4 + 1] = (a == 0) ? dot4z(tb_, wd) : __builtin_amdgcn_sdot4((int)tb_, wd, acc[4 * c4 + 1], false); } \
                { const unsigned tb_ = __builtin_amdgcn_perm(p23h, p01h, 0x05040100u); acc[4 * c4 + 2] = (a == 0) ? dot4z(tb_, wd) : __builtin_amdgcn_sdot4((int)tb_, wd, acc[4 * c4 + 2], false); } \
                { const unsigned tb_ = __builtin_amdgcn_perm(p23h, p01h, 0x07060302u); acc[4 * c4 + 3] = (a == 0) ? dot4z(tb_, wd) : __builtin_amdgcn_sdot4((int)tb_, wd, acc[4 * c4 + 3], false); } } } \
        int r8[8], r4[4], r2[2]; \
        _Pragma("unroll") for (int j = 0; j < 8; ++j) { const int keep = b32 ? acc[8 + j] : acc[j], send = b32 ? acc[j] : acc[8 + j]; r8[j] = keep + __shfl_xor(send, 32); } \
        _Pragma("unroll") for (int j = 0; j < 4; ++j) { const int keep = b16 ? r8[4 + j] : r8[j], send = b16 ? r8[j] : r8[4 + j]; r4[j] = keep + __shfl_xor(send, 16); } \
        _Pragma("unroll") for (int j = 0; j < 2; ++j) { const int keep = b8 ? r4[2 + j] : r4[j], send = b8 ? r4[j] : r4[2 + j]; r2[j] = keep + __shfl_xor(send, 8); } \
        const size_t o_ = t_ * D + s * 128 + ch * 16 + 2 * g; const float wsc_ = WSUM[tl_];     \
        const unsigned xr_ = XR; \
        const float v0_ = bflo(xr_) + wsc_ * (float)r2[0], v1_ = bfhi(xr_) + wsc_ * (float)r2[1]; \
        float ss_ = v0_ * v0_ + v1_ * v1_; ss_ = wave_sum(ss_); \
        if (!(FIN)) { *(unsigned*)(x2tmp(t_) + s * 128 + ch * 16 + 2 * g) = pk2bf(v0_, v1_);     \
            if (lane == 0) SSQ[tl_] += ss_; } \
        else {     \
            const float rn_ = rsqrtf((SSQ[tl_] + ss_) * (1.0f / D) + RMS_EPS); float* orow_ = out + t_ * D; \
            *(f32x2*)(orow_ + s * 128 + ch * 16 + 2 * g) = (f32x2){v0_ * rn_ * g7a, v1_ * rn_ * g7b}; \
            if (lane < 56) { float* ol_ = orow_ + lane * 16; const u32x4 xa_ = PK0, xb_ = PK1; \
                *(f32x4*)(ol_) = (f32x4){bflo(xa_.x), bfhi(xa_.x), bflo(xa_.y), bfhi(xa_.y)} * rn_ * gn0; *(f32x4*)(ol_ + 4) = (f32x4){bflo(xa_.z), bfhi(xa_.z), bflo(xa_.w), bfhi(xa_.w)} * rn_ * gn1; \
                *(f32x4*)(ol_ + 8) = (f32x4){bflo(xb_.x), bfhi(xb_.x), bflo(xb_.y), bfhi(xb_.y)} * rn_ * gn2; *(f32x4*)(ol_ + 12) = (f32x4){bflo(xb_.z), bfhi(xb_.z), bflo(xb_.w), bfhi(xb_.w)} * rn_ * gn3; } } } while (0)
    const f32x4 gn0 = *(const f32x4*)(gfin + lane * 16), gn1 = *(const f32x4*)(gfin + lane * 16 + 4), gn2 = *(const f32x4*)(gfin + lane * 16 + 8), gn3 = *(const f32x4*)(gfin + lane * 16 + 12);
    const float g7a = gfin[7 * 128 + ch * 16 + 2 * g], g7b = gfin[7 * 128 + ch * 16 + 2 * g + 1];
    u32x4 pa0 = {0u, 0u, 0u, 0u}, pa1 = pa0, pb0 = pa0, pb1 = pa0;
#pragma unroll 1
    for (int s = 0; s < 7; ++s) {
        u32x4 ra[16], rb[16]; unsigned xra, xrb; const unsigned char* vsl = VQ + (size_t)s * (16384 * 128);
        EXV_LOAD(ra, xra, 0);
#pragma unroll 1
        for (int q = 0; q < TPW; q += 2) {
            EXV_LOAD(rb, xrb, q + 1);
            EXV_COMP(ra, xra, q, 0, pa0, pa1);
            if (q + 2 < TPW) EXV_LOAD(ra, xra, q + 2);
            EXV_COMP(rb, xrb, q + 1, 0, pb0, pb1);
        }
    }
    {
        constexpr int s = 7;
        u32x4 ra[16], rb[16]; unsigned xra, xrb; const unsigned char* vsl = VQ + (size_t)s * (16384 * 128);
        EXV_LOAD(ra, xra, 0); EXV_LOADP(pa0, pa1, 0);
#pragma unroll 1
        for (int q = 0; q < TPW; q += 2) {
            EXV_LOAD(rb, xrb, q + 1); EXV_LOADP(pb0, pb1, q + 1);
            EXV_COMP(ra, xra, q, 1, pa0, pa1);
            if (q + 2 < TPW) { EXV_LOAD(ra, xra, q + 2); EXV_LOADP(pa0, pa1, q + 2); }
            EXV_COMP(rb, xrb, q + 1, 1, pb0, pb1);
        }
    }
#undef EXV_LOAD
#undef EXV_LOADP
#undef EXV_COMP
    asm volatile("s_waitcnt vmcnt(0) lgkmcnt(0)" ::: "memory");
}

#if DBG
constexpr int SSM_CH = 256, SSM_GROUPS = 16, SSM_STATE = 64, SSM_GROUP = 16;
constexpr int PEER_HEADS = 8, PEER_KEYS = 128, PEER_HALF = 128, PEER_TOPK = 16, PEER_QD = 2048;
__device__ __forceinline__ float sigm_n(float v) { return 1.0f / (1.0f + expf(-v)); }
__global__ void __launch_bounds__(256) ngemm(const float* __restrict__ A, int lda, const float* __restrict__ B, int ldb,
                                             float* __restrict__ C, int ldc, int M, int N, int K) {
    __shared__ float As[16][64 + 4];
    __shared__ float Bs[16][64 + 4];
    const int tx = threadIdx.x & 15, ty = threadIdx.x >> 4;
    const int bm = blockIdx.y * 64, bn = blockIdx.x * 64;
    float acc[4][4] = {};
    for (int k0 = 0; k0 < K; k0 += 16) {
        {
            const int r = threadIdx.x >> 2, c4 = (threadIdx.x & 3) * 4;
            const float4 v = *(const float4*)(A + (size_t)(bm + r) * lda + k0 + c4);
            As[c4 + 0][r] = v.x; As[c4 + 1][r] = v.y; As[c4 + 2][r] = v.z; As[c4 + 3][r] = v.w;
            const int rb = threadIdx.x >> 4, cb4 = (threadIdx.x & 15) * 4;
            const float4 w = *(const float4*)(B + (size_t)(k0 + rb) * ldb + bn + cb4);
            Bs[rb][cb4 + 0] = w.x; Bs[rb][cb4 + 1] = w.y; Bs[rb][cb4 + 2] = w.z; Bs[rb][cb4 + 3] = w.w;
        }
        __syncthreads();
#pragma unroll
        for (int k = 0; k < 16; ++k) {
            float a[4], b[4];
#pragma unroll
            for (int i = 0; i < 4; ++i) a[i] = As[k][ty * 4 + i];
#pragma unroll
            for (int j = 0; j < 4; ++j) b[j] = Bs[k][tx * 4 + j];
#pragma unroll
            for (int i = 0; i < 4; ++i)
#pragma unroll
                for (int j = 0; j < 4; ++j) acc[i][j] = fmaf(a[i], b[j], acc[i][j]);
        }
        __syncthreads();
    }
#pragma unroll
    for (int i = 0; i < 4; ++i) {
        float4 o = make_float4(acc[i][0], acc[i][1], acc[i][2], acc[i][3]);
        *(float4*)(C + (size_t)(bm + ty * 4 + i) * ldc + bn + tx * 4) = o;
    }
}

__global__ void __launch_bounds__(256) n_rmsnorm(const float* __restrict__ x, const float* __restrict__ g, float* __restrict__ y) {
    __shared__ float red[4];
    const size_t row = blockIdx.x;
    const float4 v = *(const float4*)(x + row * D + threadIdx.x * 4);
    float s = v.x * v.x + v.y * v.y + v.z * v.z + v.w * v.w;
    for (int o = 32; o > 0; o >>= 1) s += __shfl_xor(s, o);
    if ((threadIdx.x & 63) == 0) red[threadIdx.x >> 6] = s;
    __syncthreads();
    const float tot = red[0] + red[1] + red[2] + red[3];
    const float r = rsqrtf(tot * (1.0f / D) + RMS_EPS);
    const float4 gg = *(const float4*)(g + threadIdx.x * 4);
    float4 o = make_float4(v.x * r * gg.x, v.y * r * gg.y, v.z * r * gg.z, v.w * r * gg.w);
    *(float4*)(y + row * D + threadIdx.x * 4) = o;
}

__global__ void __launch_bounds__(256) n_conv(const float* __restrict__ proj, const float* __restrict__ cw, const float* __restrict__ cbias,
                                              float* __restrict__ am, int S) {
    const size_t i = (size_t)blockIdx.x * 256 + threadIdx.x;
    const int t = (int)(i / CONV_CH), j = (int)(i % CONV_CH);
    if (t >= S) return;
    const float* pr = proj + (size_t)t * IN_COLS;
    float y = cbias[j];
#pragma unroll
    for (int k = 0; k < 3; ++k) {
        const int tt = t - 2 + k;
        if (tt >= 0) { const float* q = proj + (size_t)tt * IN_COLS; y += cw[k * CONV_CH + j] * (q[CONV_CH + j] * q[2 * CONV_CH + j]); }
    }
    am[(size_t)t * CONV_CH + j] = pr[j] * y;
}

__global__ void n_ssm_const(const float* lam_re, const float* lam_im, const float* log_dt, float* cst) {
    const int i = blockIdx.x * blockDim.x + threadIdx.x;
    if (i >= 1024) return;
    const int g = i >> 6;
    const float lr = lam_re[i], li = lam_im[i], dt = expf(log_dt[g]);
    const float mag = expf(lr * dt), ang = li * dt;
    const float ar = mag * cosf(ang), ai = mag * sinf(ang);
    const float den = lr * lr + li * li, nr = ar - 1.0f, ni = ai;
    cst[i] = ar; cst[1024 + i] = ai; cst[2048 + i] = (nr * lr + ni * li) / den; cst[3072 + i] = (ni * lr - nr * li) / den;
}
__global__ void __launch_bounds__(256) n_ssm_x(const float* __restrict__ proj, const float* __restrict__ bre, const float* __restrict__ bim,
                                               const float* __restrict__ cst, float* __restrict__ xr, float* __restrict__ xi, int S) {
    const size_t i = (size_t)blockIdx.x * 256 + threadIdx.x;
    const int t = (int)(i >> 10), gp = (int)(i & 1023), g = gp >> 6;
    if (t >= S) return;
    const float* u = proj + (size_t)t * IN_COLS + 3 * CONV_CH + g * 16;
    float br = 0.f, bi = 0.f;
#pragma unroll
    for (int h = 0; h < 16; ++h) { br = fmaf(u[h], bre[gp * 16 + h], br); bi = fmaf(u[h], bim[gp * 16 + h], bi); }
    const float kr = cst[2048 + gp], ki = cst[3072 + gp];
    xr[i] = kr * br - ki * bi; xi[i] = kr * bi + ki * br;
}
__global__ void __launch_bounds__(256) n_ssm_scan(const float* __restrict__ cst, float* __restrict__ xr, float* __restrict__ xi, int S) {
    const int gp = blockIdx.x * 256 + threadIdx.x;
    const float ar = cst[gp], ai = cst[1024 + gp];
    float sr = 0.f, si = 0.f;
    for (int t = 0; t < S; ++t) {
        const size_t o = (size_t)t * 1024 + gp;
        const float a = xr[o], b = xi[o];
        const float nr = ar * sr - ai * si + a, ni = ar * si + ai * sr + b;
        sr = nr; si = ni; xr[o] = sr; xi[o] = si;
    }
}
__global__ void __launch_bounds__(256) n_ssm_y(const float* __restrict__ proj, const float* __restrict__ sr, const float* __restrict__ si,
                                               const float* __restrict__ cre, const float* __restrict__ cim, const float* __restrict__ dsk,
                                               float* __restrict__ z, int S) {
    const size_t i = (size_t)blockIdx.x * 256 + threadIdx.x;
    const int t = (int)(i >> 8), c = (int)(i & 255), g = c >> 4;
    if (t >= S) return;
    const float* a = sr + (size_t)t * 1024 + g * 64; const float* b = si + (size_t)t * 1024 + g * 64;
    float y = 0.f;
    for (int p = 0; p < 64; ++p) y += a[p] * cre[c * 64 + p] - b[p] * cim[c * 64 + p];
    y += dsk[c] * proj[(size_t)t * IN_COLS + 3 * CONV_CH + c];
    z[i] = gelu_exact(y);
}
__global__ void __launch_bounds__(256) n_glu(const float* __restrict__ z, const float* __restrict__ lin, const float* __restrict__ bglu, float* __restrict__ o, size_t n) {
    const size_t i = (size_t)blockIdx.x * 256 + threadIdx.x; if (i >= n) return;
    o[i] = z[i] * sigm_n(lin[i] + bglu[i & 255]);
}
__global__ void __launch_bounds__(256) n_merge(const float* __restrict__ proj, const float* __restrict__ bg, const float* __restrict__ ya,
                                               const float* __restrict__ yb, float* __restrict__ m, size_t n) {
    const size_t i = (size_t)blockIdx.x * 256 + threadIdx.x; if (i >= n) return;
    const size_t t = i >> 10; const int d = (int)(i & 1023);
    const float* gl = proj + t * IN_COLS + 3 * CONV_CH + SSM_CH;
    m[i] = sigm_n(gl[d] + bg[d]) * ya[i] + sigm_n(gl[D + d] + bg[D + d]) * yb[i];
}
__global__ void __launch_bounds__(256) n_add(const float* __restrict__ a, float* __restrict__ b, size_t n) {
    const size_t i = (size_t)blockIdx.x * 256 + threadIdx.x; if (i >= n) return; b[i] += a[i];
}

__device__ __forceinline__ void wave_argmax(float& v, int& idx) {
    for (int o = 32; o > 0; o >>= 1) {
        const float ov = __shfl_xor(v, o); const int oi = __shfl_xor(idx, o);
        if (ov > v || (ov == v && oi < idx)) { v = ov; idx = oi; }
    }
}
__global__ void __launch_bounds__(256) n_route(const float* __restrict__ q, const float* __restrict__ k1, const float* __restrict__ k2,
                                               int* __restrict__ eidx, float* __restrict__ gate) {
    __shared__ float qs[PEER_QD];
    __shared__ float sc[PEER_QD];
    __shared__ float tv[16][16]; __shared__ int ti[16][16];
    const size_t t = blockIdx.x; const int tid = threadIdx.x, lane = tid & 63, w = tid >> 6;
    for (int i = tid; i < PEER_QD; i += 256) qs[i] = q[t * PEER_QD + i];
    __syncthreads();
    for (int i = tid; i < PEER_QD; i += 256) {
        const int hs = i >> 7, n = i & 127, side = hs & 1;
        const float* kk = (side ? k2 : k1) + n * PEER_HALF; const float* qq = qs + hs * 128;
        float s = 0.f;
        for (int k = 0; k < 128; ++k) s = fmaf(qq[k], kk[k], s);
        sc[i] = s;
    }
    __syncthreads();
    for (int gi = 0; gi < 4; ++gi) {
        const int grp = w * 4 + gi;
        float a0 = sc[grp * 128 + lane], a1 = sc[grp * 128 + 64 + lane];
        for (int it = 0; it < 16; ++it) {
            float v; int idx;
            if (a0 >= a1) { v = a0; idx = lane; } else { v = a1; idx = lane + 64; }
            wave_argmax(v, idx);
            if (lane == 0) { tv[grp][it] = v; ti[grp][it] = idx; }
            if (idx == lane) a0 = -INFINITY; if (idx == lane + 64) a1 = -INFINITY;
        }
    }
    __syncthreads();
    for (int hh = 0; hh < 2; ++hh) {
        const int h = w * 2 + hh;
        float c[4]; int ci[4];
#pragma unroll
        for (int j = 0; j < 4; ++j) { const int pos = j * 64 + lane, a = pos >> 4, b = pos & 15; c[j] = tv[2 * h][a] + tv[2 * h + 1][b]; ci[j] = pos; }
        float bestv = 0.f; int beste = 0; float mx = 0.f;
        for (int it = 0; it < 16; ++it) {
            float v = c[0]; int idx = ci[0];
#pragma unroll
            for (int j = 1; j < 4; ++j) if (c[j] > v) { v = c[j]; idx = ci[j]; }
            wave_argmax(v, idx);
#pragma unroll
            for (int j = 0; j < 4; ++j) if (ci[j] == idx) c[j] = -INFINITY;
            if (it == 0) mx = v;
            if (lane == it) { bestv = v; beste = ti[2 * h][idx >> 4] * PEER_KEYS + ti[2 * h + 1][idx & 15]; }
        }
        float e = (lane < 16) ? expf(bestv - mx) : 0.f;
        float s = e; for (int o = 32; o > 0; o >>= 1) s += __shfl_xor(s, o);
        if (lane < 16) { eidx[t * 128 + h * 16 + lane] = beste; gate[t * 128 + h * 16 + lane] = e / s; }
    }
}

__global__ void __launch_bounds__(256) n_expert(const float* __restrict__ xn, const float* __restrict__ x1, const int* __restrict__ eidx,
                                                const float* __restrict__ gate, const float* __restrict__ eu, const float* __restrict__ ev,
                                                const float* __restrict__ gfin, float* __restrict__ out) {
    const size_t t = (size_t)blockIdx.x * 4 + (threadIdx.x >> 6); const int lane = threadIdx.x & 63;
    float4 xv[4], acc[4];
#pragma unroll
    for (int i = 0; i < 4; ++i) { xv[i] = *(const float4*)(xn + t * D + i * 256 + lane * 4); acc[i] = make_float4(0.f, 0.f, 0.f, 0.f); }
    for (int k = 0; k < 128; ++k) {
        const int e = eidx[t * 128 + k]; const float gt = gate[t * 128 + k];
        const float* ur = eu + (size_t)e * D; const float* vr = ev + (size_t)e * D;
        float s = 0.f;
#pragma unroll
        for (int i = 0; i < 4; ++i) { const float4 u = *(const float4*)(ur + i * 256 + lane * 4); s += u.x * xv[i].x + u.y * xv[i].y + u.z * xv[i].z + u.w * xv[i].w; }
        for (int o = 32; o > 0; o >>= 1) s += __shfl_xor(s, o);
        const float wgt = gt * gelu_exact(s);
#pragma unroll
        for (int i = 0; i < 4; ++i) { const float4 v = *(const float4*)(vr + i * 256 + lane * 4);
            acc[i].x = fmaf(wgt, v.x, acc[i].x); acc[i].y = fmaf(wgt, v.y, acc[i].y); acc[i].z = fmaf(wgt, v.z, acc[i].z); acc[i].w = fmaf(wgt, v.w, acc[i].w); }
    }
    float ss = 0.f;
#pragma unroll
    for (int i = 0; i < 4; ++i) { const float4 r = *(const float4*)(x1 + t * D + i * 256 + lane * 4);
        acc[i].x += r.x; acc[i].y += r.y; acc[i].z += r.z; acc[i].w += r.w;
        ss += acc[i].x * acc[i].x + acc[i].y * acc[i].y + acc[i].z * acc[i].z + acc[i].w * acc[i].w; }
    for (int o = 32; o > 0; o >>= 1) ss += __shfl_xor(ss, o);
    const float r = rsqrtf(ss * (1.0f / D) + RMS_EPS);
#pragma unroll
    for (int i = 0; i < 4; ++i) { const float4 g = *(const float4*)(gfin + i * 256 + lane * 4);
        *(float4*)(out + t * D + i * 256 + lane * 4) = make_float4(acc[i].x * r * g.x, acc[i].y * r * g.y, acc[i].z * r * g.z, acc[i].w * r * g.w); }
}


__device__ __forceinline__ float bf_at(const bf16_t* p, size_t i) { return __uint_as_float(((unsigned)p[i]) << 16); }
template <class F> __device__ __forceinline__ void dbg_cmp(unsigned char* ws, int id, int rows, int cols, F f) {
    float e2 = 0.f, r2 = 0.f;
    const size_t n = (size_t)rows * cols;
    int tid = threadIdx.x; asm volatile("" : "+v"(tid));
    for (size_t i = (size_t)blockIdx.x * NTHR + tid; i < n; i += (size_t)NBLK * NTHR) { float a, b; f((int)(i / cols), (int)(i % cols), a, b); e2 += (a - b) * (a - b); r2 += b * b; }
    e2 = wave_sum(e2); r2 = wave_sum(r2);
    if ((tid & 63) == 0) { atomicAdd((float*)(ws + DB_ACC) + id * 2, e2); atomicAdd((float*)(ws + DB_ACC) + id * 2 + 1, r2); }
}
__global__ void dbg_report(const float* acc, float* out, int n, int first_id) {
    float c = 0.f;
    for (int id = first_id; id < 32; ++id) { const float e2 = acc[id * 2], r2 = acc[id * 2 + 1]; if (r2 <= 0.f) continue; const float rel = sqrtf(e2 / r2);
        const float thr = id == 12 ? 0.22f : id == 13 ? 0.1f : DBG_THR;
        if (rel > thr || !(rel == rel)) { int d = (rel == rel) ? (int)(-4.0f * log10f(fminf(rel, 1.0f)) + 0.5f) : 9; if (d > 9) d = 9; c = sqrtf((float)(id * 10 + d) - 1.0f); break; } }
    for (int i = blockIdx.x * blockDim.x + threadIdx.x; i < n; i += gridDim.x * blockDim.x) out[i] = c;
}
#endif
__global__ void __launch_bounds__(512, 2) fwd_megakernel(Params p) {
    extern __shared__ __attribute__((aligned(16))) unsigned char smem[];
    LAS unsigned char* lds = (LAS unsigned char*)smem;
    unsigned char* ws = p.ws;
    volatile LAS unsigned* bst = (volatile LAS unsigned*)(lds + LDS_MISC);
    if (threadIdx.x < 4) bst[threadIdx.x] = 0u;
    *(LAS f32x4*)(lds + LDS_GBIAS + threadIdx.x * 16) = *(const f32x4*)(p.in[3] + threadIdx.x * 4);
    __syncthreads();
    XcdBarrier bar = xcd_barrier_post((unsigned*)(ws + WS_CTL), bst);
    Order S;
    TSTAMP(0);
    for (int rep_ah = 0; rep_ah < REP_AH; ++rep_ah) {
    for (int rp_ = 0; rp_ < (REP_PH == 1 ? 2 : 1); ++rp_) {
    phase_prologue(p, lds, rp_ ? SKIPA : 0);
    xcd_barrier(bar); TSTAMP(1);
    }
    for (int rp_ = 0; rp_ < (REP_PH == 2 ? 2 : 1); ++rp_) {
    { Gemm g{(const bf16_t*)(ws + WS_XB), (const bf16_t*)(ws + WS_WIN), 1024, 1024, 1024, 0, 0}; S.init(T, IN_COLS, 1, 0);
      EpiG1 e{(const LAS float*)(lds + LDS_GBIAS), (bf16_t*)(ws + WS_CB), (bf16_t*)(ws + WS_V), (bf16_t*)(ws + WS_SU), ws + WS_G};
      if (NULLG1 == 1 && rp_) { EpiNull en; gemm_phase(lds, g, S, en); } else if (NULLG1 == 2 && rp_) { EpiG1T<true> en{(const LAS float*)(lds + LDS_GBIAS), nullptr, nullptr, nullptr, nullptr}; gemm_phase(lds, g, S, en); } else
      gemm_phase(lds, g, S, e); }
    xcd_barrier(bar); TSTAMP(2);
    DBGC({ const float* pj = (const float*)(ws + DB_PROJ); const float* bg = p.in[3];
      const bf16_t* CBp = (const bf16_t*)(ws + WS_CB); const bf16_t* Vp = (const bf16_t*)(ws + WS_V); const bf16_t* SUp = (const bf16_t*)(ws + WS_SU); const bf16_t* Gp = (const bf16_t*)(ws + WS_G);
      dbg_cmp(ws, 1, NB, 768, [=](int t, int c, float& a, float& b) { a = bf_at(CBp, (size_t)t * 768 + c); b = pj[(size_t)t * IN_COLS + c]; });
      dbg_cmp(ws, 2, NB, 768, [=](int t, int c, float& a, float& b) { a = bf_at(Vp, (size_t)t * 768 + c); b = pj[(size_t)t * IN_COLS + 768 + c] * pj[(size_t)t * IN_COLS + 1536 + c]; });
      dbg_cmp(ws, 3, NB, 256, [=](int t, int c, float& a, float& b) { a = bf_at(SUp, ((size_t)(c >> 4) * NCHUNK + (t >> LOGCL)) * SUK + (t & (CL - 1)) * 16 + (c & 15)); b = pj[(size_t)t * IN_COLS + 2304 + c]; });
      dbg_cmp(ws, 4, NB, 2048, [=](int t, int c, float& a, float& b) { a = bf_at(Gp, (size_t)t * 2048 + c); b = sigm_n(pj[(size_t)t * IN_COLS + 2560 + c] + bg[c]); }); })
    }
    for (int rp_ = 0; rp_ < (REP_PH == 3 ? 2 : 1); ++rp_) {
    phase_conv_my(p, 16 * (NCHUNK / BM));
    { Gemm g{(const bf16_t*)(ws + WS_SU), (const bf16_t*)(ws + WS_MEND), SUK, CK, CK, (long)NCHUNK * SUK, (long)256 * CK}; S.init(NCHUNK, 256, 16, 0); S.window(0, S.u1, 0, 16 * (NCHUNK / BM));
      EpiE e{(float*)(ws + WS_E)}; gemm_phase(lds, g, S, e); }
    xcd_barrier(bar); TSTAMP(3);
    DBGC({ const bf16_t* A2p = (const bf16_t*)(ws + WS_A2); const float* am = (const float*)(ws + DB_AM);
      dbg_cmp(ws, 5, NB, 768, [=](int t, int c, float& a, float& b) { a = bf_at(A2p, (size_t)t * 768 + c); b = am[(size_t)t * 768 + c]; }); })
    }
    for (int rp_ = 0; rp_ < (REP_PH == 4 ? 2 : 1); ++rp_) {
    phase_carry(p);
    { Gemm g{(const bf16_t*)(ws + WS_A2), (const bf16_t*)(ws + WS_WA), 768, 768, 768, 0, 0}; S.init(T, 1024, 1, 0); S.window(0, S.u1 / 2, 0, NBLK);
      EpiP e{ws + WS_G, (bf16_t*)(ws + WS_P)}; gemm_phase(lds, g, S, e); }
    xcd_barrier(bar); TSTAMP(4);
    }
    for (int rp_ = 0; rp_ < (REP_PH == 5 ? 2 : 1); ++rp_) {
    { Gemm g{(const bf16_t*)(ws + WS_SU), (const bf16_t*)(ws + WS_MY), SUK, SUK, SUK, (long)NCHUNK * SUK, (long)CK * SUK}; S.init(NCHUNK, CK, 16, 0); S.window(0, S.u1, 0, NBLK / 2);
      EpiY e{(const bf16_t*)(ws + WS_SU), p.in[13], (bf16_t*)(ws + WS_Z)}; gemm_phase(lds, g, S, e); }
    { Gemm g{(const bf16_t*)(ws + WS_A2), (const bf16_t*)(ws + WS_WA), 768, 768, 768, 0, 0}; S.init(T, 1024, 1, 0); S.window(S.u1 / 2, S.u1, NBLK / 2, NBLK / 2);
      EpiP e{ws + WS_G, (bf16_t*)(ws + WS_P)}; gemm_phase(lds, g, S, e); }
    xcd_barrier(bar); TSTAMP(5);
    DBGC({ const bf16_t* Pp = (const bf16_t*)(ws + WS_P); const float* ya = (const float*)(ws + DB_YA); const float* pj = (const float*)(ws + DB_PROJ); const float* bg = p.in[3];
      dbg_cmp(ws, 6, NB, 1024, [=](int t, int c, float& a, float& b) { a = bf_at(Pp, (size_t)t * 1024 + c); b = ya[(size_t)t * 1024 + c] * sigm_n(pj[(size_t)t * IN_COLS + 2560 + c] + bg[c]); }); })
    DBGC({ const bf16_t* Zp = (const bf16_t*)(ws + WS_Z); const float* zn = (const float*)(ws + DB_Z);
      dbg_cmp(ws, 7, NB, 256, [=](int t, int c, float& a, float& b) { a = bf_at(Zp, (size_t)t * 256 + c); b = zn[(size_t)t * 256 + c]; }); })
    }
    for (int rp_ = 0; rp_ < (REP_PH == 6 ? 2 : 1); ++rp_) {
    { Gemm g{(const bf16_t*)(ws + WS_Z), (const bf16_t*)(ws + WS_WGLU), 256, 256, 256, 0, 0}; S.init(T, 256, 1, 0);
      EpiGlu e{(const bf16_t*)(ws + WS_Z), p.in[15], (bf16_t*)(ws + WS_S5)}; gemm_phase(lds, g, S, e); }
    xcd_barrier(bar); TSTAMP(6);
    DBGC({ const bf16_t* Sp = (const bf16_t*)(ws + WS_S5); const float* sn = (const float*)(ws + DB_S5);
      dbg_cmp(ws, 8, NB, 256, [=](int t, int c, float& a, float& b) { a = bf_at(Sp, (size_t)t * 256 + c); b = sn[(size_t)t * 256 + c]; }); })
    }
    for (int rp_ = 0; rp_ < (REP_PH == 7 ? 2 : 1); ++rp_) {
    { Gemm g{(const bf16_t*)(ws + WS_S5), (const bf16_t*)(ws + WS_WB), 256, 256, 256, 0, 0}; S.init(T, 1024, 1, 0);
      EpiMerge e{ws + WS_G, (const bf16_t*)(ws + WS_P), (bf16_t*)(ws + WS_MG)}; gemm_phase(lds, g, S, e); }
    xcd_barrier(bar); TSTAMP(7);
    DBGC({ const bf16_t* Mp = (const bf16_t*)(ws + WS_MG); const float* mn = (const float*)(ws + DB_MG);
      dbg_cmp(ws, 9, NB, 1024, [=](int t, int c, float& a, float& b) { a = bf_at(Mp, (size_t)t * 1024 + c); b = mn[(size_t)t * 1024 + c]; }); })
    }
    for (int rp_ = 0; rp_ < (REP_PH == 8 ? 2 : 1); ++rp_) {
    { Gemm g{(const bf16_t*)(ws + WS_MG), (const bf16_t*)(ws + WS_WOUT), 1024, 1024, 1024, 0, 0}; S.init(T, 1024, 1, 0);
      EpiX1 e{(const float*)(ws + WS_RINV), (bf16_t*)(ws + WS_X1B), (float*)(ws + WS_RS2P)}; gemm_phase(lds, g, S, e); }
    xcd_barrier(bar); TSTAMP(8);
    DBGC({ const bf16_t* Xp = (const bf16_t*)(ws + WS_X1B); const float* xn1 = (const float*)(ws + DB_X1);
      dbg_cmp(ws, 10, NB, 1024, [=](int t, int c, float& a, float& b) { a = bf_at(Xp, (size_t)t * 1024 + c); b = xn1[(size_t)t * 1024 + c]; }); })
    }
    }
    for (int hh = 0; hh < REP_I; ++hh) {
        { Gemm g{(const bf16_t*)(ws + WS_X1B), (const bf16_t*)(ws + WS_WS), 1024, 1024, 1024, 0, 0}; S.init(T, 2048, 1, 0);
          EpiSC e{(unsigned short*)(ws + WS_SC)}; gemm_phase(lds, g, S, e); }
        xcd_barrier(bar); TSTAMP(9);
    }
    DBGC({ const float* SCp = (const float*)(ws + WS_SC); const float* qn = (const float*)(ws + DB_Q); const float* RSp = (const float*)(ws + WS_RS2P); const float* kk1 = p.in[21]; const float* kk2 = p.in[22];
          dbg_cmp(ws, 11, NB, 2048, [=](int t, int c, float& a, float& b) { float ss = 0.f; for (int i = 0; i < 16; ++i) ss += RSp[(size_t)t * 16 + i];
            a = SCp[(size_t)t * 2048 + c] * rsqrtf(ss * (1.0f / D) + RMS_EPS); const int hs = c >> 7, j = c & 127; const float* kp = ((hs & 1) ? kk2 : kk1) + j * 128; const float* qq = qn + (size_t)t * 2048 + hs * 128;
            float sr = 0.f; for (int k = 0; k < 128; ++k) sr += qq[k] * kp[k]; b = sr; }); })
    for (int rep = 0; rep < REP_J; ++rep) { for (int rtk = 0; rtk < REP_TK; ++rtk) phase_topk(p, lds); asm volatile("s_waitcnt vmcnt(0) lgkmcnt(0)" ::: "memory"); __syncthreads();     phase_expert(p, lds); __syncthreads(); }
#if TIMING
    xcd_barrier(bar); TSTAMP(13);
    xcd_barrier(bar);
    { const unsigned long long* ts = (const unsigned long long*)(p.ws + WS_RSTD1 - 1024);
      const float ua = (float)(ts[TIME_A] - ts[TIME_A - 1]) * 0.01f, ub = (float)(ts[TIME_B] - ts[TIME_B - 1]) * 0.01f;
      const float c = sqrtf(ua);
      for (size_t i = (size_t)blockIdx.x * NTHR + threadIdx.x; i < (size_t)T * D; i += (size_t)NBLK * NTHR) p.out[i] = (i == 0) ? ub : c; }
#endif
    DBGC(xcd_barrier(bar); { const float* On = (const float*)(ws + DB_OUT); const float* Op = p.out;
      { const int* Ep = (const int*)(ws + WS_EIDX); const int* En = (const int*)(ws + DB_EIDX); const float* Gp2 = (const float*)(ws + WS_GATE); const float* Gn = (const float*)(ws + DB_GATE);
          dbg_cmp(ws, 12, NB, 128, [=](int t, int c, float& a, float& b) { const int e = Ep[(size_t)t * 128 + c]; const int* nn = En + (size_t)t * 128 + (c & ~15); int f = 0; for (int k = 0; k < 16; ++k) f |= (nn[k] == e); a = f ? 1.f : 0.f; b = 1.f; });
          dbg_cmp(ws, 13, NB, 128, [=](int t, int c, float& a, float& b) { const int e = Ep[(size_t)t * 128 + c]; const int* nn = En + (size_t)t * 128 + (c & ~15); a = Gp2[(size_t)t * 128 + c]; b = a; for (int k = 0; k < 16; ++k) if (nn[k] == e) b = Gn[(size_t)t * 128 + (c & ~15) + k]; }); }
      dbg_cmp(ws, 14, NB, 1024, [=](int t, int c, float& a, float& b) { a = Op[(size_t)t * 1024 + c]; b = On[(size_t)t * 1024 + c]; }); })
}
}

extern "C" void kernel_launch(void* const* d_in, const int* in_sizes, int n_in, void* d_out, int out_size, void* d_ws, size_t ws_size, hipStream_t stream) {
    static int ready = 0;
    if (ready == 0) {
        if (n_in != 26 || out_size != 32768 * D || ws_size < WS_END) { fprintf(stderr, "kernel_launch: unexpected shapes (n_in %d out %d ws %zu need %zu)\n", n_in, out_size, ws_size, (size_t)WS_END); ready = -1; return; }
        if (hipFuncSetAttribute((const void*)fwd_megakernel, hipFuncAttributeMaxDynamicSharedMemorySize, LDS_BYTES) != hipSuccess) { fprintf(stderr, "kernel_launch: hipFuncSetAttribute failed\n"); ready = -1; return; }
        ready = 1;
    }
    if (ready < 0) return;
    (void)hipMemsetAsync((char*)d_ws + WS_CTL, 0, 65536, stream);
#if DBG
    {
        char* wsb = (char*)d_ws; const int S = NB;
        const float* x = (const float*)d_in[0];
        float* cst = (float*)(wsb + DB_CST); float* hn = (float*)(wsb + DB_HN); float* proj = (float*)(wsb + DB_PROJ); float* am = (float*)(wsb + DB_AM); float* ya = (float*)(wsb + DB_YA);
        float* xr = (float*)(wsb + DB_XR); float* xi = (float*)(wsb + DB_XI); float* z = (float*)(wsb + DB_Z); float* lin = (float*)(wsb + DB_LIN); float* s5 = (float*)(wsb + DB_S5);
        float* yb = (float*)(wsb + DB_YB); float* merged = (float*)(wsb + DB_MG); float* x1 = (float*)(wsb + DB_X1); float* xn = (float*)(wsb + DB_XN); float* q = (float*)(wsb + DB_Q);
        int* eidx = (int*)(wsb + DB_EIDX); float* gate = (float*)(wsb + DB_GATE); float* outn = (float*)(wsb + DB_OUT);
        auto F = [&](int i) { return (const float*)d_in[i]; };
        auto gemm = [&](const float* A, int lda, const float* B, int ldb, float* C, int ldc, int M, int N, int K) { ngemm<<<dim3(N / 64, M / 64), 256, 0, stream>>>(A, lda, B, ldb, C, ldc, M, N, K); };
        (void)hipMemsetAsync(wsb + DB_ACC, 0, 4096, stream);
        n_ssm_const<<<4, 256, 0, stream>>>(F(6), F(7), F(8), cst);
        n_rmsnorm<<<S, 256, 0, stream>>>(x, F(1), hn);
        gemm(hn, D, F(2), IN_COLS, proj, IN_COLS, S, IN_COLS, D);
        n_conv<<<(S * CONV_CH) / 256, 256, 0, stream>>>(proj, F(4), F(5), am, S);
        gemm(am, CONV_CH, F(16), D, ya, D, S, D, CONV_CH);
        n_ssm_x<<<(S * 1024) / 256, 256, 0, stream>>>(proj, F(9), F(10), cst, xr, xi, S);
        n_ssm_scan<<<4, 256, 0, stream>>>(cst, xr, xi, S);
        n_ssm_y<<<(S * 256) / 256, 256, 0, stream>>>(proj, xr, xi, F(11), F(12), F(13), z, S);
        gemm(z, 256, F(14), 256, lin, 256, S, 256, 256);
        n_glu<<<(S * 256) / 256, 256, 0, stream>>>(z, lin, F(15), s5, (size_t)S * 256);
        gemm(s5, 256, F(17), D, yb, D, S, D, 256);
        n_merge<<<(S * D) / 256, 256, 0, stream>>>(proj, F(3), ya, yb, merged, (size_t)S * D);
        gemm(merged, D, F(18), D, x1, D, S, D, D);
        n_add<<<(S * D) / 256, 256, 0, stream>>>(x, x1, (size_t)S * D);
        n_rmsnorm<<<S, 256, 0, stream>>>(x1, F(19), xn);
        gemm(xn, D, F(20), PEER_QD, q, PEER_QD, S, PEER_QD, D);
        n_route<<<S, 256, 0, stream>>>(q, F(21), F(22), eidx, gate);
        n_expert<<<S / 4, 256, 0, stream>>>(xn, x1, eidx, gate, F(23), F(24), F(25), outn);
    }
#endif
    Params p{};
    for (int i = 0; i < 26; ++i) p.in[i] = (const float*)d_in[i];
    p.out = (float*)d_out; p.ws = (unsigned char*)d_ws;
    hipLaunchKernelGGL(fwd_megakernel, dim3(NBLK), dim3(NTHR), LDS_BYTES, stream, p);
#if DBG
    dbg_report<<<1024, 256, 0, stream>>>((const float*)((char*)d_ws + DB_ACC), (float*)d_out, out_size, DBG_FIRST);
#endif
}
```

```cpp
#include <hip/hip_runtime.h>
#include <cstdint>
#include <cstddef>
#include <cstdio>

#define LAS __attribute__((address_space(3)))
#ifndef DBG
#define DBG 0
#endif
#ifndef TIMING
#define TIMING 0
#endif
#ifndef REP_J
#define REP_J 1
#endif
#ifndef REP_AH
#define REP_AH 1
#endif
#ifndef REP_I
#define REP_I 1
#endif
#ifndef REP_PH
#define REP_PH 0
#endif
#ifndef NULLG1
#define NULLG1 0
#endif
#ifndef SKIPA
#define SKIPA 0
#endif
#ifndef REP_TK
#define REP_TK 1
#endif
#ifndef TIME_A
#define TIME_A 13
#endif
#ifndef TIME_B
#define TIME_B 2
#endif
#ifndef DBG_THR
#define DBG_THR 0.03f
#endif
#ifndef DBG_FIRST
#define DBG_FIRST 1
#endif
#if TIMING
#define TSTAMP(k) do { if (blockIdx.x == 0 && threadIdx.x == 0) ((unsigned long long*)(p.ws + WS_RSTD1 - 1024))[k] = __builtin_amdgcn_s_memrealtime(); } while (0)
#else
#define TSTAMP(k)
#endif
#if DBG
#define DBGC(...) __VA_ARGS__
#else
#define DBGC(...)
#endif
namespace {
typedef unsigned short bf16_t;
typedef short bf16x8 __attribute__((ext_vector_type(8)));
typedef float f32x4 __attribute__((ext_vector_type(4)));
typedef unsigned u32x4 __attribute__((ext_vector_type(4)));
typedef unsigned u32x2 __attribute__((ext_vector_type(2)));
typedef float f32x2 __attribute__((ext_vector_type(2)));
typedef _Float16 h2 __attribute__((ext_vector_type(2)));

constexpr int D = 1024, T = DBG ? 16384 : 32768, SEQ = 8192;
constexpr int CONV_CH = 768, IN_COLS = 4608;
constexpr float RMS_EPS = 1e-6f;
constexpr int NBLK = 256, NTHR = 512, NWAVE = 8, NGW = NBLK * NWAVE;
constexpr int CL = 32, LOGCL = 5, CK = CL * 16;
constexpr int SUK = CK + 128;
constexpr int NCHUNK = T / CL, CPS = SEQ / CL;

constexpr size_t MB = 1024 * 1024;
constexpr size_t WS_CTL = 0;
constexpr size_t WS_RSTD1 = WS_CTL + 65536;
constexpr size_t WS_RS2P = WS_RSTD1 + (size_t)T * 4;
constexpr size_t WS_WIN = WS_RS2P + (size_t)T * 64;
constexpr size_t WS_WA = WS_WIN + (size_t)4608 * 1024 * 2;
constexpr size_t WS_WB = WS_WA + (size_t)1024 * 768 * 2;
constexpr size_t WS_WOUT = WS_WB + (size_t)1024 * 256 * 2;
constexpr size_t WS_WGLU = WS_WOUT + (size_t)1024 * 1024 * 2;
constexpr size_t WS_WS = WS_WGLU + (size_t)256 * 256 * 2;
constexpr size_t WS_UH = WS_WS + (size_t)2048 * 1024 * 2;
constexpr size_t WS_USC = WS_UH + (size_t)16384 * 1024;
constexpr size_t WS_VH = WS_USC + (size_t)16384 * 4;
constexpr size_t WS_VSC = WS_VH + (size_t)16384 * 1024;
constexpr size_t WS_RINV = WS_VSC + (size_t)16384 * 4;
constexpr size_t WS_POW = WS_RINV + (size_t)T * 4;
constexpr size_t WS_WN2 = WS_POW, WS_SIGW = WS_POW + 8192;
constexpr size_t WS_BBAR = WS_POW + (size_t)16 * 65 * 64 * 2 * 4;
constexpr size_t WS_KC = WS_BBAR + (size_t)16 * 64 * 16 * 2 * 4;
constexpr size_t WS_E = WS_KC + (size_t)16 * 64 * 256 * 4;
constexpr size_t WS_MEND = WS_E + (size_t)16 * NCHUNK * 128 * 4;
constexpr size_t WS_MY = WS_MEND + (size_t)16 * 256 * CK * 2;
constexpr size_t WS_EIDX = WS_MY + (size_t)16 * CK * SUK * 2;
constexpr size_t WS_GATE = WS_EIDX + (size_t)T * 128 * 4;
constexpr size_t WS_XB = WS_GATE + (size_t)T * 128 * 4;
constexpr size_t WS_G = WS_XB + (size_t)T * 1024 * 2;
constexpr size_t WS_CB = WS_G + (size_t)T * 2048 * 2;
constexpr size_t WS_V = WS_CB + (size_t)T * 768 * 2;
constexpr size_t WS_SU = WS_V + (size_t)T * 768 * 2;
constexpr size_t WS_A2 = WS_SU + (size_t)16 * NCHUNK * SUK * 2;
constexpr size_t WS_END = WS_A2 + (size_t)T * 768 * 2;
constexpr size_t WS_XQ = WS_A2 + (size_t)T * 512;
constexpr size_t WS_XB8 = WS_G + (size_t)T * 2048 + (size_t)4 * MB, WS_XSC = WS_XB8 + (size_t)T * 1024;
static_assert(WS_XSC + (size_t)T * 4 <= WS_G + (size_t)T * 2048 * 2, "XB8 / XSC inside the gate region");
constexpr size_t WS_A2S = WS_XSC;
constexpr int CTL_WMAX = 12000, CTL_WDONE = 12016, CTL_AMAX = 12032;
constexpr size_t WS_WQ8 = WS_G + (size_t)T * 2048, WS_WSC = WS_WQ8 + (size_t)2048 * 1024, WS_HSG = WS_RINV;
constexpr size_t WS_P = WS_CB, WS_X1B = WS_XB, WS_X1 = WS_G, WS_MG = WS_CB, WS_SC = WS_CB, WS_Z = WS_V + (size_t)T * 256 * 2, WS_S5 = WS_V + (size_t)T * 512 * 2;
static_assert(WS_GATE + (size_t)T * 128 * 4 <= WS_XB, "EIDX/GATE placement");
static_assert(WS_SC + (size_t)T * 2048 * 2 <= WS_XQ && WS_XQ + (size_t)T * 1024 <= WS_END, "SC / XQ overlay");
static_assert(WS_END <= (size_t)512 * MB, "workspace");
static_assert(WS_MG + (size_t)T * 1024 * 2 <= WS_Z && WS_S5 + (size_t)T * 256 * 2 <= WS_SU, "Z/S5 placement");
#if DBG
constexpr int NB = 2048;
constexpr size_t DB_BASE = (WS_END + 4095) & ~(size_t)4095;
constexpr size_t DB_ACC = DB_BASE;
constexpr size_t DB_CST = DB_ACC + 4096;
constexpr size_t DB_HN = DB_CST + 16384;
constexpr size_t DB_PROJ = DB_HN + (size_t)NB * D * 4;
constexpr size_t DB_AM = DB_PROJ + (size_t)NB * IN_COLS * 4;
constexpr size_t DB_YA = DB_AM + (size_t)NB * CONV_CH * 4;
constexpr size_t DB_XR = DB_YA + (size_t)NB * D * 4;
constexpr size_t DB_XI = DB_XR + (size_t)NB * D * 4;
constexpr size_t DB_Z = DB_XI + (size_t)NB * D * 4;
constexpr size_t DB_LIN = DB_Z + (size_t)NB * 256 * 4;
constexpr size_t DB_S5 = DB_LIN + (size_t)NB * 256 * 4;
constexpr size_t DB_YB = DB_S5 + (size_t)NB * 256 * 4;
constexpr size_t DB_MG = DB_YB + (size_t)NB * D * 4;
constexpr size_t DB_X1 = DB_MG + (size_t)NB * D * 4;
constexpr size_t DB_XN = DB_X1 + (size_t)NB * D * 4;
constexpr size_t DB_Q = DB_XN + (size_t)NB * D * 4;
constexpr size_t DB_EIDX = DB_Q + (size_t)NB * 2048 * 4;
constexpr size_t DB_GATE = DB_EIDX + (size_t)NB * 128 * 4;
constexpr size_t DB_OUT = DB_GATE + (size_t)NB * 128 * 4;
constexpr size_t DB_H = DB_OUT + (size_t)NB * D * 4;
constexpr size_t DB_END = DB_H + (size_t)NB * 128 * 4;
static_assert(DB_END <= (size_t)512 * MB, "debug workspace");
constexpr size_t DBH_OFF = DB_H;
#endif

constexpr int LDS_STAGE = 131072, LDS_MISC = LDS_STAGE, LDS_GBIAS = LDS_STAGE + 4096, LDS_BYTES = LDS_GBIAS + 8192;

struct Params { const float* in[26]; float* out; unsigned char* ws; };

__device__ __forceinline__ unsigned pk2bf(float lo, float hi) { unsigned r; asm volatile("v_cvt_pk_bf16_f32 %0, %1, %2" : "=v"(r) : "v"(lo), "v"(hi)); return r; }
__device__ __forceinline__ int dot4z(unsigned a, int b) { int r; asm("v_dot4_i32_i8 %0, %1, %2, 0" : "=v"(r) : "v"(a), "v"(b)); return r; }
__device__ __forceinline__ h2 as_h2(unsigned v) { return __builtin_bit_cast(h2, v); }
__device__ __forceinline__ unsigned pk2h(float lo, float hi) { unsigned r; asm("v_cvt_pkrtz_f16_f32 %0, %1, %2" : "=v"(r) : "v"(lo), "v"(hi)); return r; }
__device__ __forceinline__ float bflo(unsigned d) { return __uint_as_float(d << 16); }
__device__ __forceinline__ float bfhi(unsigned d) { return __uint_as_float(d & 0xffff0000u); }
__device__ __forceinline__ float gelu_exact(float v) { return 0.5f * v * (1.0f + erff(v * 0.70710678118654752f)); }
__device__ __forceinline__ float ub0(unsigned w) { return (float)(w & 0xffu); }
__device__ __forceinline__ float ub1(unsigned w) { return (float)((w >> 8) & 0xffu); }
__device__ __forceinline__ float ub2(unsigned w) { return (float)((w >> 16) & 0xffu); }
__device__ __forceinline__ float ub3(unsigned w) { return (float)(w >> 24); }
__device__ __forceinline__ float sigm(float v) { return __builtin_amdgcn_rcpf(1.0f + __builtin_amdgcn_exp2f(v * -1.44269504089f)); }
__device__ __forceinline__ float sigm255(float v) { return __builtin_amdgcn_rcpf(fmaf(__builtin_amdgcn_exp2f(v * -1.44269504089f), 1.0f / 255.0f, 1.0f / 255.0f)); }
__device__ __forceinline__ u32x4 pack8(const f32x4 a, const f32x4 b) { u32x4 w; w.x = pk2bf(a[0], a[1]); w.y = pk2bf(a[2], a[3]); w.z = pk2bf(b[0], b[1]); w.w = pk2bf(b[2], b[3]); return w; }
__device__ __forceinline__ float wave_sum(float v) {
#pragma unroll
    for (int o = 1; o < 64; o <<= 1) v += __shfl_xor(v, o);
    return v;
}

#define XB_TMO      128
#define XB_XCNT(j)  (256  + 64 * (j))
#define XB_XSUB(j)  (1280 + 64 * (j))
#define XB_XGEN(j)  (2304 + 64 * (j))
#define XB_TOP      3328
#define XB_TOPGEN   3392
#define XCD_BAR_WORDS 3456
#define XB_SPIN_CAP (1u << 22)
__device__ __forceinline__ unsigned xb_ld(unsigned* p)              { return __hip_atomic_load(p, __ATOMIC_RELAXED, __HIP_MEMORY_SCOPE_AGENT); }
__device__ __forceinline__ unsigned xb_add(unsigned* p, unsigned v) { return __hip_atomic_fetch_add(p, v, __ATOMIC_RELAXED, __HIP_MEMORY_SCOPE_AGENT); }
__device__ __forceinline__ unsigned xb_xcc_id() { return (unsigned)__builtin_amdgcn_s_getreg((3 << 11) | 20) & 0xFu; }
#define XB_SPIN(cond, bar) do { unsigned _sp = 0; while (cond) { __builtin_amdgcn_s_sleep(1); \
    if ((++_sp & 255u) == 0u) { if (xb_ld(&(bar)[XB_TMO])) break; if (_sp > XB_SPIN_CAP) { atomicAdd(&(bar)[XB_TMO], 1u); break; } } } } while (0)
struct XcdBarrier { unsigned* bar; unsigned x; volatile LAS unsigned* st; };
__device__ __forceinline__ XcdBarrier xcd_barrier_post(unsigned* bar, volatile LAS unsigned* st) {
    XcdBarrier b; b.bar = bar; b.x = xb_xcc_id(); b.st = st;
    if (threadIdx.x == 0) (void)xb_add(&bar[XB_XCNT(b.x)], 1u);
    return b;
}
__device__ __forceinline__ void xcd_barrier_complete(unsigned* bar, unsigned x, unsigned& nloc, unsigned& nx) {
    const unsigned G = gridDim.x * gridDim.y * gridDim.z;
    unsigned sum, cnt, mine, sp = 0u;
    for (;;) {
        sum = 0u; cnt = 0u; mine = 0u;
#pragma unroll
        for (unsigned j = 0; j < 16; ++j) { const unsigned c = xb_ld(&bar[XB_XCNT(j)]); sum += c; cnt += (c > 0u) ? 1u : 0u; mine = (j == x) ? c : mine; }
        if (sum == G) break;
        __builtin_amdgcn_s_sleep(1);
        if ((++sp & 255u) == 0u) { if (xb_ld(&bar[XB_TMO])) break; if (sp > XB_SPIN_CAP) { atomicAdd(&bar[XB_TMO], 1u); break; } }
    }
    nloc = mine > 0u ? mine : 1u; nx = cnt > 0u ? cnt : 1u;
}
__device__ __forceinline__ void xcd_barrier(const XcdBarrier& b) {
    asm volatile("s_waitcnt vmcnt(0)" ::: "memory");
    __syncthreads();
    if (threadIdx.x == 0) {
        unsigned* bar = b.bar;
        __builtin_amdgcn_s_waitcnt(0);
        unsigned nloc = b.st[0], nx = b.st[1];
        if (nloc == 0u) { xcd_barrier_complete(bar, b.x, nloc, nx); b.st[0] = nloc; b.st[1] = nx; }
        const unsigned old = xb_add(&bar[XB_XSUB(b.x)], 1u);
        const unsigned gen = old / nloc;
        if (old + 1u == (gen + 1u) * nloc) {
            __builtin_amdgcn_fence(__ATOMIC_RELEASE, "agent");
            asm volatile("s_waitcnt vmcnt(0)" ::: "memory");
            const unsigned og = xb_add(&bar[XB_TOP], 1u);
            const unsigned tg = og / nx;
            if (og + 1u == (tg + 1u) * nx) xb_add(&bar[XB_TOPGEN], 1u);
            else XB_SPIN(xb_ld(&bar[XB_TOPGEN]) == tg, bar);
            __builtin_amdgcn_fence(__ATOMIC_ACQUIRE, "agent");
            xb_add(&bar[XB_XGEN(b.x)], 1u);
            asm volatile("s_waitcnt vmcnt(0)" ::: "memory");
        } else {
            XB_SPIN(xb_ld(&bar[XB_XGEN(b.x)]) == gen, bar);
            __builtin_amdgcn_fence(__ATOMIC_ACQUIRE, "agent");
            asm volatile("s_waitcnt vmcnt(0)" ::: "memory");
        }
    }
    __syncthreads();
}

constexpr int BM = 256, BK = 64, HALF = 128, HTB = HALF * BK * 2, NXCD = 8, WGM = 8;
__device__ __forceinline__ int lds_byte(int r, int c) { const int st = (r >> 4) * 2 + (c >> 5), rr = r & 15, cc = c & 31, ob = rr * 64 + cc * 2; return st * 1024 + (ob ^ (((ob >> 9) & 1) << 5)); }
__device__ __forceinline__ void stage_rc(int b, int& R, int& C) { const int st = b / 1024, sb = b % 1024, swz = sb ^ (((sb >> 9) & 1) << 5); R = (st >> 1) * 16 + swz / 64; C = (st & 1) * 32 + (swz % 64) / 2; }
__device__ __forceinline__ int perm32(int rho) { const int n = rho >> 4, i = rho & 15; return 8 * (i >> 2) + 4 * n + (i & 3); }

typedef int v4i_g __attribute__((ext_vector_type(4)));
template <class E, class = void> struct EpiI8 { static constexpr bool v = false; };
template <class E> struct EpiI8<E, decltype((void)E::I8)> { static constexpr bool v = E::I8; };
struct Unit { int pm, pn, z; };
struct Gemm { const bf16_t* A; const bf16_t* Bt; int lda, ldb, K; long sAz, sBz; };
struct Order {
    int nM, nN, nZ, G, c, pm_off; long u0, u1; int b0; int dn, dpm, dpn0;
    __device__ void init(int M, int N, int Z, int pmo) { nM = M / BM; nN = N / BM; nZ = Z; G = gridDim.x; c = blockIdx.x; pm_off = pmo; u0 = 0; u1 = (long)nM * nN * nZ; b0 = 0; dn = -1; dpm = 0; dpn0 = 0; }
    __device__ void direct(int pm, int pn0, int n) { dn = n; dpm = pm; dpn0 = pn0; }
    __device__ void window(long first_unit, long end_unit, int first_block, int nblocks) { u0 = first_unit; u1 = end_unit; b0 = first_block; G = nblocks; }
    __device__ bool next(int i, Unit& u) const {
        if (dn >= 0) { if (i >= dn) return false; u.pm = dpm; u.pn = dpn0 + i; u.z = 0; return true; }
        if (c < b0 || c >= b0 + G) return false;
        const long L = u0 + (long)i * G + (c - b0); const int nwg = nM * nN;
        if (L >= u1) return false;
        if (nZ == 1) {
            int wgid = (int)L; { const int q = nwg / NXCD, r = nwg % NXCD, xcd = wgid % NXCD, off = wgid / NXCD; wgid = (xcd < r ? xcd * (q + 1) : r * (q + 1) + (xcd - r) * q) + off; }
            const int nig = WGM * nN, gid = wgid / nig, fm = gid * WGM, gsz = (nM - fm) < WGM ? (nM - fm) : WGM;
            u.pm = pm_off + fm + ((wgid % nig) % gsz); u.pn = (wgid % nig) / gsz; u.z = 0;
        } else { u.z = (int)(L / nwg); const int r = (int)(L % nwg); u.pm = r % nM; u.pn = r / nM; }
        return true;
    }
};

template <class Epi>
__device__ __forceinline__ void gemm_phase(LAS unsigned char* lds, const Gemm g, const Order& S, const Epi& E) {
    int tid = threadIdx.x; asm volatile("" : "+v"(tid));
    const int wid = __builtin_amdgcn_readfirstlane(tid >> 6), lane = tid & 63, wr = wid >> 2, wc = wid & 3, fr = lane & 15, fq = lane >> 4;
    const int K = g.K, nt = K / BK;
    unsigned voffA[2], voffB[2];
#pragma unroll
    for (int i = 0; i < 2; ++i) { int R, C; stage_rc(tid * 16 + i * 8192, R, C); const int Rb = Epi::PERM ? ((R & ~31) + perm32(R & 31)) : R;
        voffA[i] = (unsigned)(R * g.lda + C) * 2u; voffB[i] = (unsigned)(Rb * g.ldb + C) * 2u; }
    const size_t kstep = (size_t)(BK * 2);
    const size_t hstepA = (size_t)HALF * g.lda * 2, hstepB = (size_t)HALF * g.ldb * 2;
    const unsigned ldsw = (unsigned)wid * 1024u;
    const int aoff = lds_byte(wr * 64 + fr, fq * 8), boff = lds_byte(wc * 32 + fr, fq * 8);
#define PG8_SA(b, h) (((b) * 2 + (h)) * HTB)
#define PG8_SB(b, h) ((4 + (b) * 2 + (h)) * HTB)
#define PG8_STAGE(bufoff, gbase, voff) do { _Pragma("unroll") for (int _i = 0; _i < 2; ++_i) \
        __builtin_amdgcn_global_load_lds((const unsigned*)((const char*)(gbase) + (voff)[_i]), (LAS unsigned*)(lds + (bufoff) + ldsw + _i * 8192), 16, 0, 0); } while (0)
#define PG8_LDA(dst, b, h) do { _Pragma("unroll") for (int m = 0; m < 4; ++m) _Pragma("unroll") for (int k = 0; k < 2; ++k) dst[m][k] = *(const LAS bf16x8*)(lds + PG8_SA(b, h) + aoff + m * 2048 + k * 1024); } while (0)
#define PG8_LDB(dst, b, h) do { _Pragma("unroll") for (int n = 0; n < 2; ++n) _Pragma("unroll") for (int k = 0; k < 2; ++k) dst[n][k] = *(const LAS bf16x8*)(lds + PG8_SB(b, h) + boff + n * 2048 + k * 1024); } while (0)
#define PG8_MMA(ai, bj, At, Bt) do { __builtin_amdgcn_s_setprio(1); _Pragma("unroll") for (int m = 0; m < 4; ++m) _Pragma("unroll") for (int n = 0; n < 2; ++n) _Pragma("unroll") for (int k = 0; k < 2; ++k) \
        { if constexpr (EpiI8<Epi>::v) acc[ai][bj][m][n] = __builtin_bit_cast(f32x4, __builtin_amdgcn_mfma_i32_16x16x64_i8(__builtin_bit_cast(v4i_g, Bt[n][k]), __builtin_bit_cast(v4i_g, At[m][k]), __builtin_bit_cast(v4i_g, acc[ai][bj][m][n]), 0, 0, 0)); \
          else acc[ai][bj][m][n] = __builtin_amdgcn_mfma_f32_16x16x32_bf16(Bt[n][k], At[m][k], acc[ai][bj][m][n], 0, 0, 0); } __builtin_amdgcn_s_setprio(0); } while (0)
#define PG8_WAIT_V(n) asm volatile("s_waitcnt vmcnt(" #n ")" ::: "memory")
#define PG8_WAIT_L(n) asm volatile("s_waitcnt lgkmcnt(" #n ")" ::: "memory")
#define PG8_BAR __builtin_amdgcn_s_barrier()
#define PG8_SCHED __builtin_amdgcn_sched_barrier(0)
    Unit cur, nxt; int ui = 0;
    if (!S.next(0, cur)) return;
    f32x4 acc[2][2][4][2];
#pragma unroll
    for (int a = 0; a < 2; ++a)
#pragma unroll
        for (int b = 0; b < 2; ++b)
#pragma unroll
            for (int m = 0; m < 4; ++m)
#pragma unroll
                for (int n = 0; n < 2; ++n) acc[a][b][m][n] = (f32x4){0.f, 0.f, 0.f, 0.f};
    bf16x8 At[4][2], B0[2][2], B1[2][2];
    const char* cA = (const char*)g.A + ((size_t)cur.z * g.sAz) * 2 + (size_t)cur.pm * 2 * hstepA;
    const char* cB = (const char*)g.Bt + ((size_t)cur.z * g.sBz) * 2 + (size_t)cur.pn * 2 * hstepB;
    PG8_STAGE(PG8_SB(0, 0), cB, voffB); PG8_STAGE(PG8_SB(0, 1), cB + hstepB, voffB); PG8_STAGE(PG8_SA(0, 0), cA, voffA); PG8_STAGE(PG8_SA(0, 1), cA + hstepA, voffA);
    if (wr == 1) PG8_BAR;
    PG8_WAIT_V(2); PG8_BAR;
    PG8_STAGE(PG8_SB(1, 0), cB + kstep, voffB); PG8_STAGE(PG8_SA(1, 0), cA + kstep, voffA); PG8_STAGE(PG8_SB(1, 1), cB + hstepB + kstep, voffB);
    PG8_WAIT_V(6); PG8_BAR;
    for (;;) {
        const bool has_next = S.next(ui + 1, nxt);
        const char* nA = has_next ? (const char*)g.A + ((size_t)nxt.z * g.sAz) * 2 + (size_t)nxt.pm * 2 * hstepA : cA;
        const char* nB = has_next ? (const char*)g.Bt + ((size_t)nxt.z * g.sBz) * 2 + (size_t)nxt.pn * 2 * hstepB : cB;
#pragma unroll 1
        for (int t = 0; t < nt; t += 2) {
            const bool last = (t == nt - 2);
            const char* a1 = cA + (size_t)(t + 1) * kstep;
            const char* a2 = last ? nA : cA + (size_t)(t + 2) * kstep; const char* b2 = last ? nB : cB + (size_t)(t + 2) * kstep;
            const char* a3 = a2 + kstep; const char* b3 = b2 + kstep;
            PG8_LDB(B0, 0, 0); PG8_LDB(B1, 0, 1); PG8_SCHED; PG8_LDA(At, 0, 0); PG8_STAGE(PG8_SA(1, 1), a1 + hstepA, voffA);
            PG8_WAIT_V(8); PG8_WAIT_L(0); PG8_BAR; PG8_MMA(0, 0, At, B0); PG8_MMA(0, 1, At, B1); PG8_BAR; PG8_SCHED;
            PG8_LDA(At, 0, 1); PG8_STAGE(PG8_SB(0, 0), b2, voffB); PG8_STAGE(PG8_SB(0, 1), b2 + hstepB, voffB); PG8_STAGE(PG8_SA(0, 0), a2, voffA);
            PG8_WAIT_V(8); PG8_WAIT_L(0); PG8_BAR; PG8_MMA(1, 0, At, B0); PG8_MMA(1, 1, At, B1); PG8_BAR; PG8_SCHED;
            PG8_LDB(B0, 1, 0); PG8_LDB(B1, 1, 1); PG8_SCHED; PG8_LDA(At, 1, 0); PG8_STAGE(PG8_SA(0, 1), a2 + hstepA, voffA);
            PG8_WAIT_V(8); PG8_WAIT_L(0); PG8_BAR; PG8_MMA(0, 0, At, B0); PG8_MMA(0, 1, At, B1); PG8_BAR; PG8_SCHED;
            PG8_LDA(At, 1, 1); PG8_STAGE(PG8_SB(1, 0), b3, voffB); PG8_STAGE(PG8_SB(1, 1), b3 + hstepB, voffB); PG8_STAGE(PG8_SA(1, 0), a3, voffA);
            PG8_WAIT_V(8); PG8_WAIT_L(0); PG8_BAR; PG8_MMA(1, 0, At, B0); PG8_MMA(1, 1, At, B1); PG8_BAR; PG8_SCHED;
        }
        if (wr == 0) PG8_BAR;
        { int fr_e = fr, fq_e = fq; asm volatile("" : "+v"(fr_e), "+v"(fq_e));
          E(acc, cur, wr, wc, fr_e, fq_e); }
        if (!has_next) break;
#pragma unroll
        for (int a = 0; a < 2; ++a)
#pragma unroll
            for (int b = 0; b < 2; ++b)
#pragma unroll
                for (int m = 0; m < 4; ++m)
#pragma unroll
                    for (int n = 0; n < 2; ++n) acc[a][b][m][n] = (f32x4){0.f, 0.f, 0.f, 0.f};
        cur = nxt; cA = nA; cB = nB; ++ui;
        if (wr == 1) PG8_BAR;
    }
    PG8_WAIT_V(0);
    PG8_BAR;
#undef PG8_SA
#undef PG8_SB
#undef PG8_STAGE
#undef PG8_LDA
#undef PG8_LDB
#undef PG8_MMA
#undef PG8_WAIT_V
#undef PG8_WAIT_L
#undef PG8_BAR
#undef PG8_SCHED
}

__device__ __forceinline__ u32x4 xpose16(const u32x4 v, int src_addr) {
    u32x4 r; r.x = (unsigned)__builtin_amdgcn_ds_bpermute(src_addr, (int)v.x); r.y = (unsigned)__builtin_amdgcn_ds_bpermute(src_addr, (int)v.y);
    r.z = (unsigned)__builtin_amdgcn_ds_bpermute(src_addr, (int)v.z); r.w = (unsigned)__builtin_amdgcn_ds_bpermute(src_addr, (int)v.w); return r;
}
typedef const f32x4 (&AccRef)[2][2][4][2];
template <bool NOST> struct EpiG1T {
    static constexpr bool PERM = true;
    static constexpr bool I8 = true;
    const LAS float* bgate; bf16_t *CB, *V, *SU; unsigned char* G8; const float* XSC; float wsc;
    __device__ __forceinline__ void operator()(AccRef acc, const Unit& u, int wr, int wc, int fr, int fq) const {
        const int pn = u.pn, c0 = wc * 32 + 8 * fq;
        float xs_[2][4];
#pragma unroll
        for (int ai = 0; ai < 2; ++ai)
#pragma unroll
            for (int m = 0; m < 4; ++m) xs_[ai][m] = XSC[u.pm * BM + ai * HALF + wr * 64 + m * 16 + fr] * wsc;
        const int lane = fq * 16 + fr, sa = ((lane & 3) * 16 + (lane >> 2)) * 4, tr = lane >> 2, tc0 = wc * 32 + 8 * (lane & 3);
#pragma unroll
        for (int ai = 0; ai < 2; ++ai)
#pragma unroll
            for (int m = 0; m < 4; ++m) {
                const int row = u.pm * BM + ai * HALF + wr * 64 + m * 16 + tr;
                f32x4 sc_[2][2];
#pragma unroll
                for (int bj = 0; bj < 2; ++bj)
#pragma unroll
                    for (int n = 0; n < 2; ++n) { const v4i_g iv = __builtin_bit_cast(v4i_g, acc[ai][bj][m][n]); sc_[bj][n] = (f32x4){(float)iv[0], (float)iv[1], (float)iv[2], (float)iv[3]} * xs_[ai][m]; }
                if (pn < 3) {
#pragma unroll
                    for (int bj = 0; bj < 2; ++bj) { const u32x4 w_ = xpose16(pack8(sc_[bj][0], sc_[bj][1]), sa); if (NOST) asm volatile("" :: "v"(w_)); else *(u32x4*)(CB + (size_t)row * CONV_CH + pn * 256 + bj * HALF + tc0) = w_; }
                } else if (pn < 9) {
                    { const u32x4 w_ = xpose16(pack8(sc_[0][0] * sc_[1][0], sc_[0][1] * sc_[1][1]), sa); if (NOST) asm volatile("" :: "v"(w_)); else *(u32x4*)(V + (size_t)row * CONV_CH + (pn - 3) * HALF + tc0) = w_; }
                } else if (pn == 9) {
#pragma unroll
                    for (int bj = 0; bj < 2; ++bj) { const int c = bj * HALF + tc0, gq = c >> 4, h0 = c & 15;
                        const u32x4 w_ = xpose16(pack8(sc_[bj][0], sc_[bj][1]), sa); if (NOST) asm volatile("" :: "v"(w_)); else *(u32x4*)(SU + ((size_t)(gq * NCHUNK + (row >> LOGCL))) * SUK + (row & (CL - 1)) * 16 + h0) = w_; }
                } else {
#pragma unroll
                    for (int bj = 0; bj < 2; ++bj) { const int col = (pn - 10) * 256 + bj * HALF + c0;
                        const f32x4 b0 = *(const LAS f32x4*)(bgate + col), b1 = *(const LAS f32x4*)(bgate + col + 4);
                        unsigned lo = 0u, hi = 0u;
{ const v4i_g ga_ = __builtin_bit_cast(v4i_g, acc[ai][bj][m][0]), gb_ = __builtin_bit_cast(v4i_g, acc[ai][bj][m][1]); const float r32_ = xs_[ai][m] * 32.0f;
#pragma unroll
                        for (int e = 0; e < 4; ++e) { lo = __builtin_amdgcn_cvt_pk_u8_f32(fmaf((float)ga_[e], r32_, b0[e]), e, lo); hi = __builtin_amdgcn_cvt_pk_u8_f32(fmaf((float)gb_[e], r32_, b1[e]), e, hi); } }
                        const int rowd = u.pm * BM + ai * HALF + wr * 64 + m * 16 + fr; const u32x2 w_ = {lo, hi};
                        if (NOST) asm volatile("" :: "v"(w_)); else *(u32x2*)(G8 + (size_t)rowd * 2048 + col) = w_; }
                }
            }
    }
};
typedef EpiG1T<false> EpiG1;
struct EpiNull {
    static constexpr bool PERM = true;
    __device__ __forceinline__ void operator()(AccRef acc, const Unit& u, int wr, int wc, int fr, int fq) const {
#pragma unroll
        for (int ai = 0; ai < 2; ++ai)
#pragma unroll
            for (int bj = 0; bj < 2; ++bj)
#pragma unroll
                for (int m = 0; m < 4; ++m)
#pragma unroll
                    for (int n = 0; n < 2; ++n) asm volatile("" :: "v"(acc[ai][bj][m][n]));
    }
};
#define EPI_WAIT() asm volatile("s_waitcnt vmcnt(0)" ::: "memory")
struct EpiP {
    static constexpr bool PERM = true;
    static constexpr bool I8 = true;
    const unsigned char* G8; bf16_t* P; const LAS float* lut; const float* A2S; float wsc;
    __device__ __forceinline__ void operator()(AccRef acc, const Unit& u, int wr, int wc, int fr, int fq) const {
        const int col0 = u.pn * BM + wc * 32 + 8 * fq; const LAS float* lutl = lut + (fr & 7);
#pragma unroll
        for (int ai = 0; ai < 2; ++ai) {
            u32x2 gg[4][2]; float rs_[4];
#pragma unroll
            for (int m = 0; m < 4; ++m) { const int row = u.pm * BM + ai * HALF + wr * 64 + m * 16 + fr; rs_[m] = A2S[row];
#pragma unroll
                for (int bj = 0; bj < 2; ++bj) gg[m][bj] = *(const u32x2*)(G8 + (size_t)row * 2048 + col0 + bj * HALF); }
            EPI_WAIT();
#pragma unroll
            for (int m = 0; m < 4; ++m) { const int row = u.pm * BM + ai * HALF + wr * 64 + m * 16 + fr; const float r_ = rs_[m] * wsc;
#pragma unroll
                for (int bj = 0; bj < 2; ++bj) { const u32x2 g2 = gg[m][bj];
                    const v4i_g i0 = __builtin_bit_cast(v4i_g, acc[ai][bj][m][0]), i1 = __builtin_bit_cast(v4i_g, acc[ai][bj][m][1]);
                    f32x4 v0 = (f32x4){(float)i0[0], (float)i0[1], (float)i0[2], (float)i0[3]} * r_, v1 = (f32x4){(float)i1[0], (float)i1[1], (float)i1[2], (float)i1[3]} * r_;
                    v0[0] *= lutl[(g2.x & 255u) * 8u]; v0[1] *= lutl[((g2.x >> 8) & 255u) * 8u]; v0[2] *= lutl[((g2.x >> 16) & 255u) * 8u]; v0[3] *= lutl[(g2.x >> 24) * 8u];
                    v1[0] *= lutl[(g2.y & 255u) * 8u]; v1[1] *= lutl[((g2.y >> 8) & 255u) * 8u]; v1[2] *= lutl[((g2.y >> 16) & 255u) * 8u]; v1[3] *= lutl[(g2.y >> 24) * 8u];
                    *(u32x4*)(P + (size_t)row * D + col0 + bj * HALF) = pack8(v0, v1); } }
        }
    }
};
struct EpiE {
    static constexpr bool PERM = false;
    float* E;
    __device__ __forceinline__ void operator()(AccRef acc, const Unit& u, int wr, int wc, int fr, int fq) const {
#pragma unroll
        for (int ai = 0; ai < 2; ++ai)
#pragma unroll
            for (int m = 0; m < 4; ++m) { const int row = u.pm * BM + ai * HALF + wr * 64 + m * 16 + fr;
#pragma unroll
                for (int n = 0; n < 2; ++n) *(f32x4*)(E + ((size_t)u.z * NCHUNK + row) * 128 + wc * 32 + n * 16 + 4 * fq) = acc[ai][0][m][n]; }
    }
};
struct EpiY {
    static constexpr bool PERM = true;
    const bf16_t* SU; const float* dskip; bf16_t* Z;
    __device__ __forceinline__ void operator()(AccRef acc, const Unit& u, int wr, int wc, int fr, int fq) const {
        f32x4 d0[2], d1[2];
#pragma unroll
        for (int bj = 0; bj < 2; ++bj) { const int col = u.pn * BM + bj * HALF + wc * 32 + 8 * fq, h0 = col & 15; d0[bj] = *(const f32x4*)(dskip + u.z * 16 + h0); d1[bj] = *(const f32x4*)(dskip + u.z * 16 + h0 + 4); }
#pragma unroll
        for (int ai = 0; ai < 2; ++ai) {
            u32x4 uu[4][2];
#pragma unroll
            for (int m = 0; m < 4; ++m) { const int chunk = u.pm * BM + ai * HALF + wr * 64 + m * 16 + fr;
#pragma unroll
                for (int bj = 0; bj < 2; ++bj) { const int col = u.pn * BM + bj * HALF + wc * 32 + 8 * fq;
                    uu[m][bj] = *(const u32x4*)(SU + ((size_t)u.z * NCHUNK + chunk) * SUK + col); } }
            EPI_WAIT();
#pragma unroll
            for (int m = 0; m < 4; ++m) { const int chunk = u.pm * BM + ai * HALF + wr * 64 + m * 16 + fr;
#pragma unroll
                for (int bj = 0; bj < 2; ++bj) { const int col = u.pn * BM + bj * HALF + wc * 32 + 8 * fq, j = col >> 4, h0 = col & 15; const u32x4 u4 = uu[m][bj];
                    f32x4 v0 = acc[ai][bj][m][0], v1 = acc[ai][bj][m][1];
                    v0[0] += d0[bj][0] * bflo(u4.x); v0[1] += d0[bj][1] * bfhi(u4.x); v0[2] += d0[bj][2] * bflo(u4.y); v0[3] += d0[bj][3] * bfhi(u4.y);
                    v1[0] += d1[bj][0] * bflo(u4.z); v1[1] += d1[bj][1] * bfhi(u4.z); v1[2] += d1[bj][2] * bflo(u4.w); v1[3] += d1[bj][3] * bfhi(u4.w);
#pragma unroll
                    for (int e = 0; e < 4; ++e) { v0[e] = gelu_exact(v0[e]); v1[e] = gelu_exact(v1[e]); }
                    *(u32x4*)(Z + ((size_t)chunk * CL + j) * 256 + u.z * 16 + h0) = pack8(v0, v1); } }
        }
    }
};
struct EpiGlu {
    static constexpr bool PERM = true;
    const bf16_t* Z; const float* bglu; bf16_t* S5;
    __device__ __forceinline__ void operator()(AccRef acc, const Unit& u, int wr, int wc, int fr, int fq) const {
        f32x4 b0[2], b1[2];
#pragma unroll
        for (int bj = 0; bj < 2; ++bj) { const int col = bj * HALF + wc * 32 + 8 * fq; b0[bj] = *(const f32x4*)(bglu + col); b1[bj] = *(const f32x4*)(bglu + col + 4); }
#pragma unroll
        for (int ai = 0; ai < 2; ++ai) {
            u32x4 zz[4][2];
#pragma unroll
            for (int m = 0; m < 4; ++m) { const int row = u.pm * BM + ai * HALF + wr * 64 + m * 16 + fr;
#pragma unroll
                for (int bj = 0; bj < 2; ++bj) zz[m][bj] = *(const u32x4*)(Z + (size_t)row * 256 + bj * HALF + wc * 32 + 8 * fq); }
            EPI_WAIT();
#pragma unroll
            for (int m = 0; m < 4; ++m) { const int row = u.pm * BM + ai * HALF + wr * 64 + m * 16 + fr;
#pragma unroll
                for (int bj = 0; bj < 2; ++bj) { const int col = bj * HALF + wc * 32 + 8 * fq; const u32x4 z4 = zz[m][bj];
                    f32x4 v0 = acc[ai][bj][m][0] + b0[bj], v1 = acc[ai][bj][m][1] + b1[bj];
                    v0[0] = bflo(z4.x) * sigm(v0[0]); v0[1] = bfhi(z4.x) * sigm(v0[1]); v0[2] = bflo(z4.y) * sigm(v0[2]); v0[3] = bfhi(z4.y) * sigm(v0[3]);
                    v1[0] = bflo(z4.z) * sigm(v1[0]); v1[1] = bfhi(z4.z) * sigm(v1[1]); v1[2] = bflo(z4.w) * sigm(v1[2]); v1[3] = bfhi(z4.w) * sigm(v1[3]);
                    *(u32x4*)(S5 + (size_t)row * 256 + col) = pack8(v0, v1); } }
        }
    }
};
struct EpiMerge {
    static constexpr bool PERM = true;
    const unsigned char* G8; const bf16_t* P; bf16_t* MG; const LAS float* lut;
    __device__ __forceinline__ void operator()(AccRef acc, const Unit& u, int wr, int wc, int fr, int fq) const {
        const int col0 = u.pn * BM + wc * 32 + 8 * fq; const LAS float* lutl = lut + (fr & 7);
#pragma unroll
        for (int ai = 0; ai < 2; ++ai) {
            u32x2 gg[4][2]; u32x4 pp[4][2];
#pragma unroll
            for (int m = 0; m < 4; ++m) { const int row = u.pm * BM + ai * HALF + wr * 64 + m * 16 + fr;
#pragma unroll
                for (int bj = 0; bj < 2; ++bj) { gg[m][bj] = *(const u32x2*)(G8 + (size_t)row * 2048 + D + col0 + bj * HALF); pp[m][bj] = *(const u32x4*)(P + (size_t)row * D + col0 + bj * HALF); } }
            EPI_WAIT();
#pragma unroll
            for (int m = 0; m < 4; ++m) { const int row = u.pm * BM + ai * HALF + wr * 64 + m * 16 + fr;
#pragma unroll
                for (int bj = 0; bj < 2; ++bj) { const u32x2 g2 = gg[m][bj]; const u32x4 p4 = pp[m][bj];
                    f32x4 v0 = acc[ai][bj][m][0], v1 = acc[ai][bj][m][1];
                    v0[0] = bflo(p4.x) + lutl[(g2.x & 255u) * 8u] * v0[0]; v0[1] = bfhi(p4.x) + lutl[((g2.x >> 8) & 255u) * 8u] * v0[1]; v0[2] = bflo(p4.y) + lutl[((g2.x >> 16) & 255u) * 8u] * v0[2]; v0[3] = bfhi(p4.y) + lutl[(g2.x >> 24) * 8u] * v0[3];
                    v1[0] = bflo(p4.z) + lutl[(g2.y & 255u) * 8u] * v1[0]; v1[1] = bfhi(p4.z) + lutl[((g2.y >> 8) & 255u) * 8u] * v1[1]; v1[2] = bflo(p4.w) + lutl[((g2.y >> 16) & 255u) * 8u] * v1[2]; v1[3] = bfhi(p4.w) + lutl[(g2.y >> 24) * 8u] * v1[3];
                    *(u32x4*)(MG + (size_t)row * D + col0 + bj * HALF) = pack8(v0, v1); } }
        }
    }
};
struct EpiX1 {
    static constexpr bool PERM = true;
    const float* x; bf16_t* X1B; float* RS2P;
    __device__ __forceinline__ void operator()(AccRef acc, const Unit& u, int wr, int wc, int fr, int fq) const {
        const int col0 = u.pn * BM + wc * 32 + 8 * fq;
#pragma unroll
        for (int ai = 0; ai < 2; ++ai) {
            f32x4 xa[4][2], xb[4][2];
#pragma unroll
            for (int m = 0; m < 4; ++m) { const int row = u.pm * BM + ai * HALF + wr * 64 + m * 16 + fr;
#pragma unroll
                for (int bj = 0; bj < 2; ++bj) { const size_t o = (size_t)row * D + col0 + bj * HALF; xa[m][bj] = *(const f32x4*)(x + o); xb[m][bj] = *(const f32x4*)(x + o + 4); } }
            EPI_WAIT();
#pragma unroll
            for (int m = 0; m < 4; ++m) { const int row = u.pm * BM + ai * HALF + wr * 64 + m * 16 + fr; float ss = 0.f;
#pragma unroll
                for (int bj = 0; bj < 2; ++bj) { const size_t o = (size_t)row * D + col0 + bj * HALF;
                    const f32x4 v0 = acc[ai][bj][m][0] + xa[m][bj], v1 = acc[ai][bj][m][1] + xb[m][bj];
                    *(u32x4*)(X1B + o) = pack8(v0, v1);
                    ss += (v0[0] * v0[0] + v0[1] * v0[1]) + (v0[2] * v0[2] + v0[3] * v0[3]) + (v1[0] * v1[0] + v1[1] * v1[1]) + (v1[2] * v1[2] + v1[3] * v1[3]); }
                ss += __shfl_xor(ss, 16); ss += __shfl_xor(ss, 32);
                if (fq == 0) RS2P[(size_t)row * 16 + u.pn * 4 + wc] = ss; }
        }
    }
};
struct EpiSC {
    static constexpr bool PERM = true;
    static constexpr bool I8 = true;
    unsigned char* SC8; const LAS float* rsl; const float* WSC; int pm0, pm1, pm2;
    __device__ __forceinline__ void operator()(AccRef acc, const Unit& u, int wr, int wc, int fr, int fq) const {
        const int col0 = u.pn * BM + wc * 32 + 8 * fq;
        const int slot = (u.pm == pm0) ? 0 : (u.pm == pm1) ? 1 : (u.pm == pm2) ? 2 : 3;
        f32x4 wa[2][2];
#pragma unroll
        for (int bj = 0; bj < 2; ++bj) { wa[bj][0] = *(const f32x4*)(WSC + col0 + bj * HALF); wa[bj][1] = *(const f32x4*)(WSC + col0 + bj * HALF + 4); }
#pragma unroll
        for (int ai = 0; ai < 2; ++ai)
#pragma unroll
            for (int m = 0; m < 4; ++m) { const int rl = ai * HALF + wr * 64 + m * 16 + fr, row = u.pm * BM + rl; const float r32 = rsl[slot * 256 + rl];
#pragma unroll
                for (int bj = 0; bj < 2; ++bj) { const v4i_g i0 = __builtin_bit_cast(v4i_g, acc[ai][bj][m][0]), i1 = __builtin_bit_cast(v4i_g, acc[ai][bj][m][1]); const f32x4 s0 = wa[bj][0] * r32, s1 = wa[bj][1] * r32; unsigned lo = 0u, hi = 0u;
#pragma unroll
                    for (int e = 0; e < 4; ++e) { lo = __builtin_amdgcn_cvt_pk_u8_f32(fmaf((float)i0[e], s0[e], -32.0f), e, lo); hi = __builtin_amdgcn_cvt_pk_u8_f32(fmaf((float)i1[e], s1[e], -32.0f), e, hi); }
                    *(u32x2*)(SC8 + (size_t)row * 2048 + col0 + bj * HALF) = (u32x2){lo, hi}; } }
    }
};

__device__ __forceinline__ void transpose_item(const float* W, int ldw, int src_col0, bf16_t* WT, int ldt, int dst_row0, int k0, const float* scale, LAS float* scr, int lane, float cs = 1.0f) {
#pragma unroll
    for (int i = 0; i < 32; ++i) { const int kk = 2 * i + (lane >> 5); float v = W[(size_t)(k0 + kk) * ldw + src_col0 + (lane & 31)] * cs; if (scale) v *= scale[k0 + kk]; scr[kk * 33 + (lane & 31)] = v; }
    asm volatile("s_waitcnt lgkmcnt(0)" ::: "memory");
    const int c = lane & 7;
#pragma unroll
    for (int j = 0; j < 4; ++j) { const int n = (lane >> 3) + 8 * j; const LAS float* s = scr + (8 * c) * 33 + n;
        u32x4 o; o.x = pk2bf(s[0 * 33], s[1 * 33]); o.y = pk2bf(s[2 * 33], s[3 * 33]); o.z = pk2bf(s[4 * 33], s[5 * 33]); o.w = pk2bf(s[6 * 33], s[7 * 33]);
        *(u32x4*)(WT + (size_t)(dst_row0 + n) * ldt + k0 + 8 * c) = o; }
    asm volatile("s_waitcnt lgkmcnt(0)" ::: "memory");
}
struct TrIt { const float* src; bf16_t* dst; const float* scale; int ldw, ldt; float cs; int i8; };
__device__ __forceinline__ void tr_load(const TrIt& t, int lane, float (&v)[32]) {
#pragma unroll
    for (int i = 0; i < 32; ++i) v[i] = t.src[(size_t)(2 * i + (lane >> 5)) * t.ldw + (lane & 31)];
}
__device__ __forceinline__ void tr_flush(const TrIt& t, const float (&v)[32], LAS float* scr, int lane) {
#pragma unroll
    for (int i = 0; i < 32; ++i) scr[(2 * i + (lane >> 5)) * 33 + (lane & 31)] = v[i];
    asm volatile("s_waitcnt lgkmcnt(0)" ::: "memory");
    const int c = lane & 7;
    f32x4 s0 = (f32x4){t.cs, t.cs, t.cs, t.cs}, s1 = s0;
    if (t.scale) { s0 = *(const f32x4*)(t.scale + 8 * c) * t.cs; s1 = *(const f32x4*)(t.scale + 8 * c + 4) * t.cs; }
#pragma unroll
    for (int j = 0; j < 4; ++j) { const int n = (lane >> 3) + 8 * j; const LAS float* s = scr + (8 * c) * 33 + n;
        u32x4 o; o.x = pk2bf(s[0 * 33] * s0[0], s[1 * 33] * s0[1]); o.y = pk2bf(s[2 * 33] * s0[2], s[3 * 33] * s0[3]); o.z = pk2bf(s[4 * 33] * s1[0], s[5 * 33] * s1[1]); o.w = pk2bf(s[6 * 33] * s1[2], s[7 * 33] * s1[3]);
        if (!t.i8) *(u32x4*)(t.dst + (size_t)n * t.ldt + 8 * c) = o;
        else { unsigned lo = 0u, hi = 0u;
#pragma unroll
            for (int e = 0; e < 4; ++e) { lo |= ((unsigned)(int)rintf(s[e * 33] * s0[e]) & 0xffu) << (8 * e); hi |= ((unsigned)(int)rintf(s[(4 + e) * 33] * s1[e]) & 0xffu) << (8 * e); }
            *(u32x2*)((unsigned char*)t.dst + (size_t)n * t.ldt + 8 * c) = (u32x2){lo, hi}; } }
    asm volatile("s_waitcnt lgkmcnt(0)" ::: "memory");
}
__device__ __forceinline__ int win_src_col(int n) {
    if (n < 768 || n >= 2304) return n;
    const int q = n - 768, j = q >> 8, r = q & 255;
    return r < 128 ? 768 + j * 128 + r : 1536 + j * 128 + (r - 128);
}
__device__ __forceinline__ void phase_prologue(const Params& p, LAS unsigned char* lds, int skip) {
    int tid = threadIdx.x; asm volatile("" : "+v"(tid));
    const int lane = tid & 63, wave = __builtin_amdgcn_readfirstlane(tid >> 6), gw = blockIdx.x * NWAVE + wave;
    unsigned char* ws = p.ws;
    const float* x = p.in[0]; const float* g_mix = p.in[1]; const float* w_in = p.in[2];
    const float* lam_re = p.in[6]; const float* lam_im = p.in[7]; const float* log_dt = p.in[8]; const float* b_re = p.in[9]; const float* b_im = p.in[10];
    const float* w_glu = p.in[14]; const float* w_a = p.in[16]; const float* w_b = p.in[17]; const float* w_out = p.in[18]; const float* g_ffn = p.in[19]; const float* w_q = p.in[20];
    const float* k1 = p.in[21]; const float* k2 = p.in[22]; const float* eu = p.in[23]; const float* ev = p.in[24];
    const int hw = wave & 3, ghw = blockIdx.x * 4 + hw;
    if (wave >= 4) {
    { const int hs_b = (blockIdx.x * 4) >> 6; const float* keys = (hs_b & 1) ? k2 : k1;
      if (!(skip & 1)) {
#pragma unroll
        for (int k = 0; k < 16; ++k) { const int i = hw * 1024 + k * 64 + lane; *(LAS f32x4*)(lds + (size_t)i * 16) = *(const f32x4*)(keys + i * 4); }
        asm volatile("s_waitcnt vmcnt(0) lgkmcnt(0)" ::: "memory"); } }
    if (!(skip & 2)) { unsigned* ctl = (unsigned*)(ws + WS_CTL); float mxw = 0.f, mxa = 0.f; const int t4 = tid - 256;
#pragma unroll
        for (int j = 0; j < 18; ++j) { const int i4 = ((int)blockIdx.x * 18 + j) * 256 + t4; const f32x4 wv = *(const f32x4*)(w_in + (size_t)i4 * 4); const float gk = g_mix[(i4 * 4) / IN_COLS];
            mxw = fmaxf(mxw, fmaxf(fmaxf(fabsf(wv[0]), fabsf(wv[1])), fmaxf(fabsf(wv[2]), fabsf(wv[3]))) * fabsf(gk)); }
        for (int i4 = (int)blockIdx.x * 256 + t4; i4 < CONV_CH * 1024 / 4; i4 += NBLK * 256) { const f32x4 wv = *(const f32x4*)(w_a + (size_t)i4 * 4);
            mxa = fmaxf(mxa, fmaxf(fmaxf(fabsf(wv[0]), fabsf(wv[1])), fmaxf(fabsf(wv[2]), fabsf(wv[3])))); }
#pragma unroll
        for (int o = 1; o < 64; o <<= 1) { mxw = fmaxf(mxw, __shfl_xor(mxw, o)); mxa = fmaxf(mxa, __shfl_xor(mxa, o)); }
        if (lane == 0) { (void)__hip_atomic_fetch_max(&ctl[CTL_WMAX], __float_as_uint(mxw), __ATOMIC_RELAXED, __HIP_MEMORY_SCOPE_AGENT); (void)__hip_atomic_fetch_max(&ctl[CTL_AMAX], __float_as_uint(mxa), __ATOMIC_RELAXED, __HIP_MEMORY_SCOPE_AGENT); }
        asm volatile("s_waitcnt vmcnt(0)" ::: "memory");
        if (lane == 0) (void)xb_add(&ctl[CTL_WDONE], 1u); }
    if (!(skip & 1)) {
        const int hs = ghw >> 6, dblk = (ghw >> 2) & 15, jq = ghw & 3, d = dblk * 64 + lane;
        f32x4 wq[32];
#pragma unroll
        for (int i = 0; i < 32; ++i) wq[i] = *(const f32x4*)(w_q + (size_t)d * 2048 + hs * 128 + i * 4);
        const float gd = g_ffn[d];
        bf16_t* WS = (bf16_t*)(ws + WS_WS);
        for (int j = jq * 32; j < jq * 32 + 32; ++j) {
            const LAS f32x4* kp = (const LAS f32x4*)(lds + (size_t)j * 512); float s0 = 0.f, s1 = 0.f;
#pragma unroll
            for (int i = 0; i < 32; i += 2) { const f32x4 ka = kp[i], kb = kp[i + 1];
                s0 = fmaf(wq[i][0], ka[0], s0); s0 = fmaf(wq[i][1], ka[1], s0); s0 = fmaf(wq[i][2], ka[2], s0); s0 = fmaf(wq[i][3], ka[3], s0);
                s1 = fmaf(wq[i + 1][0], kb[0], s1); s1 = fmaf(wq[i + 1][1], kb[1], s1); s1 = fmaf(wq[i + 1][2], kb[2], s1); s1 = fmaf(wq[i + 1][3], kb[3], s1); }
            WS[(size_t)(hs * 128 + j) * D + d] = (bf16_t)(pk2bf((s0 + s1) * gd, 0.f) & 0xffffu);
        }
    }
    if (!(skip & 2)) {
        LAS float* scr = (LAS float*)(lds + 65536 + hw * 16384);
        constexpr int I_IN = 16 * 144, I_A = 12 * 32, I_B = 4 * 32, I_O = 16 * 32, I_G = 4 * 8, NIT = I_IN + I_A + I_B + I_O + I_G;
        float winq, waq;
        { unsigned* ctl = (unsigned*)(ws + WS_CTL); XB_SPIN(xb_ld(&ctl[CTL_WDONE]) < (unsigned)(4 * NBLK), ctl); const float wm = __uint_as_float(xb_ld(&ctl[CTL_WMAX])); winq = wm > 0.f ? 127.0f / wm : 1.0f;
          const float am = __uint_as_float(xb_ld(&ctl[CTL_AMAX])); waq = am > 0.f ? 127.0f / am : 1.0f; }
        auto decode = [=](int r) -> TrIt {
            if (r < I_IN) { const int kb = r / 144, nb = r % 144; return TrIt{w_in + (size_t)(kb * 64) * IN_COLS + win_src_col(nb * 32), (bf16_t*)(ws + WS_WIN + (size_t)(nb * 32) * 1024 + kb * 64), g_mix + kb * 64, IN_COLS, 1024, winq, 1}; } r -= I_IN;
            if (r < I_A) { const int kb = r / 32, nb = r % 32; return TrIt{w_a + (size_t)(kb * 64) * 1024 + nb * 32, (bf16_t*)(ws + WS_WA + (size_t)(nb * 32) * 768 + kb * 64), nullptr, 1024, 768, waq, 1}; }     r -= I_A;
            if (r < I_B) { const int kb = r / 32, nb = r % 32; return TrIt{w_b + (size_t)(kb * 64) * 1024 + nb * 32, (bf16_t*)(ws + WS_WB) + (size_t)(nb * 32) * 256 + kb * 64, nullptr, 1024, 256, 1.0f, 0}; } r -= I_B;
            if (r < I_O) { const int kb = r / 32, nb = r % 32; return TrIt{w_out + (size_t)(kb * 64) * 1024 + nb * 32, (bf16_t*)(ws + WS_WOUT) + (size_t)(nb * 32) * 1024 + kb * 64, nullptr, 1024, 1024, 1.0f, 0}; } r -= I_O;
            { const int kb = r / 8, nb = r % 8; return TrIt{w_glu + (size_t)(kb * 64) * 256 + nb * 32, (bf16_t*)(ws + WS_WGLU) + (size_t)(nb * 32) * 256 + kb * 64, nullptr, 256, 256, 1.0f, 0}; }
        };
        static_assert(NIT >= 3 * (NGW / 2) && NIT <= 4 * (NGW / 2), "three or four transpose items per wave");
        const bool has3 = ghw + 3 * (NGW / 2) < NIT;
        const TrIt t0 = decode(ghw), t1 = decode(ghw + NGW / 2), t2 = decode(ghw + 2 * (NGW / 2)), t3 = decode(has3 ? ghw + 3 * (NGW / 2) : ghw);
        float v0[32], v1[32], v2[32], v3[32];
        tr_load(t0, lane, v0); tr_load(t1, lane, v1); tr_load(t2, lane, v2); if (has3) tr_load(t3, lane, v3);
        tr_flush(t0, v0, scr, lane); tr_flush(t1, v1, scr, lane); tr_flush(t2, v2, scr, lane); if (has3) tr_flush(t3, v3, scr, lane);
    }
    if (!(skip & 16)) {
        const int g = blockIdx.x >> 4, h = blockIdx.x & 15;
        const float dt = expf(log_dt[g]);
        bf16_t* MEND = (bf16_t*)(ws + WS_MEND); bf16_t* MY = (bf16_t*)(ws + WS_MY);
        {
            const int gp = g * 64 + lane; const float lr = lam_re[gp], li = lam_im[gp];
            float sn1, cs1; sincosf(li * dt, &sn1, &cs1); const float mag1 = expf(lr * dt), ar = mag1 * cs1, ai = mag1 * sn1;
            const float den = lr * lr + li * li, nr = ar - 1.0f, ni = ai, kr = (nr * lr + ni * li) / den, ki = (ni * lr - nr * li) / den;
            float bbr[16], bbi[16];
#pragma unroll
            for (int q = 0; q < 4; ++q) { const f32x4 br = *(const f32x4*)(b_re + (size_t)gp * 16 + q * 4), bi = *(const f32x4*)(b_im + (size_t)gp * 16 + q * 4);
#pragma unroll
                for (int c = 0; c < 4; ++c) { bbr[q * 4 + c] = kr * br[c] - ki * bi[c]; bbi[q * 4 + c] = kr * bi[c] + ki * br[c]; } }
            const float cr = p.in[11][(g * 16 + h) * 64 + lane], ci = p.in[12][(g * 16 + h) * 64 + lane];
            const bool b32 = lane & 32, b16 = lane & 16, b8 = lane & 8, b4 = lane & 4;
            const int jl = ((lane >> 5) & 1) * 8 + ((lane >> 4) & 1) * 4 + ((lane >> 3) & 1) * 2 + ((lane >> 2) & 1);
            LAS float* KCL = (LAS float*)(lds + 77824);
            float pr, pi; { const float d0 = (float)(hw * (CL / 4)); float sn, cs; sincosf(li * dt * d0, &sn, &cs); const float mg = expf(lr * dt * d0); pr = mg * cs; pi = mg * sn; }
#pragma unroll 1
            for (int d = hw * (CL / 4); d < (hw + 1) * (CL / 4); ++d) {
                const float wr_ = cr * pr - ci * pi, wi_ = cr * pi + ci * pr;
                float pd[16];
#pragma unroll
                for (int e = 0; e < 16; ++e) pd[e] = wr_ * bbr[e] - wi_ * bbi[e];
                float q8[8], q4[4], q2[2];
#pragma unroll
                for (int j = 0; j < 8; ++j) { const float keep = b32 ? pd[8 + j] : pd[j], send = b32 ? pd[j] : pd[8 + j]; q8[j] = keep + __shfl_xor(send, 32); }
#pragma unroll
                for (int j = 0; j < 4; ++j) { const float keep = b16 ? q8[4 + j] : q8[j], send = b16 ? q8[j] : q8[4 + j]; q4[j] = keep + __shfl_xor(send, 16); }
#pragma unroll
                for (int j = 0; j < 2; ++j) { const float keep = b8 ? q4[2 + j] : q4[j], send = b8 ? q4[j] : q4[2 + j]; q2[j] = keep + __shfl_xor(send, 8); }
                float hsum; { const float keep = b4 ? q2[1] : q2[0], send = b4 ? q2[0] : q2[1]; hsum = keep + __shfl_xor(send, 4); }
                hsum += __shfl_xor(hsum, 2); hsum += __shfl_xor(hsum, 1);
                if ((lane & 3) == 0) KCL[d * 16 + jl] = hsum;
                const float npr = pr * ar - pi * ai, npi = pr * ai + pi * ar; pr = npr; pi = npi;
            }
        }
        {
            constexpr int JP = CL / 16;
            const int it = tid - 256, n = 16 * h + (it >> 4), jseg = it & 15;
            bf16_t* rowp = MEND + (size_t)(g * 256 + n) * CK;
            if (n < 128) {
                const int gp = g * 64 + (n & 63); const float lr = lam_re[gp], li = lam_im[gp];
                float sn1, cs1; sincosf(li * dt, &sn1, &cs1); const float mag1 = expf(lr * dt), ar = mag1 * cs1, ai = mag1 * sn1;
                const float den = lr * lr + li * li, nr = ar - 1.0f, ni = ai, kr = (nr * lr + ni * li) / den, ki = (ni * lr - nr * li) / den;
                float bbr[16], bbi[16];
#pragma unroll
                for (int q = 0; q < 4; ++q) { const f32x4 br = *(const f32x4*)(b_re + (size_t)gp * 16 + q * 4), bi = *(const f32x4*)(b_im + (size_t)gp * 16 + q * 4);
#pragma unroll
                    for (int c = 0; c < 4; ++c) { bbr[q * 4 + c] = kr * br[c] - ki * bi[c]; bbi[q * 4 + c] = kr * bi[c] + ki * br[c]; } }
                float pr, pi; { const float d0 = (float)(CL - 1 - (jseg * JP + JP - 1)); float sn, cs; sincosf(li * dt * d0, &sn, &cs); const float mg = expf(lr * dt * d0); pr = mg * cs; pi = mg * sn; }
#pragma unroll
                for (int jj = JP - 1; jj >= 0; --jj) { const int jp = jseg * JP + jj;
                    float v[16];
#pragma unroll
                    for (int e = 0; e < 16; ++e) v[e] = n < 64 ? pr * bbr[e] - pi * bbi[e] : pr * bbi[e] + pi * bbr[e];
                    u32x4 o; o.x = pk2bf(v[0], v[1]); o.y = pk2bf(v[2], v[3]); o.z = pk2bf(v[4], v[5]); o.w = pk2bf(v[6], v[7]); *(u32x4*)(rowp + jp * 16) = o;
                    o.x = pk2bf(v[8], v[9]); o.y = pk2bf(v[10], v[11]); o.z = pk2bf(v[12], v[13]); o.w = pk2bf(v[14], v[15]); *(u32x4*)(rowp + jp * 16 + 8) = o;
                    const float npr = pr * ar - pi * ai, npi = pr * ai + pi * ar; pr = npr; pi = npi; }
            } else {
#pragma unroll
                for (int jj = 0; jj < JP; ++jj) { *(u32x4*)(rowp + (jseg * JP + jj) * 16) = (u32x4){0u, 0u, 0u, 0u}; *(u32x4*)(rowp + (jseg * JP + jj) * 16 + 8) = (u32x4){0u, 0u, 0u, 0u}; }
            }
        }
        {
            const int it = tid - 256, pp = it & 63, jseg = it >> 6, gp = g * 64 + pp; const float lr = lam_re[gp], li = lam_im[gp];
            float sn1, cs1; sincosf(li * dt, &sn1, &cs1); const float mag1 = expf(lr * dt), ar = mag1 * cs1, ai = mag1 * sn1;
            const float cr = p.in[11][(g * 16 + h) * 64 + pp], ci = p.in[12][(g * 16 + h) * 64 + pp];
            float pr, pi; { const float d0 = (float)(jseg * (CL / 4) + 1); float sn, cs; sincosf(li * dt * d0, &sn, &cs); const float mg = expf(lr * dt * d0); pr = mg * cs; pi = mg * sn; }
#pragma unroll 1
            for (int j = jseg * (CL / 4); j < (jseg + 1) * (CL / 4); ++j) {
                bf16_t* rowp = MY + ((size_t)(g * CK + j * 16 + h)) * SUK;
                rowp[CK + pp] = (bf16_t)(pk2bf(cr * pr - ci * pi, 0.f) & 0xffffu); rowp[CK + 64 + pp] = (bf16_t)(pk2bf(-(cr * pi + ci * pr), 0.f) & 0xffffu);
                const float npr = pr * ar - pi * ai, npi = pr * ai + pi * ar; pr = npr; pi = npi;
            }
        }
    }
    }
    if (wave < 4) {
    if (!(skip & 4)) {
        unsigned char* XB8 = ws + WS_XB8; float* XSC = (float*)(ws + WS_XSC);
        for (int t0 = ghw; t0 < T; t0 += 2 * NGW) {
            f32x4 a[4][4];
#pragma unroll
            for (int u = 0; u < 4; ++u) { const float* xr = x + (size_t)(t0 + u * (NGW / 2)) * D;
                a[u][0] = *(const f32x4*)(xr + lane * 8); a[u][1] = *(const f32x4*)(xr + lane * 8 + 4); a[u][2] = *(const f32x4*)(xr + 512 + lane * 8); a[u][3] = *(const f32x4*)(xr + 512 + lane * 8 + 4); }
#pragma unroll
            for (int u = 0; u < 4; ++u) { const int t = t0 + u * (NGW / 2); float sq = 0.f, mx = 0.f;
#pragma unroll
                for (int q = 0; q < 4; ++q) { sq += (a[u][q][0] * a[u][q][0] + a[u][q][1] * a[u][q][1]) + (a[u][q][2] * a[u][q][2] + a[u][q][3] * a[u][q][3]);
                    mx = fmaxf(mx, fmaxf(fmaxf(fabsf(a[u][q][0]), fabsf(a[u][q][1])), fmaxf(fabsf(a[u][q][2]), fabsf(a[u][q][3])))); }
                sq = wave_sum(sq);
#pragma unroll
                for (int o = 1; o < 64; o <<= 1) mx = fmaxf(mx, __shfl_xor(mx, o));
                const float rsd = rsqrtf(sq * (1.0f / D) + RMS_EPS), qi = mx > 0.f ? 127.0f / mx : 1.0f;
                if (lane == 0) XSC[t] = (mx > 0.f ? mx * (1.0f / 127.0f) : 1.0f) * rsd;
                unsigned d4[4];
#pragma unroll
                for (int q = 0; q < 4; ++q) { unsigned d = 0;
#pragma unroll
                    for (int c = 0; c < 4; ++c) d |= ((unsigned)(int)rintf(a[u][q][c] * qi) & 0xffu) << (8 * c);
                    d4[q] = d; }
                *(u32x2*)(XB8 + (size_t)t * D + lane * 8) = (u32x2){d4[0], d4[1]}; *(u32x2*)(XB8 + (size_t)t * D + 512 + lane * 8) = (u32x2){d4[2], d4[3]}; }
        }
    }
    if (!(skip & 8)) {
        unsigned char* UQ = ws + WS_UH; unsigned char* VQ = ws + WS_VH; float* USC = (float*)(ws + WS_USC); float* VSC = (float*)(ws + WS_VSC);
        f32x4 gf[4];
#pragma unroll
        for (int q = 0; q < 4; ++q) gf[q] = *(const f32x4*)(g_ffn + lane * 16 + q * 4);
        for (int r0 = ghw; r0 < 2 * 16384; r0 += 2 * NGW) {
            f32x4 v[4][4];
#pragma unroll
            for (int u = 0; u < 4; ++u) { const int r = r0 + u * (NGW / 2); const bool isv = r >= 16384; const int e = isv ? r - 16384 : r; const float* src = (isv ? ev : eu) + (size_t)e * D + lane * 16;
#pragma unroll
                for (int q = 0; q < 4; ++q) v[u][q] = *(const f32x4*)(src + q * 4); }
#pragma unroll
            for (int u = 0; u < 4; ++u) { const int r = r0 + u * (NGW / 2); const bool isv = r >= 16384; const int e = isv ? r - 16384 : r;
                float mx = 0.f;
#pragma unroll
                for (int q = 0; q < 4; ++q) { if (!isv) v[u][q] = v[u][q] * gf[q];
#pragma unroll
                    for (int c = 0; c < 4; ++c) mx = fmaxf(mx, fabsf(v[u][q][c])); }
#pragma unroll
                for (int o = 1; o < 64; o <<= 1) mx = fmaxf(mx, __shfl_xor(mx, o));
                const float sc = mx > 0.f ? mx * (1.0f / 127.0f) : 1.0f, inv = 1.0f / sc;
                u32x4 w;
#pragma unroll
                for (int q = 0; q < 4; ++q) { unsigned d = 0;
#pragma unroll
                    for (int c = 0; c < 4; ++c) { int qi = (int)rintf(v[u][q][c] * inv); qi = qi > 127 ? 127 : (qi < -127 ? -127 : qi); d |= ((unsigned)qi & 0xffu) << (8 * c); }
                    w[q] = d; }
                *(u32x4*)((isv ? VQ : UQ) + ((size_t)(lane >> 3) * 16384 + e) * 128 + (lane & 7) * 16) = w;
                if (lane == 0) (isv ? VSC : USC)[e] = sc; }
        }
    }
    }
    asm volatile("s_waitcnt lgkmcnt(0)" ::: "memory");
    __syncthreads();
    if (!(skip & 16)) {
        const int g = blockIdx.x >> 4, h = blockIdx.x & 15; bf16_t* MY = (bf16_t*)(ws + WS_MY); const LAS float* KCL = (const LAS float*)(lds + 77824);
        for (int it = tid; it < CL * (CK / 8); it += NTHR) {
            const int j = it / (CK / 8), kc = it % (CK / 8), jp = kc >> 1, h0 = (kc & 1) * 8;
            u32x4 w = (u32x4){0u, 0u, 0u, 0u};
            if (j >= jp) { const LAS f32x4* src = (const LAS f32x4*)(KCL + (j - jp) * 16 + h0); const f32x4 a = src[0], b = src[1]; w = pack8(a, b); }
            *(u32x4*)(MY + ((size_t)(g * CK + j * 16 + h)) * SUK + kc * 8) = w;
        }
    }
}

__device__ __forceinline__ void phase_ssm_tables(const Params& p) {
    unsigned char* ws = p.ws; const float* c_re = p.in[11]; const float* c_im = p.in[12];
    const float* POW = (const float*)(ws + WS_POW); const float* BBAR = (const float*)(ws + WS_BBAR);
    float* KC = (float*)(ws + WS_KC); bf16_t* MEND = (bf16_t*)(ws + WS_MEND);
    int tid = threadIdx.x; asm volatile("" : "+v"(tid));
    const int gt = blockIdx.x * NTHR + tid, NT = NBLK * NTHR;
    {
        const int lane = tid & 63, wave = __builtin_amdgcn_readfirstlane(tid >> 6), gw = blockIdx.x * NWAVE + wave;
        const bool b32 = lane & 32, b16 = lane & 16, b8 = lane & 8, b4 = lane & 4;
        const int jl = ((lane >> 5) & 1) * 8 + ((lane >> 4) & 1) * 4 + ((lane >> 3) & 1) * 2 + ((lane >> 2) & 1);
        for (int it = gw; it < 16 * 64 * 16; it += NGW) {
            const int g = it >> 10, d = (it >> 4) & 63, h = it & 15;
            const float cr = c_re[(g * 16 + h) * 64 + lane], ci = c_im[(g * 16 + h) * 64 + lane];
            const float pr = POW[((size_t)(g * 65 + d) * 64 + lane) * 2], pi = POW[((size_t)(g * 65 + d) * 64 + lane) * 2 + 1];
            const float wr_ = cr * pr - ci * pi, wi_ = cr * pi + ci * pr;
            const f32x4* bb = (const f32x4*)(BBAR + (size_t)(g * 64 + lane) * 32);
            float pd[16];
#pragma unroll
            for (int q = 0; q < 8; ++q) { const f32x4 v = bb[q]; pd[2 * q] = wr_ * v[0] - wi_ * v[1]; pd[2 * q + 1] = wr_ * v[2] - wi_ * v[3]; }
            float q8[8], q4[4], q2[2];
#pragma unroll
            for (int j = 0; j < 8; ++j) { const float keep = b32 ? pd[8 + j] : pd[j], send = b32 ? pd[j] : pd[8 + j]; q8[j] = keep + __shfl_xor(send, 32); }
#pragma unroll
            for (int j = 0; j < 4; ++j) { const float keep = b16 ? q8[4 + j] : q8[j], send = b16 ? q8[j] : q8[4 + j]; q4[j] = keep + __shfl_xor(send, 16); }
#pragma unroll
            for (int j = 0; j < 2; ++j) { const float keep = b8 ? q4[2 + j] : q4[j], send = b8 ? q4[j] : q4[2 + j]; q2[j] = keep + __shfl_xor(send, 8); }
            float hsum; { const float keep = b4 ? q2[1] : q2[0], send = b4 ? q2[0] : q2[1]; hsum = keep + __shfl_xor(send, 4); }
            hsum += __shfl_xor(hsum, 2); hsum += __shfl_xor(hsum, 1);
            if ((lane & 3) == 0) KC[(size_t)it * 16 + jl] = hsum;
        }
    }
    for (int i = gt; i < 16 * 256 * 128; i += NT) {
        const int g = i >> 15, n = (i >> 7) & 255, k8 = (i & 127) * 8, jp = k8 >> 4, h0 = k8 & 15;
        u32x4 o = (u32x4){0u, 0u, 0u, 0u};
        if (n < 128) {
            const int pp = n & 63; const float pr = POW[((size_t)(g * 65 + 63 - jp) * 64 + pp) * 2], pi = POW[((size_t)(g * 65 + 63 - jp) * 64 + pp) * 2 + 1];
            float v[8];
#pragma unroll
            for (int e = 0; e < 8; ++e) { const float br = BBAR[((size_t)(g * 64 + pp) * 16 + h0 + e) * 2], bi = BBAR[((size_t)(g * 64 + pp) * 16 + h0 + e) * 2 + 1];
                v[e] = n < 64 ? pr * br - pi * bi : pr * bi + pi * br; }
            o.x = pk2bf(v[0], v[1]); o.y = pk2bf(v[2], v[3]); o.z = pk2bf(v[4], v[5]); o.w = pk2bf(v[6], v[7]);
        }
        *(u32x4*)(MEND + (size_t)i * 8) = o;
    }
}

__device__ __forceinline__ void phase_conv_my(const Params& p, int first_block) {
    if ((int)blockIdx.x < first_block) return;
    unsigned char* ws = p.ws; const float* conv_w = p.in[4]; const float* conv_b = p.in[5]; const float* c_re = p.in[11]; const float* c_im = p.in[12];
    const bf16_t* CB = (const bf16_t*)(ws + WS_CB); const bf16_t* V = (const bf16_t*)(ws + WS_V); bf16_t* A2 = (bf16_t*)(ws + WS_A2);
    const float* KC = (const float*)(ws + WS_KC); const float* POW = (const float*)(ws + WS_POW); bf16_t* MY = (bf16_t*)(ws + WS_MY);
    int tid = threadIdx.x; asm volatile("" : "+v"(tid));
    const int nb = NBLK - first_block, gt = ((int)blockIdx.x - first_block) * NTHR + tid, NT = nb * NTHR;
    const int lane = tid & 63, wave = __builtin_amdgcn_readfirstlane(tid >> 6), gw = ((int)blockIdx.x - first_block) * NWAVE + wave, NW = nb * NWAVE;
    unsigned char* A8 = ws + WS_A2; float* A2S = (float*)(ws + WS_A2S);
    float w0[12], w1[12], w2[12], bb[12];
#pragma unroll
    for (int e = 0; e < 12; ++e) { const int j = lane * 12 + e; w0[e] = conv_w[j]; w1[e] = conv_w[CONV_CH + j]; w2[e] = conv_w[2 * CONV_CH + j]; bb[e] = conv_b[j]; }
    for (int it = gw; it < T / 8; it += NW) {
        const int t0 = it * 8;
        unsigned vm2[6], vm1[6];
#pragma unroll
        for (int k = 0; k < 6; ++k) { vm2[k] = 0u; vm1[k] = 0u; }
        if ((t0 & (SEQ - 1)) != 0) {
#pragma unroll
            for (int k = 0; k < 3; ++k) { const u32x2 q2 = *(const u32x2*)(V + (size_t)(t0 - 2) * CONV_CH + lane * 12 + k * 4), q1 = *(const u32x2*)(V + (size_t)(t0 - 1) * CONV_CH + lane * 12 + k * 4);
                vm2[2 * k] = q2.x; vm2[2 * k + 1] = q2.y; vm1[2 * k] = q1.x; vm1[2 * k + 1] = q1.y; } }
        u32x2 cb4[8][3], v4[8][3];
#pragma unroll
        for (int u = 0; u < 8; ++u)
#pragma unroll
            for (int k = 0; k < 3; ++k) { const size_t o = (size_t)(t0 + u) * CONV_CH + lane * 12 + k * 4; cb4[u][k] = *(const u32x2*)(CB + o); v4[u][k] = *(const u32x2*)(V + o); }
#pragma unroll
        for (int u = 0; u < 8; ++u) { const int t = t0 + u;
            float r[12]; float mx = 0.f;
#pragma unroll
            for (int e = 0; e < 12; ++e) { const unsigned dc = (e & 2) ? cb4[u][e >> 2].y : cb4[u][e >> 2].x, d0 = (e & 2) ? v4[u][e >> 2].y : v4[u][e >> 2].x, d1 = vm1[e >> 1], d2 = vm2[e >> 1];
                const float fc = (e & 1) ? bfhi(dc) : bflo(dc), f0 = (e & 1) ? bfhi(d0) : bflo(d0), f1 = (e & 1) ? bfhi(d1) : bflo(d1), f2 = (e & 1) ? bfhi(d2) : bflo(d2);
                r[e] = fc * (bb[e] + w0[e] * f2 + w1[e] * f1 + w2[e] * f0); mx = fmaxf(mx, fabsf(r[e])); }
#pragma unroll
            for (int o = 1; o < 64; o <<= 1) mx = fmaxf(mx, __shfl_xor(mx, o));
            const float qi = mx > 0.f ? 127.0f / mx : 1.0f;
            if (lane == 0) A2S[t] = mx > 0.f ? mx * (1.0f / 127.0f) : 1.0f;
#pragma unroll
            for (int k = 0; k < 3; ++k) { unsigned d = 0;
#pragma unroll
                for (int c = 0; c < 4; ++c) d |= ((unsigned)(int)rintf(r[k * 4 + c] * qi) & 0xffu) << (8 * c);
                *(unsigned*)(A8 + (size_t)t * CONV_CH + lane * 12 + k * 4) = d; }
#pragma unroll
            for (int k = 0; k < 3; ++k) { vm2[2 * k] = vm1[2 * k]; vm2[2 * k + 1] = vm1[2 * k + 1]; vm1[2 * k] = v4[u][k].x; vm1[2 * k + 1] = v4[u][k].y; } }
    }
}

__device__ __forceinline__ void phase_carry(const Params& p, LAS unsigned char* lds, int b, int g) {
    constexpr int CPW = CPS / NWAVE;
    static_assert(CPS == BM, "one end-state GEMM row tile per sequence");
    int tid = threadIdx.x; asm volatile("" : "+v"(tid));
    const int lane = tid & 63, wave = __builtin_amdgcn_readfirstlane(tid >> 6);
    unsigned char* ws = p.ws; const float* E = (const float*)(ws + WS_E); bf16_t* SU = (bf16_t*)(ws + WS_SU);
    const size_t ch0 = (size_t)g * NCHUNK + b * CPS + wave * CPW;
    float er[CPW], ei[CPW];
#pragma unroll
    for (int k = 0; k < CPW; ++k) { er[k] = E[(ch0 + k) * 128 + lane]; ei[k] = E[(ch0 + k) * 128 + 64 + lane]; }
    float ar, ai; { const float lr = p.in[6][g * 64 + lane], li = p.in[7][g * 64 + lane], dt = expf(p.in[8][g]); float sn, cs; sincosf(li * dt * (float)CL, &sn, &cs); const float mg = expf(lr * dt * (float)CL); ar = mg * cs; ai = mg * sn; }
    float sr = 0.f, si = 0.f, mr = 1.f, mi = 0.f;
#pragma unroll
    for (int k = 0; k < CPW; ++k) { const float nr = ar * sr - ai * si + er[k], ni = ar * si + ai * sr + ei[k]; sr = nr; si = ni; const float tr = mr * ar - mi * ai, ti = mr * ai + mi * ar; mr = tr; mi = ti; }
    LAS float* seg = (LAS float*)lds;
    seg[(wave * 2) * 64 + lane] = sr; seg[(wave * 2 + 1) * 64 + lane] = si;
    __syncthreads();
    float xr = 0.f, xi = 0.f;
    for (int w = 0; w < wave; ++w) { const float qr = seg[(w * 2) * 64 + lane], qi = seg[(w * 2 + 1) * 64 + lane]; const float nr = mr * xr - mi * xi + qr, ni = mr * xi + mi * xr + qi; xr = nr; xi = ni; }
#pragma unroll
    for (int k = 0; k < CPW; ++k) {
        SU[(ch0 + k) * SUK + CK + lane] = (bf16_t)(pk2bf(xr, 0.f) & 0xffffu); SU[(ch0 + k) * SUK + CK + 64 + lane] = (bf16_t)(pk2bf(xi, 0.f) & 0xffffu);
        const float nr = ar * xr - ai * xi + er[k], ni = ar * xi + ai * xr + ei[k]; xr = nr; xi = ni; }
    __syncthreads();
}

__device__ __forceinline__ void ins16(float (&a)[16], float x, float big) {
#pragma unroll
    for (int k = 15; k >= 1; --k) a[k] = __builtin_amdgcn_fmed3f(a[k - 1], a[k], x);
    a[0] = __builtin_amdgcn_fmed3f(a[0], x, big);
}
__device__ __forceinline__ void ins16r(float (&a)[16], float x, float big, int R) {
#pragma unroll
    for (int k = 15; k >= 1; --k) if (k >= R) a[k] = __builtin_amdgcn_fmed3f(a[k - 1], a[k], x);
    if (R == 0) a[0] = __builtin_amdgcn_fmed3f(a[0], x, big);
}
__device__ __forceinline__ void ce_desc(float& hi, float& lo, float big) { const float h = __builtin_amdgcn_fmed3f(hi, lo, big), l = __builtin_amdgcn_fmed3f(hi, lo, -big); hi = h; lo = l; }
__device__ __forceinline__ void sort16_desc(float (&a)[16], float big) {
#pragma unroll
    for (int p = 1; p < 16; p <<= 1)
#pragma unroll
        for (int k = p; k >= 1; k >>= 1)
#pragma unroll
            for (int j = k % p; j + k < 16; j += 2 * k)
#pragma unroll
                for (int i = 0; i < k; ++i)
                    if (i + j + k < 16 && (i + j) / (2 * p) == (i + j + k) / (2 * p)) ce_desc(a[i + j], a[i + j + k], big);
}
__device__ __forceinline__ void top16_of_sorted(float (&a)[16], const float (&x)[16], const float (&y)[16], float big) {
#pragma unroll
    for (int i = 0; i < 16; ++i) a[i] = __builtin_amdgcn_fmed3f(x[i], y[15 - i], big);
#pragma unroll
    for (int d = 8; d >= 1; d >>= 1)
#pragma unroll
        for (int i = 0; i < 16; ++i) if (!(i & d)) ce_desc(a[i], a[i + d], big);
}
__device__ __forceinline__ void phase_topk(const Params& p, LAS unsigned char* lds) {
    unsigned char* ws = p.ws; const unsigned char* SC8 = ws + WS_SC; const float sstep = ((const float*)(ws + WS_SIGW))[blockIdx.x];
    unsigned short* EIDX = (unsigned short*)(ws + WS_EIDX); unsigned short* GATE = (unsigned short*)(ws + WS_GATE);
    int tid = threadIdx.x; asm volatile("" : "+v"(tid));
    const int lane = tid & 63, wave = __builtin_amdgcn_readfirstlane(tid >> 6);
    LAS unsigned char* wst = lds + wave * 17408;
    LAS unsigned* myl = (LAS unsigned*)(wst + lane * 32);
    const float NINF = -__builtin_inff(); float BIG = 3.0e38f; asm volatile("" : "+s"(BIG));
    const int tw0 = blockIdx.x * (T / NBLK) + wave * (T / NGW);
#define TK_LOAD(it_) do { _Pragma("unroll") for (int i = 0; i < 8; ++i)     \
        r[i] = *(const u32x4*)(SC8 + (size_t)(tw0 + (it_) * 4) * 2048 + (size_t)(i * 64 + lane) * 16); } while (0)
    u32x4 r[8];
    TK_LOAD(0);
#pragma unroll 1
    for (int item = 0; item < (T / NGW) / 4; ++item) {
        const int t = tw0 + item * 4 + (lane >> 4), hs = lane & 15, h = hs >> 1, odd = lane & 1;
        float a[16];
        {
#pragma unroll
            for (int i = 0; i < 8; ++i) *(LAS u32x4*)(wst + (i * 8 + (lane >> 3)) * 144 + (lane & 7) * 16) = r[i];
            if (item + 1 < (T / NGW) / 4) TK_LOAD(item + 1);
            float xs[16], ys[16];
#pragma unroll
            for (int c = 0; c < 8; ++c) { const u32x4 v = *(const LAS u32x4*)(wst + lane * 144 + c * 16);
#pragma unroll
                for (int e = 0; e < 4; ++e) { const unsigned dw = v[e]; const unsigned ib = (unsigned)(c * 16 + 4 * e);
                    const float k0 = __uint_as_float(__float_as_uint((float)(dw & 0xffu)) | ib), k1 = __uint_as_float(__float_as_uint((float)((dw >> 8) & 0xffu)) | (ib + 1u));
                    const float k2 = __uint_as_float(__float_as_uint((float)((dw >> 16) & 0xffu)) | (ib + 2u)), k3 = __uint_as_float(__float_as_uint((float)(dw >> 24)) | (ib + 3u));
                    const float w2 = __builtin_amdgcn_fmed3f(__builtin_amdgcn_fmed3f(k0, k1, BIG), __builtin_amdgcn_fmed3f(k2, k3, BIG), BIG);
                    if (c < 4) xs[4 * c + e] = w2; else ys[4 * (c - 4) + e] = w2; }
                if (c == 3) sort16_desc(xs, BIG);
                __builtin_amdgcn_sched_barrier(0); }
            sort16_desc(ys, BIG);
            top16_of_sorted(a, xs, ys, BIG);
            { unsigned pi[15]; float l2[15];
#pragma unroll
              for (int k = 0; k < 15; ++k) pi[k] = ((__float_as_uint(a[k]) & 127u) >> 1) ^ 1u;
#pragma unroll
              for (int k = 0; k < 15; ++k) { const unsigned pr = *(const LAS unsigned short*)(wst + lane * 144 + pi[k] * 2);
                  const float k0 = __uint_as_float(__float_as_uint((float)(pr & 0xffu)) | (pi[k] * 2u)), k1 = __uint_as_float(__float_as_uint((float)(pr >> 8)) | (pi[k] * 2u + 1u));
                  l2[k] = __builtin_amdgcn_fmed3f(k0, k1, BIG); }
#pragma unroll
              for (int k = 0; k < 15; ++k) ins16r(a, l2[k], BIG, k + 1); }
            unsigned li[15]; float lk[15];
#pragma unroll
            for (int k = 0; k < 15; ++k) li[k] = (__float_as_uint(a[k]) & 127u) ^ 1u;
#pragma unroll
            for (int k = 0; k < 15; ++k) { const unsigned bb = *(const LAS unsigned char*)(wst + lane * 144 + li[k]); lk[k] = __uint_as_float(__float_as_uint((float)bb) | li[k]); }
#pragma unroll
            for (int k = 0; k < 15; ++k) ins16r(a, lk[k], BIG, k + 1);
        }
        float A[16], B[16];
#pragma unroll
        for (int k = 0; k < 16; ++k) { const float o = __shfl_xor(a[k], 1); A[k] = odd ? o : a[k]; B[k] = odd ? a[k] : o; }
        float f[16];
#pragma unroll
        for (int k = 0; k < 16; ++k) f[k] = NINF;
#pragma unroll
        for (int ia = 0; ia < 16; ++ia)
#pragma unroll
            for (int ib = 0; ib < 16; ++ib)
                if ((ia + 1) * (ib + 1) <= 16) {
                    const unsigned sb = __float_as_uint(A[ia] + B[ib]), sg = (unsigned)((int)sb >> 31);
                    ins16r(f, __uint_as_float((sb & ~255u) | ((sg ^ (255u - (unsigned)(ia * 16 + ib))) & 255u)), BIG, (ia + 1) * (ib + 1) - 1); }
        u32x4 wa, wb;
        wa.x = (__float_as_uint(A[0]) & 127u) | ((__float_as_uint(A[1]) & 127u) << 8) | ((__float_as_uint(A[2]) & 127u) << 16) | ((__float_as_uint(A[3]) & 127u) << 24);
        wa.y = (__float_as_uint(A[4]) & 127u) | ((__float_as_uint(A[5]) & 127u) << 8) | ((__float_as_uint(A[6]) & 127u) << 16) | ((__float_as_uint(A[7]) & 127u) << 24);
        wa.z = (__float_as_uint(A[8]) & 127u) | ((__float_as_uint(A[9]) & 127u) << 8) | ((__float_as_uint(A[10]) & 127u) << 16) | ((__float_as_uint(A[11]) & 127u) << 24);
        wa.w = (__float_as_uint(A[12]) & 127u) | ((__float_as_uint(A[13]) & 127u) << 8) | ((__float_as_uint(A[14]) & 127u) << 16) | ((__float_as_uint(A[15]) & 127u) << 24);
        wb.x = (__float_as_uint(B[0]) & 127u) | ((__float_as_uint(B[1]) & 127u) << 8) | ((__float_as_uint(B[2]) & 127u) << 16) | ((__float_as_uint(B[3]) & 127u) << 24);
        wb.y = (__float_as_uint(B[4]) & 127u) | ((__float_as_uint(B[5]) & 127u) << 8) | ((__float_as_uint(B[6]) & 127u) << 16) | ((__float_as_uint(B[7]) & 127u) << 24);
        wb.z = (__float_as_uint(B[8]) & 127u) | ((__float_as_uint(B[9]) & 127u) << 8) | ((__float_as_uint(B[10]) & 127u) << 16) | ((__float_as_uint(B[11]) & 127u) << 24);
        wb.w = (__float_as_uint(B[12]) & 127u) | ((__float_as_uint(B[13]) & 127u) << 8) | ((__float_as_uint(B[14]) & 127u) << 16) | ((__float_as_uint(B[15]) & 127u) << 24);
        *(LAS u32x4*)myl = wa; *(LAS u32x4*)(myl + 4) = wb;
        float ex[16], sum = 0.f;
#pragma unroll
        for (int k = 0; k < 16; ++k) { ex[k] = __expf((f[k] - f[0]) * sstep); sum += ex[k]; }
        const float inv = 1.0f / sum;
        int eo[8]; float go[8]; const unsigned omask = odd ? 0xffffffffu : 0u;
        const LAS unsigned char* mb = (const LAS unsigned char*)myl;
#pragma unroll
        for (int r = 0; r < 8; ++r) {
            const unsigned fsel = (__float_as_uint(f[8 + r]) & omask) | (__float_as_uint(f[r]) & ~omask);
            const unsigned code = ~(fsel ^ (unsigned)((int)fsel >> 31)) & 255u;
            const unsigned i1 = mb[code >> 4], i2 = mb[16 + (code & 15u)];
            eo[r] = (int)(i1 * 128u + i2); go[r] = __uint_as_float((__float_as_uint(ex[8 + r]) & omask) | (__float_as_uint(ex[r]) & ~omask)) * inv;
        }
        const size_t ob = ((size_t)t * 8 + h) * 16 + odd * 8;
        *(u32x4*)(EIDX + ob) = (u32x4){(unsigned)eo[0] | ((unsigned)eo[1] << 16), (unsigned)eo[2] | ((unsigned)eo[3] << 16), (unsigned)eo[4] | ((unsigned)eo[5] << 16), (unsigned)eo[6] | ((unsigned)eo[7] << 16)};
        *(u32x4*)(GATE + ob) = (u32x4){pk2h(go[0], go[1]), pk2h(go[2], go[3]), pk2h(go[4], go[5]), pk2h(go[6], go[7])};
    }
}

#undef TK_LOAD
#define LANE_OF(j) ((((j) >> 3) & 1) * 32 + (((j) >> 2) & 1) * 16 + (((j) >> 1) & 1) * 8 + ((j) & 1) * 4)
__device__ __forceinline__ void axpy4u(float* acc, unsigned d, float w) {
    acc[0] = fmaf((float)(d & 0xffu), w, acc[0]); acc[1] = fmaf((float)((d >> 8) & 0xffu), w, acc[1]);
    acc[2] = fmaf((float)((d >> 16) & 0xffu), w, acc[2]); acc[3] = fmaf((float)(d >> 24), w, acc[3]);
}
constexpr int TPB = T / NBLK, TPW = TPB / NWAVE;
__device__ __forceinline__ void phase_xq(const Params& p) {
    unsigned char* ws = p.ws; const bf16_t* X1B = (const bf16_t*)(ws + WS_X1B); const float* RS2P = (const float*)(ws + WS_RS2P); unsigned char* XQ = ws + WS_XQ; float* HSG = (float*)(ws + WS_HSG);
    int tid = threadIdx.x; asm volatile("" : "+v"(tid));
    const int lane = tid & 63, wave = __builtin_amdgcn_readfirstlane(tid >> 6);
    const int t0 = (int)blockIdx.x * TPB + wave * TPW;
#pragma unroll 1
    for (int q0 = 0; q0 < TPW; q0 += 4) {
        u32x4 xa4[4], xb4[4]; float sq4[4];
#pragma unroll
        for (int u = 0; u < 4; ++u) { const size_t t = (size_t)(t0 + q0 + u);
            xa4[u] = *(const u32x4*)(X1B + t * D + lane * 16); xb4[u] = *(const u32x4*)(X1B + t * D + lane * 16 + 8);
            sq4[u] = (lane < 16) ? RS2P[t * 16 + lane] : 0.f; }
#pragma unroll
        for (int u = 0; u < 4; ++u) { const size_t t = (size_t)(t0 + q0 + u); const u32x4 xa = xa4[u], xb = xb4[u];
            float xf[16];
            xf[0] = bflo(xa.x); xf[1] = bfhi(xa.x); xf[2] = bflo(xa.y); xf[3] = bfhi(xa.y); xf[4] = bflo(xa.z); xf[5] = bfhi(xa.z); xf[6] = bflo(xa.w); xf[7] = bfhi(xa.w);
            xf[8] = bflo(xb.x); xf[9] = bfhi(xb.x); xf[10] = bflo(xb.y); xf[11] = bfhi(xb.y); xf[12] = bflo(xb.z); xf[13] = bfhi(xb.z); xf[14] = bflo(xb.w); xf[15] = bfhi(xb.w);
            float mx = 0.f;
#pragma unroll
            for (int i = 0; i < 16; ++i) mx = fmaxf(mx, fabsf(xf[i]));
#pragma unroll
            for (int o = 1; o < 64; o <<= 1) mx = fmaxf(mx, __shfl_xor(mx, o));
            const float xsc = mx > 0.f ? mx * (1.0f / 127.0f) : 1.0f, xinv = 1.0f / xsc;
            u32x4 xq;
#pragma unroll
            for (int k = 0; k < 4; ++k) { unsigned d = 0;
#pragma unroll
                for (int c = 0; c < 4; ++c) d |= ((unsigned)(int)rintf(xf[k * 4 + c] * xinv) & 0xffu) << (8 * c);
                xq[k] = d; }
            *(u32x4*)(XQ + t * D + lane * 16) = xq;
            const float ssq = wave_sum(sq4[u]);
            if (lane == 0) HSG[t] = rsqrtf(ssq * (1.0f / D) + RMS_EPS) * xsc; }
    }
}
constexpr int EX_EL = 0, EX_HA = TPB * 128 * 2, EX_HS = EX_HA + TPB * 128 * 4, EX_WS = EX_HS + TPB * 4, EX_SS = EX_WS + TPB * 4;
static_assert(EX_SS + TPB * 4 <= LDS_STAGE && NWAVE * 17408 <= LDS_BYTES, "expert phase / routing LDS");
__device__ __forceinline__ void phase_expert(const Params& p, LAS unsigned char* lds) {
    unsigned char* ws = p.ws;
    const bf16_t* X1B = (const bf16_t*)(ws + WS_X1B); const float* RS2P = (const float*)(ws + WS_RS2P);
    const unsigned short* EIDX = (const unsigned short*)(ws + WS_EIDX); const unsigned short* GATE = (const unsigned short*)(ws + WS_GATE);
    const unsigned char* UQ = ws + WS_UH; const unsigned char* VQ = ws + WS_VH; const float* USC = (const float*)(ws + WS_USC); const float* VSC = (const float*)(ws + WS_VSC);
    unsigned char* XQ = ws + WS_XQ;
    const float* gfin = p.in[25]; float* out = p.out;
    unsigned char* const SCb = ws + WS_SC;
    auto x2tmp = [=](size_t t) -> bf16_t* { return (bf16_t*)(SCb + t * 2048); };
    int tid = threadIdx.x; asm volatile("" : "+v"(tid));
    const int lane = tid & 63, wave = __builtin_amdgcn_readfirstlane(tid >> 6);
    const int g = lane >> 3, ch = lane & 7;
    const bool b1 = lane & 1, b2 = lane & 2, b4 = lane & 4, b8 = lane & 8, b16 = lane & 16, b32 = lane & 32;
    LAS unsigned short* EL = (LAS unsigned short*)(lds + EX_EL); LAS int* HA = (LAS int*)(lds + EX_HA);
    LAS float* HS = (LAS float*)(lds + EX_HS); LAS float* WSUM = (LAS float*)(lds + EX_WS); LAS float* SSQ = (LAS float*)(lds + EX_SS);
    const int tl0 = wave * TPW, tg0 = blockIdx.x * TPB;
    { const float* HSG = (const float*)(ws + WS_HSG);
#pragma unroll 1
      for (int q0 = 0; q0 < TPW; q0 += 4) {
        unsigned ew4[4]; float hs4[4];
#pragma unroll
        for (int u = 0; u < 4; ++u) { const size_t t = (size_t)(tg0 + tl0 + q0 + u); ew4[u] = *(const unsigned*)(EIDX + t * 128 + 2 * lane); hs4[u] = HSG[t]; }
#pragma unroll
        for (int u = 0; u < 4; ++u) { const int tl = tl0 + q0 + u;
            if (lane == 0) { HS[tl] = hs4[u]; SSQ[tl] = 0.f; }
            *(LAS unsigned*)(EL + tl * 128 + 2 * lane) = ew4[u];
            HA[tl * 128 + lane] = 0; HA[tl * 128 + 64 + lane] = 0; } } }
    asm volatile("s_waitcnt vmcnt(0) lgkmcnt(0)" ::: "memory");
    __syncthreads();
#define EXU_LOAD(R, XS, q_) do { const int tl_ = tl0 + (q_); XS = *(const u32x4*)(XQ + (size_t)(tg0 + tl_) * D + s * 128 + ch * 16); \
        _Pragma("unroll") for (int i = 0; i < 16; ++i) { const int e_ = EL[tl_ * 128 + 8 * i + g]; R[i] = *(const u32x4*)(usl + (unsigned)(e_ * 128 + ch * 16)); } } while (0)
#define EXU_COMP(R, XS, q_) do { const int tl_ = tl0 + (q_); int pd[16]; \
        _Pragma("unroll") for (int i = 0; i < 16; ++i) { int sd = dot4z(R[i].x, (int)XS.x); sd = __builtin_amdgcn_sdot4((int)R[i].y, (int)XS.y, sd, false); \
            sd = __builtin_amdgcn_sdot4((int)R[i].z, (int)XS.z, sd, false); sd = __builtin_amdgcn_sdot4((int)R[i].w, (int)XS.w, sd, false); pd[i] = sd; } \
        int q8[8], q4[4], q2[2]; \
        _Pragma("unroll") for (int j = 0; j < 8; ++j) { const int keep = b4 ? pd[8 + j] : pd[j], send = b4 ? pd[j] : pd[8 + j]; q8[j] = keep + __shfl_xor(send, 4); } \
        _Pragma("unroll") for (int j = 0; j < 4; ++j) { const int keep = b2 ? q8[4 + j] : q8[j], send = b2 ? q8[j] : q8[4 + j]; q4[j] = keep + __shfl_xor(send, 2); } \
        _Pragma("unroll") for (int j = 0; j < 2; ++j) { const int keep = b1 ? q4[2 + j] : q4[j], send = b1 ? q4[j] : q4[2 + j]; q2[j] = keep + __shfl_xor(send, 1); } \
        HA[tl_ * 128 + 16 * ch + g] += q2[0]; HA[tl_ * 128 + 16 * ch + 8 + g] += q2[1]; } while (0)
#pragma unroll 1
    for (int s = 0; s < 8; ++s) {
        u32x4 ra[16], rb[16], xsa, xsb; const unsigned char* usl = UQ + (size_t)s * (16384 * 128);
        EXU_LOAD(ra, xsa, 0);
#pragma unroll 1
        for (int q = 0; q < TPW; q += 2) {
            EXU_LOAD(rb, xsb, q + 1);
            EXU_COMP(ra, xsa, q);
            if (q + 2 < TPW) EXU_LOAD(ra, xsa, q + 2);
            EXU_COMP(rb, xsb, q + 1);
        }
    }
#undef EXU_LOAD
#undef EXU_COMP
#pragma unroll 1
    for (int q0 = 0; q0 < TPW; q0 += 4) {
        float hv[4][2], us[4][2], vs[4][2], gt[4][2];
#pragma unroll
        for (int u = 0; u < 4; ++u) { const int tl = tl0 + q0 + u; const size_t t = (size_t)(tg0 + tl);
#pragma unroll
            for (int hlf = 0; hlf < 2; ++hlf) { const int k = hlf * 64 + lane; const int e = EL[tl * 128 + k];
                hv[u][hlf] = (float)HA[tl * 128 + k]; us[u][hlf] = USC[e]; vs[u][hlf] = VSC[e]; gt[u][hlf] = (float)__builtin_bit_cast(_Float16, GATE[t * 128 + k]); } }
#pragma unroll
        for (int u = 0; u < 4; ++u) { const int tl = tl0 + q0 + u; const float hs = HS[tl];
            float w2[2];
#pragma unroll
            for (int hlf = 0; hlf < 2; ++hlf) w2[hlf] = gt[u][hlf] * gelu_exact(hv[u][hlf] * (hs * us[u][hlf])) * vs[u][hlf];
            float wm = fmaxf(fabsf(w2[0]), fabsf(w2[1]));
#pragma unroll
            for (int o = 1; o < 64; o <<= 1) wm = fmaxf(wm, __shfl_xor(wm, o));
            const float wsc = wm > 0.f ? wm * (1.0f / 127.0f) : 1.0f, winv = 1.0f / wsc;
            LAS signed char* WQ = (LAS signed char*)(HA + tl * 128);
#pragma unroll
            for (int hlf = 0; hlf < 2; ++hlf) { const int i = hlf * 8 + (lane >> 3), gg = lane & 7;
                WQ[((i >> 2) * 8 + gg) * 4 + (i & 3)] = (signed char)(int)rintf(w2[hlf] * winv); }
            if (lane == 0) WSUM[tl] = wsc; }
    }
    typedef int v4i_t __attribute__((ext_vector_type(4)));
    const bool vvalid = ((g & 1) == (g >> 2));
    const int chb = 4 * ((g >> 1) & 1) + (b32 ? 2 : 0);
    const int colo0 = chb * 16 + 2 * ch, colo1 = colo0 + 16;
    const int x40 = (lane ^ 40) * 4;
    unsigned mk[8];
#pragma unroll
    for (int i = 0; i < 8; ++i) mk[i] = (ch == i) ? 0xffffffffu : 0u;
#define EXV_LOAD(R, XR0, XR1, q_, WX) do { const int tl_ = tl0 + (q_); const bf16_t* xp_ = X1B + (size_t)(tg0 + tl_) * D + s * 128; \
        _Pragma("unroll") for (int i = 0; i < 16; ++i) { const int e_ = EL[tl_ * 128 + 8 * i + g]; R[i] = *(const u32x4*)(vsl + (unsigned)(e_ * 128 + ch * 16)); } \
        asm volatile("" ::: "memory"); if (WX) { XR0 = *(const unsigned*)(xp_ + colo0); XR1 = *(const unsigned*)(xp_ + colo1); } } while (0)
#define EXV_LOADP(PK0, PK1, q_) do { if (lane < 56) { const bf16_t* pr_ = x2tmp((size_t)(tg0 + tl0 + (q_))) + lane * 16; PK0 = *(const u32x4*)pr_; PK1 = *(const u32x4*)(pr_ + 8); \
        const bf16_t* xw_ = X1B + (size_t)(tg0 + tl0 + (q_)) * D + lane * 16; PK0##x = *(const u32x4*)xw_; PK1##x = *(const u32x4*)(xw_ + 8); } } while (0)
#define EXV_COMP(R, XR0, XR1, q_, FIN, PK0, PK1) do { const int tl_ = tl0 + (q_); const size_t t_ = (size_t)(tg0 + tl_); \
        int wd_[4]; _Pragma("unroll") for (int a = 0; a < 4; ++a) wd_[a] = HA[tl_ * 128 + a * 8 + g]; \
        v4i_t ac0_ = {0, 0, 0, 0}, ac1_ = {0, 0, 0, 0}; \
        _Pragma("unroll") for (int c4 = 0; c4 < 4; ++c4) { unsigned tt_[4][4]; \
            _Pragma("unroll") for (int a = 0; a < 4; ++a) { const unsigned x0 = R[4 * a][c4], x1 = R[4 * a + 1][c4], x2 = R[4 * a + 2][c4], x3 = R[4 * a + 3][c4]; \
                const unsigned p01l = __builtin_amdgcn_perm(x1, x0, 0x05010400u), p01h = __builtin_amdgcn_perm(x1, x0, 0x07030602u), p23l = __builtin_amdgcn_perm(x3, x2, 0x05010400u), p23h = __builtin_amdgcn_perm(x3, x2, 0x07030602u); \
                tt_[a][0] = __builtin_amdgcn_perm(p23l, p01l, 0x05040100u); tt_[a][1] = __builtin_amdgcn_perm(p23l, p01l, 0x07060302u); \
                tt_[a][2] = __builtin_amdgcn_perm(p23h, p01h, 0x05040100u); tt_[a][3] = __builtin_amdgcn_perm(p23h, p01h, 0x07060302u); } \
            _Pragma("unroll") for (int hk = 0; hk < 2; ++hk) { const unsigned m_ = mk[2 * c4 + hk]; \
                const v4i_t bw_ = {(int)((unsigned)wd_[0] & m_), (int)((unsigned)wd_[1] & m_), (int)((unsigned)wd_[2] & m_), (int)((unsigned)wd_[3] & m_)}; \
                const v4i_t a0_ = {(int)tt_[0][2 * hk], (int)tt_[1][2 * hk], (int)tt_[2][2 * hk], (int)tt_[3][2 * hk]}, a1_ = {(int)tt_[0][2 * hk + 1], (int)tt_[1][2 * hk + 1], (int)tt_[2][2 * hk + 1], (int)tt_[3][2 * hk + 1]}; \
                ac0_ = __builtin_amdgcn_mfma_i32_16x16x64_i8(a0_, bw_, ac0_, 0, 0, 0); ac1_ = __builtin_amdgcn_mfma_i32_16x16x64_i8(a1_, bw_, ac1_, 0, 0, 0); } } \
        int fin_[2][2]; \
        _Pragma("unroll") for (int jj = 0; jj < 2; ++jj) { \
            { const int keep = b32 ? ac0_[2 + jj] : ac0_[jj], send = b32 ? ac0_[jj] : ac0_[2 + jj]; fin_[jj][0] = keep + __builtin_amdgcn_ds_bpermute(x40, send); } \
            { const int keep = b32 ? ac1_[2 + jj] : ac1_[jj], send = b32 ? ac1_[jj] : ac1_[2 + jj]; fin_[jj][1] = keep + __builtin_amdgcn_ds_bpermute(x40, send); } } \
        const float wsc_ = WSUM[tl_]; \
        if (!(FIN)) {     \
            if (vvalid) { bf16_t* pr_ = x2tmp(t_) + s * 128; *(unsigned*)(pr_ + colo0) = pk2bf(wsc_ * (float)fin_[0][0], wsc_ * (float)fin_[0][1]); *(unsigned*)(pr_ + colo1) = pk2bf(wsc_ * (float)fin_[1][0], wsc_ * (float)fin_[1][1]); } } \
        else {     \
            const unsigned xr0_ = XR0, xr1_ = XR1; \
            const float v00_ = bflo(xr0_) + wsc_ * (float)fin_[0][0], v01_ = bfhi(xr0_) + wsc_ * (float)fin_[0][1], v10_ = bflo(xr1_) + wsc_ * (float)fin_[1][0], v11_ = bfhi(xr1_) + wsc_ * (float)fin_[1][1]; \
            float ss_ = vvalid ? (v00_ * v00_ + v01_ * v01_) + (v10_ * v10_ + v11_ * v11_) : 0.f; \
            const u32x4 xa_ = PK0, xb_ = PK1, ya_ = PK0##x, yb_ = PK1##x; \
            const f32x4 r0_ = (f32x4){bflo(xa_.x) + bflo(ya_.x), bfhi(xa_.x) + bfhi(ya_.x), bflo(xa_.y) + bflo(ya_.y), bfhi(xa_.y) + bfhi(ya_.y)}, r1_ = (f32x4){bflo(xa_.z) + bflo(ya_.z), bfhi(xa_.z) + bfhi(ya_.z), bflo(xa_.w) + bflo(ya_.w), bfhi(xa_.w) + bfhi(ya_.w)}; \
            const f32x4 r2_ = (f32x4){bflo(xb_.x) + bflo(yb_.x), bfhi(xb_.x) + bfhi(yb_.x), bflo(xb_.y) + bflo(yb_.y), bfhi(xb_.y) + bfhi(yb_.y)}, r3_ = (f32x4){bflo(xb_.z) + bflo(yb_.z), bfhi(xb_.z) + bfhi(yb_.z), bflo(xb_.w) + bflo(yb_.w), bfhi(xb_.w) + bfhi(yb_.w)}; \
            if (lane < 56) { const f32x4 sqv_ = r0_ * r0_ + r1_ * r1_ + r2_ * r2_ + r3_ * r3_; ss_ += (sqv_[0] + sqv_[1]) + (sqv_[2] + sqv_[3]); } \
            ss_ = wave_sum(ss_); \
            const float rn_ = rsqrtf(ss_ * (1.0f / D) + RMS_EPS); float* orow_ = out + t_ * D; \
            if (vvalid) { *(f32x2*)(orow_ + s * 128 + colo0) = (f32x2){v00_ * rn_ * g7[0], v01_ * rn_ * g7[1]}; *(f32x2*)(orow_ + s * 128 + colo1) = (f32x2){v10_ * rn_ * g7[2], v11_ * rn_ * g7[3]}; } \
            if (lane < 56) { float* ol_ = orow_ + lane * 16; \
                *(f32x4*)(ol_) = r0_ * rn_ * gn0; *(f32x4*)(ol_ + 4) = r1_ * rn_ * gn1; *(f32x4*)(ol_ + 8) = r2_ * rn_ * gn2; *(f32x4*)(ol_ + 12) = r3_ * rn_ * gn3; } } } while (0)
    const f32x4 gn0 = *(const f32x4*)(gfin + lane * 16), gn1 = *(const f32x4*)(gfin + lane * 16 + 4), gn2 = *(const f32x4*)(gfin + lane * 16 + 8), gn3 = *(const f32x4*)(gfin + lane * 16 + 12);
    const float g7[4] = {gfin[7 * 128 + colo0], gfin[7 * 128 + colo0 + 1], gfin[7 * 128 + colo1], gfin[7 * 128 + colo1 + 1]};
    u32x4 pa0 = {0u, 0u, 0u, 0u}, pa1 = pa0, pb0 = pa0, pb1 = pa0, pa0x = pa0, pa1x = pa0, pb0x = pa0, pb1x = pa0;
#pragma unroll 1
    for (int s = 0; s < 7; ++s) {
        u32x4 ra[16], rb[16]; unsigned xra0 = 0u, xra1 = 0u, xrb0 = 0u, xrb1 = 0u; const unsigned char* vsl = VQ + (size_t)s * (16384 * 128);
        EXV_LOAD(ra, xra0, xra1, 0, 0);
#pragma unroll 1
        for (int q = 0; q < TPW; q += 2) {
            EXV_LOAD(rb, xrb0, xrb1, q + 1, 0);
            EXV_COMP(ra, xra0, xra1, q, 0, pa0, pa1);
            if (q + 2 < TPW) EXV_LOAD(ra, xra0, xra1, q + 2, 0);
            EXV_COMP(rb, xrb0, xrb1, q + 1, 0, pb0, pb1);
        }
    }
    {
        constexpr int s = 7;
        u32x4 ra[16], rb[16]; unsigned xra0, xra1, xrb0, xrb1; const unsigned char* vsl = VQ + (size_t)s * (16384 * 128);
        EXV_LOAD(ra, xra0, xra1, 0, 1); EXV_LOADP(pa0, pa1, 0);
#pragma unroll 1
        for (int q = 0; q < TPW; q += 2) {
            EXV_LOAD(rb, xrb0, xrb1, q + 1, 1); EXV_LOADP(pb0, pb1, q + 1);
            EXV_COMP(ra, xra0, xra1, q, 1, pa0, pa1);
            if (q + 2 < TPW) { EXV_LOAD(ra, xra0, xra1, q + 2, 1); EXV_LOADP(pa0, pa1, q + 2); }
            EXV_COMP(rb, xrb0, xrb1, q + 1, 1, pb0, pb1);
        }
    }
#undef EXV_LOAD
#undef EXV_LOADP
#undef EXV_COMP
    asm volatile("s_waitcnt vmcnt(0) lgkmcnt(0)" ::: "memory");
}

#if DBG
constexpr int SSM_CH = 256, SSM_GROUPS = 16, SSM_STATE = 64, SSM_GROUP = 16;
constexpr int PEER_HEADS = 8, PEER_KEYS = 128, PEER_HALF = 128, PEER_TOPK = 16, PEER_QD = 2048;
__device__ __forceinline__ float sigm_n(float v) { return 1.0f / (1.0f + expf(-v)); }
__global__ void __launch_bounds__(256) ngemm(const float* __restrict__ A, int lda, const float* __restrict__ B, int ldb,
                                             float* __restrict__ C, int ldc, int M, int N, int K) {
    __shared__ float As[16][64 + 4];
    __shared__ float Bs[16][64 + 4];
    const int tx = threadIdx.x & 15, ty = threadIdx.x >> 4;
    const int bm = blockIdx.y * 64, bn = blockIdx.x * 64;
    float acc[4][4] = {};
    for (int k0 = 0; k0 < K; k0 += 16) {
        {
            const int r = threadIdx.x >> 2, c4 = (threadIdx.x & 3) * 4;
            const float4 v = *(const float4*)(A + (size_t)(bm + r) * lda + k0 + c4);
            As[c4 + 0][r] = v.x; As[c4 + 1][r] = v.y; As[c4 + 2][r] = v.z; As[c4 + 3][r] = v.w;
            const int rb = threadIdx.x >> 4, cb4 = (threadIdx.x & 15) * 4;
            const float4 w = *(const float4*)(B + (size_t)(k0 + rb) * ldb + bn + cb4);
            Bs[rb][cb4 + 0] = w.x; Bs[rb][cb4 + 1] = w.y; Bs[rb][cb4 + 2] = w.z; Bs[rb][cb4 + 3] = w.w;
        }
        __syncthreads();
#pragma unroll
        for (int k = 0; k < 16; ++k) {
            float a[4], b[4];
#pragma unroll
            for (int i = 0; i < 4; ++i) a[i] = As[k][ty * 4 + i];
#pragma unroll
            for (int j = 0; j < 4; ++j) b[j] = Bs[k][tx * 4 + j];
#pragma unroll
            for (int i = 0; i < 4; ++i)
#pragma unroll
                for (int j = 0; j < 4; ++j) acc[i][j] = fmaf(a[i], b[j], acc[i][j]);
        }
        __syncthreads();
    }
#pragma unroll
    for (int i = 0; i < 4; ++i) {
        float4 o = make_float4(acc[i][0], acc[i][1], acc[i][2], acc[i][3]);
        *(float4*)(C + (size_t)(bm + ty * 4 + i) * ldc + bn + tx * 4) = o;
    }
}

__global__ void __launch_bounds__(256) n_rmsnorm(const float* __restrict__ x, const float* __restrict__ g, float* __restrict__ y) {
    __shared__ float red[4];
    const size_t row = blockIdx.x;
    const float4 v = *(const float4*)(x + row * D + threadIdx.x * 4);
    float s = v.x * v.x + v.y * v.y + v.z * v.z + v.w * v.w;
    for (int o = 32; o > 0; o >>= 1) s += __shfl_xor(s, o);
    if ((threadIdx.x & 63) == 0) red[threadIdx.x >> 6] = s;
    __syncthreads();
    const float tot = red[0] + red[1] + red[2] + red[3];
    const float r = rsqrtf(tot * (1.0f / D) + RMS_EPS);
    const float4 gg = *(const float4*)(g + threadIdx.x * 4);
    float4 o = make_float4(v.x * r * gg.x, v.y * r * gg.y, v.z * r * gg.z, v.w * r * gg.w);
    *(float4*)(y + row * D + threadIdx.x * 4) = o;
}

__global__ void __launch_bounds__(256) n_conv(const float* __restrict__ proj, const float* __restrict__ cw, const float* __restrict__ cbias,
                                              float* __restrict__ am, int S) {
    const size_t i = (size_t)blockIdx.x * 256 + threadIdx.x;
    const int t = (int)(i / CONV_CH), j = (int)(i % CONV_CH);
    if (t >= S) return;
    const float* pr = proj + (size_t)t * IN_COLS;
    float y = cbias[j];
#pragma unroll
    for (int k = 0; k < 3; ++k) {
        const int tt = t - 2 + k;
        if (tt >= 0) { const float* q = proj + (size_t)tt * IN_COLS; y += cw[k * CONV_CH + j] * (q[CONV_CH + j] * q[2 * CONV_CH + j]); }
    }
    am[(size_t)t * CONV_CH + j] = pr[j] * y;
}

__global__ void n_ssm_const(const float* lam_re, const float* lam_im, const float* log_dt, float* cst) {
    const int i = blockIdx.x * blockDim.x + threadIdx.x;
    if (i >= 1024) return;
    const int g = i >> 6;
    const float lr = lam_re[i], li = lam_im[i], dt = expf(log_dt[g]);
    const float mag = expf(lr * dt), ang = li * dt;
    const float ar = mag * cosf(ang), ai = mag * sinf(ang);
    const float den = lr * lr + li * li, nr = ar - 1.0f, ni = ai;
    cst[i] = ar; cst[1024 + i] = ai; cst[2048 + i] = (nr * lr + ni * li) / den; cst[3072 + i] = (ni * lr - nr * li) / den;
}
__global__ void __launch_bounds__(256) n_ssm_x(const float* __restrict__ proj, const float* __restrict__ bre, const float* __restrict__ bim,
                                               const float* __restrict__ cst, float* __restrict__ xr, float* __restrict__ xi, int S) {
    const size_t i = (size_t)blockIdx.x * 256 + threadIdx.x;
    const int t = (int)(i >> 10), gp = (int)(i & 1023), g = gp >> 6;
    if (t >= S) return;
    const float* u = proj + (size_t)t * IN_COLS + 3 * CONV_CH + g * 16;
    float br = 0.f, bi = 0.f;
#pragma unroll
    for (int h = 0; h < 16; ++h) { br = fmaf(u[h], bre[gp * 16 + h], br); bi = fmaf(u[h], bim[gp * 16 + h], bi); }
    const float kr = cst[2048 + gp], ki = cst[3072 + gp];
    xr[i] = kr * br - ki * bi; xi[i] = kr * bi + ki * br;
}
__global__ void __launch_bounds__(256) n_ssm_scan(const float* __restrict__ cst, float* __restrict__ xr, float* __restrict__ xi, int S) {
    const int gp = blockIdx.x * 256 + threadIdx.x;
    const float ar = cst[gp], ai = cst[1024 + gp];
    float sr = 0.f, si = 0.f;
    for (int t = 0; t < S; ++t) {
        const size_t o = (size_t)t * 1024 + gp;
        const float a = xr[o], b = xi[o];
        const float nr = ar * sr - ai * si + a, ni = ar * si + ai * sr + b;
        sr = nr; si = ni; xr[o] = sr; xi[o] = si;
    }
}
__global__ void __launch_bounds__(256) n_ssm_y(const float* __restrict__ proj, const float* __restrict__ sr, const float* __restrict__ si,
                                               const float* __restrict__ cre, const float* __restrict__ cim, const float* __restrict__ dsk,
                                               float* __restrict__ z, int S) {
    const size_t i = (size_t)blockIdx.x * 256 + threadIdx.x;
    const int t = (int)(i >> 8), c = (int)(i & 255), g = c >> 4;
    if (t >= S) return;
    const float* a = sr + (size_t)t * 1024 + g * 64; const float* b = si + (size_t)t * 1024 + g * 64;
    float y = 0.f;
    for (int p = 0; p < 64; ++p) y += a[p] * cre[c * 64 + p] - b[p] * cim[c * 64 + p];
    y += dsk[c] * proj[(size_t)t * IN_COLS + 3 * CONV_CH + c];
    z[i] = gelu_exact(y);
}
__global__ void __launch_bounds__(256) n_glu(const float* __restrict__ z, const float* __restrict__ lin, const float* __restrict__ bglu, float* __restrict__ o, size_t n) {
    const size_t i = (size_t)blockIdx.x * 256 + threadIdx.x; if (i >= n) return;
    o[i] = z[i] * sigm_n(lin[i] + bglu[i & 255]);
}
__global__ void __launch_bounds__(256) n_merge(const float* __restrict__ proj, const float* __restrict__ bg, const float* __restrict__ ya,
                                               const float* __restrict__ yb, float* __restrict__ m, size_t n) {
    const size_t i = (size_t)blockIdx.x * 256 + threadIdx.x; if (i >= n) return;
    const size_t t = i >> 10; const int d = (int)(i & 1023);
    const float* gl = proj + t * IN_COLS + 3 * CONV_CH + SSM_CH;
    m[i] = sigm_n(gl[d] + bg[d]) * ya[i] + sigm_n(gl[D + d] + bg[D + d]) * yb[i];
}
__global__ void __launch_bounds__(256) n_add(const float* __restrict__ a, float* __restrict__ b, size_t n) {
    const size_t i = (size_t)blockIdx.x * 256 + threadIdx.x; if (i >= n) return; b[i] += a[i];
}

__device__ __forceinline__ void wave_argmax(float& v, int& idx) {
    for (int o = 32; o > 0; o >>= 1) {
        const float ov = __shfl_xor(v, o); const int oi = __shfl_xor(idx, o);
        if (ov > v || (ov == v && oi < idx)) { v = ov; idx = oi; }
    }
}
__global__ void __launch_bounds__(256) n_route(const float* __restrict__ q, const float* __restrict__ k1, const float* __restrict__ k2,
                                               int* __restrict__ eidx, float* __restrict__ gate) {
    __shared__ float qs[PEER_QD];
    __shared__ float sc[PEER_QD];
    __shared__ float tv[16][16]; __shared__ int ti[16][16];
    const size_t t = blockIdx.x; const int tid = threadIdx.x, lane = tid & 63, w = tid >> 6;
    for (int i = tid; i < PEER_QD; i += 256) qs[i] = q[t * PEER_QD + i];
    __syncthreads();
    for (int i = tid; i < PEER_QD; i += 256) {
        const int hs = i >> 7, n = i & 127, side = hs & 1;
        const float* kk = (side ? k2 : k1) + n * PEER_HALF; const float* qq = qs + hs * 128;
        float s = 0.f;
        for (int k = 0; k < 128; ++k) s = fmaf(qq[k], kk[k], s);
        sc[i] = s;
    }
    __syncthreads();
    for (int gi = 0; gi < 4; ++gi) {
        const int grp = w * 4 + gi;
        float a0 = sc[grp * 128 + lane], a1 = sc[grp * 128 + 64 + lane];
        for (int it = 0; it < 16; ++it) {
            float v; int idx;
            if (a0 >= a1) { v = a0; idx = lane; } else { v = a1; idx = lane + 64; }
            wave_argmax(v, idx);
            if (lane == 0) { tv[grp][it] = v; ti[grp][it] = idx; }
            if (idx == lane) a0 = -INFINITY; if (idx == lane + 64) a1 = -INFINITY;
        }
    }
    __syncthreads();
    for (int hh = 0; hh < 2; ++hh) {
        const int h = w * 2 + hh;
        float c[4]; int ci[4];
#pragma unroll
        for (int j = 0; j < 4; ++j) { const int pos = j * 64 + lane, a = pos >> 4, b = pos & 15; c[j] = tv[2 * h][a] + tv[2 * h + 1][b]; ci[j] = pos; }
        float bestv = 0.f; int beste = 0; float mx = 0.f;
        for (int it = 0; it < 16; ++it) {
            float v = c[0]; int idx = ci[0];
#pragma unroll
            for (int j = 1; j < 4; ++j) if (c[j] > v) { v = c[j]; idx = ci[j]; }
            wave_argmax(v, idx);
#pragma unroll
            for (int j = 0; j < 4; ++j) if (ci[j] == idx) c[j] = -INFINITY;
            if (it == 0) mx = v;
            if (lane == it) { bestv = v; beste = ti[2 * h][idx >> 4] * PEER_KEYS + ti[2 * h + 1][idx & 15]; }
        }
        float e = (lane < 16) ? expf(bestv - mx) : 0.f;
        float s = e; for (int o = 32; o > 0; o >>= 1) s += __shfl_xor(s, o);
        if (lane < 16) { eidx[t * 128 + h * 16 + lane] = beste; gate[t * 128 + h * 16 + lane] = e / s; }
    }
}

__global__ void __launch_bounds__(256) n_expert(const float* __restrict__ xn, const float* __restrict__ x1, const int* __restrict__ eidx,
                                                const float* __restrict__ gate, const float* __restrict__ eu, const float* __restrict__ ev,
                                                const float* __restrict__ gfin, float* __restrict__ out) {
    const size_t t = (size_t)blockIdx.x * 4 + (threadIdx.x >> 6); const int lane = threadIdx.x & 63;
    float4 xv[4], acc[4];
#pragma unroll
    for (int i = 0; i < 4; ++i) { xv[i] = *(const float4*)(xn + t * D + i * 256 + lane * 4); acc[i] = make_float4(0.f, 0.f, 0.f, 0.f); }
    for (int k = 0; k < 128; ++k) {
        const int e = eidx[t * 128 + k]; const float gt = gate[t * 128 + k];
        const float* ur = eu + (size_t)e * D; const float* vr = ev + (size_t)e * D;
        float s = 0.f;
#pragma unroll
        for (int i = 0; i < 4; ++i) { const float4 u = *(const float4*)(ur + i * 256 + lane * 4); s += u.x * xv[i].x + u.y * xv[i].y + u.z * xv[i].z + u.w * xv[i].w; }
        for (int o = 32; o > 0; o >>= 1) s += __shfl_xor(s, o);
        const float wgt = gt * gelu_exact(s);
#pragma unroll
        for (int i = 0; i < 4; ++i) { const float4 v = *(const float4*)(vr + i * 256 + lane * 4);
            acc[i].x = fmaf(wgt, v.x, acc[i].x); acc[i].y = fmaf(wgt, v.y, acc[i].y); acc[i].z = fmaf(wgt, v.z, acc[i].z); acc[i].w = fmaf(wgt, v.w, acc[i].w); }
    }
    float ss = 0.f;
#pragma unroll
    for (int i = 0; i < 4; ++i) { const float4 r = *(const float4*)(x1 + t * D + i * 256 + lane * 4);
        acc[i].x += r.x; acc[i].y += r.y; acc[i].z += r.z; acc[i].w += r.w;
        ss += acc[i].x * acc[i].x + acc[i].y * acc[i].y + acc[i].z * acc[i].z + acc[i].w * acc[i].w; }
    for (int o = 32; o > 0; o >>= 1) ss += __shfl_xor(ss, o);
    const float r = rsqrtf(ss * (1.0f / D) + RMS_EPS);
#pragma unroll
    for (int i = 0; i < 4; ++i) { const float4 g = *(const float4*)(gfin + i * 256 + lane * 4);
        *(float4*)(out + t * D + i * 256 + lane * 4) = make_float4(acc[i].x * r * g.x, acc[i].y * r * g.y, acc[i].z * r * g.z, acc[i].w * r * g.w); }
}


__device__ __forceinline__ float bf_at(const bf16_t* p, size_t i) { return __uint_as_float(((unsigned)p[i]) << 16); }
template <class F> __device__ __forceinline__ void dbg_cmp(unsigned char* ws, int id, int rows, int cols, F f) {
    float e2 = 0.f, r2 = 0.f;
    const size_t n = (size_t)rows * cols;
    int tid = threadIdx.x; asm volatile("" : "+v"(tid));
    for (size_t i = (size_t)blockIdx.x * NTHR + tid; i < n; i += (size_t)NBLK * NTHR) { float a, b; f((int)(i / cols), (int)(i % cols), a, b); e2 += (a - b) * (a - b); r2 += b * b; }
    e2 = wave_sum(e2); r2 = wave_sum(r2);
    if ((tid & 63) == 0) { atomicAdd((float*)(ws + DB_ACC) + id * 2, e2); atomicAdd((float*)(ws + DB_ACC) + id * 2 + 1, r2); }
}
__global__ void dbg_report(const float* acc, float* out, int n, int first_id) {
    float c = 0.f;
    for (int id = first_id; id < 32; ++id) { const float e2 = acc[id * 2], r2 = acc[id * 2 + 1]; if (r2 <= 0.f) continue; const float rel = sqrtf(e2 / r2);
        const float thr = id == 12 ? 0.22f : id == 13 ? 0.1f : DBG_THR;
        if (rel > thr || !(rel == rel)) { int d = (rel == rel) ? (int)(-4.0f * log10f(fminf(rel, 1.0f)) + 0.5f) : 9; if (d > 9) d = 9; c = sqrtf((float)(id * 10 + d) - 1.0f); break; } }
    for (int i = blockIdx.x * blockDim.x + threadIdx.x; i < n; i += gridDim.x * blockDim.x) out[i] = c;
}
#endif
__global__ void __launch_bounds__(512, 2) fwd_megakernel(Params p) {
    extern __shared__ __attribute__((aligned(16))) unsigned char smem[];
    LAS unsigned char* lds = (LAS unsigned char*)smem;
    unsigned char* ws = p.ws;
    volatile LAS unsigned* bst = (volatile LAS unsigned*)(lds + LDS_MISC);
    if (threadIdx.x < 4) bst[threadIdx.x] = 0u;
    if (threadIdx.x >= 256) {
#pragma unroll
        for (int k_ = 0; k_ < 2; ++k_) { const int i_ = (int)threadIdx.x - 256 + k_ * 256; *(LAS f32x4*)(lds + LDS_GBIAS + i_ * 16) = *(const f32x4*)(p.in[3] + i_ * 4) * 32.0f + 128.0f; } }
    __syncthreads();
    XcdBarrier bar = xcd_barrier_post((unsigned*)(ws + WS_CTL), bst);
    Order S;
    TSTAMP(0);
    for (int rep_ah = 0; rep_ah < REP_AH; ++rep_ah) {
    for (int rp_ = 0; rp_ < (REP_PH == 1 ? 2 : 1); ++rp_) {
    phase_prologue(p, lds, rp_ ? SKIPA : 0);
    xcd_barrier(bar); TSTAMP(1);
    }
    for (int rp_ = 0; rp_ < (REP_PH == 2 ? 2 : 1); ++rp_) {
    { Gemm g{(const bf16_t*)(ws + WS_XB8), (const bf16_t*)(ws + WS_WIN), 512, 512, 512, 0, 0}; S.init(T, IN_COLS, 1, 0);
      const float wmx_ = __uint_as_float(xb_ld((unsigned*)(ws + WS_CTL) + CTL_WMAX));
      EpiG1 e{(const LAS float*)(lds + LDS_GBIAS), (bf16_t*)(ws + WS_CB), (bf16_t*)(ws + WS_V), (bf16_t*)(ws + WS_SU), ws + WS_G, (const float*)(ws + WS_XSC), wmx_ > 0.f ? wmx_ * (1.0f / 127.0f) : 1.0f};
      if (NULLG1 == 1 && rp_) { EpiNull en; gemm_phase(lds, g, S, en); } else if (NULLG1 == 2 && rp_) { EpiG1T<true> en{(const LAS float*)(lds + LDS_GBIAS), nullptr, nullptr, nullptr, nullptr, (const float*)(ws + WS_XSC), 1.0f}; gemm_phase(lds, g, S, en); } else
      gemm_phase(lds, g, S, e); }
    xcd_barrier(bar); TSTAMP(2);
    DBGC({ const float* pj = (const float*)(ws + DB_PROJ); const float* bg = p.in[3];
      const bf16_t* CBp = (const bf16_t*)(ws + WS_CB); const bf16_t* Vp = (const bf16_t*)(ws + WS_V); const bf16_t* SUp = (const bf16_t*)(ws + WS_SU); const bf16_t* Gp = (const bf16_t*)(ws + WS_G);
      dbg_cmp(ws, 1, NB, 768, [=](int t, int c, float& a, float& b) { a = bf_at(CBp, (size_t)t * 768 + c); b = pj[(size_t)t * IN_COLS + c]; });
      dbg_cmp(ws, 2, NB, 768, [=](int t, int c, float& a, float& b) { a = bf_at(Vp, (size_t)t * 768 + c); b = pj[(size_t)t * IN_COLS + 768 + c] * pj[(size_t)t * IN_COLS + 1536 + c]; });
      dbg_cmp(ws, 3, NB, 256, [=](int t, int c, float& a, float& b) { a = bf_at(SUp, ((size_t)(c >> 4) * NCHUNK + (t >> LOGCL)) * SUK + (t & (CL - 1)) * 16 + (c & 15)); b = pj[(size_t)t * IN_COLS + 2304 + c]; });
      dbg_cmp(ws, 4, NB, 2048, [=](int t, int c, float& a, float& b) { a = bf_at(Gp, (size_t)t * 2048 + c); b = sigm_n(pj[(size_t)t * IN_COLS + 2560 + c] + bg[c]); }); })
    }
    for (int rp_ = 0; rp_ < (REP_PH == 3 ? 2 : 1); ++rp_) {
    phase_conv_my(p, 16 * (NCHUNK / BM));
    { Gemm g{(const bf16_t*)(ws + WS_SU), (const bf16_t*)(ws + WS_MEND), SUK, CK, CK, (long)NCHUNK * SUK, (long)256 * CK}; S.init(NCHUNK, 256, 16, 0); S.window(0, S.u1, 0, 16 * (NCHUNK / BM));
      EpiE e{(float*)(ws + WS_E)}; gemm_phase(lds, g, S, e); }
    if ((int)blockIdx.x < 16 * (NCHUNK / BM)) phase_carry(p, lds, (int)blockIdx.x % (NCHUNK / BM), (int)blockIdx.x / (NCHUNK / BM));
    xcd_barrier(bar); TSTAMP(3);
    DBGC({ const bf16_t* A2p = (const bf16_t*)(ws + WS_A2); const float* am = (const float*)(ws + DB_AM);
      dbg_cmp(ws, 5, NB, 768, [=](int t, int c, float& a, float& b) { a = bf_at(A2p, (size_t)t * 768 + c); b = am[(size_t)t * 768 + c]; }); })
    }
    for (int rp_ = 0; rp_ < (REP_PH == 4 ? 2 : 1); ++rp_) {
    { LAS float* lut_ = (LAS float*)(lds + LDS_GBIAS); const int b_ = (int)threadIdx.x >> 1; const float sg_ = 1.0f / (1.0f + __expf(((float)b_ - 128.0f) * (-1.0f / 32.0f)));
      *(LAS f32x4*)(lut_ + b_ * 8 + ((int)threadIdx.x & 1) * 4) = (f32x4){sg_, sg_, sg_, sg_}; __syncthreads(); }
    { Gemm g{(const bf16_t*)(ws + WS_A2), (const bf16_t*)(ws + WS_WA), 384, 384, 384, 0, 0};     S.init(T, 1024, 1, 0); S.window(0, S.u1 / 2, 0, NBLK);
      EpiP e{ws + WS_G, (bf16_t*)(ws + WS_P), (const LAS float*)(lds + LDS_GBIAS), (const float*)(ws + WS_A2S), __uint_as_float(xb_ld((unsigned*)(ws + WS_CTL) + CTL_AMAX)) * (1.0f / 127.0f)}; gemm_phase(lds, g, S, e); }
    }
    for (int rp_ = 0; rp_ < (REP_PH == 5 ? 2 : 1); ++rp_) {
    { Gemm g{(const bf16_t*)(ws + WS_SU), (const bf16_t*)(ws + WS_MY), SUK, SUK, SUK, (long)NCHUNK * SUK, (long)CK * SUK}; S.init(NCHUNK, CK, 16, 0); S.window(0, S.u1, 0, NBLK / 2);
      EpiY e{(const bf16_t*)(ws + WS_SU), p.in[13], (bf16_t*)(ws + WS_Z)}; gemm_phase(lds, g, S, e); }
    if ((int)blockIdx.x < NBLK / 2) {
        int tid_ = threadIdx.x; asm volatile("" : "+v"(tid_)); const int ln_ = tid_ & 63, wv_ = __builtin_amdgcn_readfirstlane(tid_ >> 6);
#pragma unroll
        for (int k = 0; k < 2; ++k) { const int n = ((int)blockIdx.x * NWAVE + wv_) * 2 + k; const bf16_t* wr_ = (const bf16_t*)(ws + WS_WS) + (size_t)n * D + ln_ * 16;
            const u32x4 qa = *(const u32x4*)wr_, qb = *(const u32x4*)(wr_ + 8); float sq = 0.f;
#pragma unroll
            for (int e = 0; e < 4; ++e) { sq += bflo(qa[e]) * bflo(qa[e]) + bfhi(qa[e]) * bfhi(qa[e]); sq += bflo(qb[e]) * bflo(qb[e]) + bfhi(qb[e]) * bfhi(qb[e]); }
            sq = wave_sum(sq); if (ln_ == 0) ((float*)(ws + WS_WN2))[n] = sq;
            float wf[16]; float mx = 0.f;
#pragma unroll
            for (int e = 0; e < 4; ++e) { wf[2 * e] = bflo(qa[e]); wf[2 * e + 1] = bfhi(qa[e]); wf[8 + 2 * e] = bflo(qb[e]); wf[8 + 2 * e + 1] = bfhi(qb[e]); }
#pragma unroll
            for (int e = 0; e < 16; ++e) mx = fmaxf(mx, fabsf(wf[e]));
#pragma unroll
            for (int o = 1; o < 64; o <<= 1) mx = fmaxf(mx, __shfl_xor(mx, o));
            const float wsc_ = mx > 0.f ? mx * (1.0f / 127.0f) : 1.0f, winv_ = 1.0f / wsc_; u32x4 wq_;
#pragma unroll
            for (int k4 = 0; k4 < 4; ++k4) { unsigned d = 0;
#pragma unroll
                for (int c = 0; c < 4; ++c) d |= ((unsigned)(int)rintf(wf[k4 * 4 + c] * winv_) & 0xffu) << (8 * c);
                wq_[k4] = d; }
            *(u32x4*)(ws + WS_WQ8 + (size_t)n * D + ln_ * 16) = wq_; if (ln_ == 0) ((float*)(ws + WS_WSC))[n] = wsc_; } }
    { Gemm g{(const bf16_t*)(ws + WS_A2), (const bf16_t*)(ws + WS_WA), 384, 384, 384, 0, 0};     S.init(T, 1024, 1, 0); S.window(S.u1 / 2, S.u1, NBLK / 2, NBLK / 2);
      EpiP e{ws + WS_G, (bf16_t*)(ws + WS_P), (const LAS float*)(lds + LDS_GBIAS), (const float*)(ws + WS_A2S), __uint_as_float(xb_ld((unsigned*)(ws + WS_CTL) + CTL_AMAX)) * (1.0f / 127.0f)}; gemm_phase(lds, g, S, e); }
    xcd_barrier(bar); TSTAMP(5);
    DBGC({ const bf16_t* Pp = (const bf16_t*)(ws + WS_P); const float* ya = (const float*)(ws + DB_YA); const float* pj = (const float*)(ws + DB_PROJ); const float* bg = p.in[3];
      dbg_cmp(ws, 6, NB, 1024, [=](int t, int c, float& a, float& b) { a = bf_at(Pp, (size_t)t * 1024 + c); b = ya[(size_t)t * 1024 + c] * sigm_n(pj[(size_t)t * IN_COLS + 2560 + c] + bg[c]); }); })
    DBGC({ const bf16_t* Zp = (const bf16_t*)(ws + WS_Z); const float* zn = (const float*)(ws + DB_Z);
      dbg_cmp(ws, 7, NB, 256, [=](int t, int c, float& a, float& b) { a = bf_at(Zp, (size_t)t * 256 + c); b = zn[(size_t)t * 256 + c]; }); })
    }
    const int pairp = (int)(blockIdx.x >> 4) * 8 + (int)(blockIdx.x & 7), pairh = (int)(blockIdx.x >> 3) & 1;
    { Gemm g{(const bf16_t*)(ws + WS_Z), (const bf16_t*)(ws + WS_WGLU), 256, 256, 256, 0, 0}; S.init(T, 256, 1, 0); S.direct(pairp, 0, 1);
      EpiGlu e{(const bf16_t*)(ws + WS_Z), p.in[15], (bf16_t*)(ws + WS_S5)}; gemm_phase(lds, g, S, e); }
    { Gemm g{(const bf16_t*)(ws + WS_S5), (const bf16_t*)(ws + WS_WB), 256, 256, 256, 0, 0}; S.init(T, 1024, 1, 0); S.direct(pairp, 2 * pairh, 2);
      EpiMerge e{ws + WS_G, (const bf16_t*)(ws + WS_P), (bf16_t*)(ws + WS_MG), (const LAS float*)(lds + LDS_GBIAS)}; gemm_phase(lds, g, S, e); }
    xcd_barrier(bar); TSTAMP(7);
    for (int rp_ = 0; rp_ < (REP_PH == 8 ? 2 : 1); ++rp_) {
    { Gemm g{(const bf16_t*)(ws + WS_MG), (const bf16_t*)(ws + WS_WOUT), 1024, 1024, 1024, 0, 0}; S.init(T, 1024, 1, 0);
      EpiX1 e{p.in[0], (bf16_t*)(ws + WS_X1B), (float*)(ws + WS_RS2P)}; gemm_phase(lds, g, S, e); }
    xcd_barrier(bar); TSTAMP(8);
    DBGC({ const bf16_t* Xp = (const bf16_t*)(ws + WS_X1B); const float* xn1 = (const float*)(ws + DB_X1);
      dbg_cmp(ws, 10, NB, 1024, [=](int t, int c, float& a, float& b) { a = bf_at(Xp, (size_t)t * 1024 + c); b = xn1[(size_t)t * 1024 + c]; }); })
    }
    }
    for (int hh = 0; hh < REP_I; ++hh) {
        phase_xq(p);
        xcd_barrier(bar);
        { Gemm g{(const bf16_t*)(ws + WS_XQ), (const bf16_t*)(ws + WS_WQ8), 512, 512, 512, 0, 0}; S.init(T, 2048, 1, 0);
          LAS float* rsl = (LAS float*)(lds + LDS_GBIAS); const float* RS2Pp = (const float*)(ws + WS_RS2P);
          float sig64;
          { const f32x4 wn = *(const f32x4*)((const float*)(ws + WS_WN2) + threadIdx.x * 4); float sw = wave_sum((wn[0] + wn[1]) + (wn[2] + wn[3]));
            LAS float* prt = rsl + 1024; if ((threadIdx.x & 63) == 0) prt[threadIdx.x >> 6] = sw; __syncthreads();
            float tot = 0.f;
#pragma unroll
            for (int w = 0; w < NWAVE; ++w) tot += prt[w];
            const float sigma = sqrtf(tot * (1.0f / 2048.0f)); sig64 = 64.0f / sigma;
            if (threadIdx.x == 0) ((float*)(ws + WS_SIGW))[blockIdx.x] = sigma * (1.0f / 64.0f); }
          const float* HSGp = (const float*)(ws + WS_HSG);
          auto rs_slot = [=](int i) -> int { Unit uu; if (!S.next(i, uu)) return -1;
              if (threadIdx.x < 256) rsl[i * 256 + threadIdx.x] = HSGp[(size_t)uu.pm * BM + threadIdx.x] * sig64;
              return uu.pm; };
          const int pmA = rs_slot(0), pmB = rs_slot(1), pmC = rs_slot(2); (void)rs_slot(3);
          __syncthreads();
          EpiSC e{ws + WS_SC, rsl, (const float*)(ws + WS_WSC), pmA, pmB, pmC}; gemm_phase(lds, g, S, e); }
        xcd_barrier(bar); TSTAMP(9);
    }
    DBGC({ const float* SCp = (const float*)(ws + WS_SC); const float* qn = (const float*)(ws + DB_Q); const float* RSp = (const float*)(ws + WS_RS2P); const float* kk1 = p.in[21]; const float* kk2 = p.in[22];
          dbg_cmp(ws, 11, NB, 2048, [=](int t, int c, float& a, float& b) { float ss = 0.f; for (int i = 0; i < 16; ++i) ss += RSp[(size_t)t * 16 + i];
            a = SCp[(size_t)t * 2048 + c] * rsqrtf(ss * (1.0f / D) + RMS_EPS); const int hs = c >> 7, j = c & 127; const float* kp = ((hs & 1) ? kk2 : kk1) + j * 128; const float* qq = qn + (size_t)t * 2048 + hs * 128;
            float sr = 0.f; for (int k = 0; k < 128; ++k) sr += qq[k] * kp[k]; b = sr; }); })
    for (int rep = 0; rep < REP_J; ++rep) { for (int rtk = 0; rtk < REP_TK; ++rtk) phase_topk(p, lds); asm volatile("s_waitcnt vmcnt(0) lgkmcnt(0)" ::: "memory"); __syncthreads();     phase_expert(p, lds); __syncthreads(); }
#if TIMING
    xcd_barrier(bar); TSTAMP(13);
    xcd_barrier(bar);
    { const unsigned long long* ts = (const unsigned long long*)(p.ws + WS_RSTD1 - 1024);
      const float ua = (float)(ts[TIME_A] - ts[TIME_A - 1]) * 0.01f, ub = (float)(ts[TIME_B] - ts[TIME_B - 1]) * 0.01f;
      const float c = sqrtf(ua);
      for (size_t i = (size_t)blockIdx.x * NTHR + threadIdx.x; i < (size_t)T * D; i += (size_t)NBLK * NTHR) p.out[i] = (i == 0) ? ub : c; }
#endif
    DBGC(xcd_barrier(bar); { const float* On = (const float*)(ws + DB_OUT); const float* Op = p.out;
      { const int* Ep = (const int*)(ws + WS_EIDX); const int* En = (const int*)(ws + DB_EIDX); const float* Gp2 = (const float*)(ws + WS_GATE); const float* Gn = (const float*)(ws + DB_GATE);
          dbg_cmp(ws, 12, NB, 128, [=](int t, int c, float& a, float& b) { const int e = Ep[(size_t)t * 128 + c]; const int* nn = En + (size_t)t * 128 + (c & ~15); int f = 0; for (int k = 0; k < 16; ++k) f |= (nn[k] == e); a = f ? 1.f : 0.f; b = 1.f; });
          dbg_cmp(ws, 13, NB, 128, [=](int t, int c, float& a, float& b) { const int e = Ep[(size_t)t * 128 + c]; const int* nn = En + (size_t)t * 128 + (c & ~15); a = Gp2[(size_t)t * 128 + c]; b = a; for (int k = 0; k < 16; ++k) if (nn[k] == e) b = Gn[(size_t)t * 128 + (c & ~15) + k]; }); }
      dbg_cmp(ws, 14, NB, 1024, [=](int t, int c, float& a, float& b) { a = Op[(size_t)t * 1024 + c]; b = On[(size_t)t * 1024 + c]; }); })
}
}

extern "C" void kernel_launch(void* const* d_in, const int* in_sizes, int n_in, void* d_out, int out_size, void* d_ws, size_t ws_size, hipStream_t stream) {
    static int ready = 0;
    if (ready == 0) {
        if (n_in != 26 || out_size != 32768 * D || ws_size < WS_END) { fprintf(stderr, "kernel_launch: unexpected shapes (n_in %d out %d ws %zu need %zu)\n", n_in, out_size, ws_size, (size_t)WS_END); ready = -1; return; }
        if (hipFuncSetAttribute((const void*)fwd_megakernel, hipFuncAttributeMaxDynamicSharedMemorySize, LDS_BYTES) != hipSuccess) { fprintf(stderr, "kernel_launch: hipFuncSetAttribute failed\n"); ready = -1; return; }
        ready = 1;
    }
    if (ready < 0) return;
    (void)hipMemsetAsync((char*)d_ws + WS_CTL, 0, 65536, stream);
#if DBG
    {
        char* wsb = (char*)d_ws; const int S = NB;
        const float* x = (const float*)d_in[0];
        float* cst = (float*)(wsb + DB_CST); float* hn = (float*)(wsb + DB_HN); float* proj = (float*)(wsb + DB_PROJ); float* am = (float*)(wsb + DB_AM); float* ya = (float*)(wsb + DB_YA);
        float* xr = (float*)(wsb + DB_XR); float* xi = (float*)(wsb + DB_XI); float* z = (float*)(wsb + DB_Z); float* lin = (float*)(wsb + DB_LIN); float* s5 = (float*)(wsb + DB_S5);
        float* yb = (float*)(wsb + DB_YB); float* merged = (float*)(wsb + DB_MG); float* x1 = (float*)(wsb + DB_X1); float* xn = (float*)(wsb + DB_XN); float* q = (float*)(wsb + DB_Q);
        int* eidx = (int*)(wsb + DB_EIDX); float* gate = (float*)(wsb + DB_GATE); float* outn = (float*)(wsb + DB_OUT);
        auto F = [&](int i) { return (const float*)d_in[i]; };
        auto gemm = [&](const float* A, int lda, const float* B, int ldb, float* C, int ldc, int M, int N, int K) { ngemm<<<dim3(N / 64, M / 64), 256, 0, stream>>>(A, lda, B, ldb, C, ldc, M, N, K); };
        (void)hipMemsetAsync(wsb + DB_ACC, 0, 4096, stream);
        n_ssm_const<<<4, 256, 0, stream>>>(F(6), F(7), F(8), cst);
        n_rmsnorm<<<S, 256, 0, stream>>>(x, F(1), hn);
        gemm(hn, D, F(2), IN_COLS, proj, IN_COLS, S, IN_COLS, D);
        n_conv<<<(S * CONV_CH) / 256, 256, 0, stream>>>(proj, F(4), F(5), am, S);
        gemm(am, CONV_CH, F(16), D, ya, D, S, D, CONV_CH);
        n_ssm_x<<<(S * 1024) / 256, 256, 0, stream>>>(proj, F(9), F(10), cst, xr, xi, S);
        n_ssm_scan<<<4, 256, 0, stream>>>(cst, xr, xi, S);
        n_ssm_y<<<(S * 256) / 256, 256, 0, stream>>>(proj, xr, xi, F(11), F(12), F(13), z, S);
        gemm(z, 256, F(14), 256, lin, 256, S, 256, 256);
        n_glu<<<(S * 256) / 256, 256, 0, stream>>>(z, lin, F(15), s5, (size_t)S * 256);
        gemm(s5, 256, F(17), D, yb, D, S, D, 256);
        n_merge<<<(S * D) / 256, 256, 0, stream>>>(proj, F(3), ya, yb, merged, (size_t)S * D);
        gemm(merged, D, F(18), D, x1, D, S, D, D);
        n_add<<<(S * D) / 256, 256, 0, stream>>>(x, x1, (size_t)S * D);
        n_rmsnorm<<<S, 256, 0, stream>>>(x1, F(19), xn);
        gemm(xn, D, F(20), PEER_QD, q, PEER_QD, S, PEER_QD, D);
        n_route<<<S, 256, 0, stream>>>(q, F(21), F(22), eidx, gate);
        n_expert<<<S / 4, 256, 0, stream>>>(xn, x1, eidx, gate, F(23), F(24), F(25), outn);
    }
#endif
    Params p{};
    for (int i = 0; i < 26; ++i) p.in[i] = (const float*)d_in[i];
    p.out = (float*)d_out; p.ws = (unsigned char*)d_ws;
    hipLaunchKernelGGL(fwd_megakernel, dim3(NBLK), dim3(NTHR), LDS_BYTES, stream, p);
#if DBG
    dbg_report<<<1024, 256, 0, stream>>>((const float*)((char*)d_ws + DB_ACC), (float*)d_out, out_size, DBG_FIRST);
#endif
}
```
